# Optimizing an MI355X kernel written in HIP

```python
import jax
import jax.numpy as jnp
from jax import lax
import numpy as np


D_MODEL = 1024
BATCH = 1
SEQ = 16384
DEPTH = 2
DEC_BATCH = 2
DEC_SEQ = 8192
PAST_LEN = 128

N_META = 16
N_MIXERS = 2
N_HGRN = (DEPTH + 1) // 2
N_RWKV = DEPTH // 2
HG_HEAD_DIM = 128
HG_HEADS = D_MODEL // HG_HEAD_DIM
HG_CHUNK = 64
HG_PAD = HG_CHUNK - N_META
RW_HEAD_DIM = 64
RW_HEADS = D_MODEL // RW_HEAD_DIM
RW_DECAY_LORA = 64
RW_AAA_LORA = 64
RW_GATE_LORA = 160
RW_GN_EPS = 64e-5
D_FF = 2816
NORM_EPS = 1e-6

kernel_name = 'hgrn2_rwkv7_convglu_bidir_encoder'


def rmsnorm(x, g):
    xf = x.astype(jnp.float32)
    y = xf * lax.rsqrt(jnp.mean(xf * xf, axis=-1, keepdims=True) + NORM_EPS)
    return (y * g.astype(jnp.float32)).astype(x.dtype)


def flip_seq(t):
    return jnp.flip(t, axis=1)


def hgrn2_chunk_scan(q, k, i, logf):
    B, Lp, H, DK = q.shape
    DV = i.shape[-1]
    C = HG_CHUNK
    N = Lp // C
    rs = lambda t: t.astype(jnp.float32).reshape(B, N, C, H, t.shape[-1])
    q, k, i, logf = rs(q), rs(k), rs(i), rs(logf)
    b = jnp.cumsum(logf, axis=2)
    ref = b[:, :, C // 2:C // 2 + 1]
    b_last = b[:, :, C - 1:]
    q_in = q * jnp.exp(b - ref)
    k_in = k * jnp.exp(ref - b)
    scores = jnp.einsum('bnthk,bnshk->bnhts', q_in, k_in)
    causal = jnp.tril(jnp.ones((C, C), dtype=bool))
    scores = jnp.where(causal, scores, 0.0)
    o_intra = jnp.einsum('bnhts,bnshv->bnthv', scores, i)
    q_st = q * jnp.exp(b)
    k_st = k * jnp.exp(b_last - b)
    g_tot = jnp.exp(b_last[:, :, 0])

    def step(S, xs):
        q_n, k_n, i_n, g_n = xs
        o_n = jnp.einsum('bthk,bhkv->bthv', q_n, S)
        S = g_n[..., None] * S + jnp.einsum('bshk,bshv->bhkv', k_n, i_n)
        return S, o_n

    S0 = jnp.zeros((B, H, DK, DV), jnp.float32)
    xs = (jnp.moveaxis(q_st, 1, 0), jnp.moveaxis(k_st, 1, 0), jnp.moveaxis(i, 1, 0), jnp.moveaxis(g_tot, 1, 0))
    _, o_inter = lax.scan(step, S0, xs)
    o = o_intra + jnp.moveaxis(o_inter, 0, 1)
    return o.reshape(B, Lp, H, DV)


def hgrn2_mixer(h, norm_g, w_in, w_out, onorm_g, lb):
    B, L, D = h.shape
    H, DH = HG_HEADS, HG_HEAD_DIM
    hn = rmsnorm(h, norm_g)
    q, f_fw, f_bw, i, g = jnp.split(hn @ w_in, 5, axis=-1)
    heads = lambda t: t.reshape(B, L, H, DH)
    pad = lambda t: jnp.pad(t.astype(jnp.float32), ((0, 0), (HG_PAD, 0), (0, 0), (0, 0)))
    valid = (jnp.arange(L + HG_PAD) >= HG_PAD).astype(jnp.float32)[None, :, None, None]
    lbh = lb.astype(jnp.float32).reshape(H, DH)
    q_p = pad(heads(jax.nn.silu(q)))
    i_p = pad(heads(i))

    def gates(f):
        f = pad(heads(f))
        logf = jnp.log(lbh + (1.0 - lbh) * jax.nn.sigmoid(f)) * valid
        k = (1.0 - lbh) * jax.nn.sigmoid(-f) * valid
        return k, logf

    k_f, lf_f = gates(f_fw)
    k_b, lf_b = gates(f_bw)
    o_f = hgrn2_chunk_scan(q_p, k_f, i_p, lf_f)
    o_b = flip_seq(hgrn2_chunk_scan(flip_seq(q_p), flip_seq(k_b), flip_seq(i_p), flip_seq(lf_b)))
    o = (o_f + o_b)[:, HG_PAD:]
    o = o * lax.rsqrt(jnp.mean(o * o, axis=-1, keepdims=True) + NORM_EPS) * onorm_g.astype(jnp.float32).reshape(H, DH)
    o = o.reshape(B, L, D) * jax.nn.silu(g.astype(jnp.float32))
    return h + o.astype(h.dtype) @ w_out


def rwkv7_scan(r, w, k, v, kk, a):
    B, L, H, N = r.shape

    def step(S, xs):
        r_t, w_t, k_t, v_t, kk_t, a_t = xs
        sa = jnp.einsum('bhvk,bhk->bhv', S, kk_t)
        S = S * w_t[:, :, None, :] - sa[..., None] * (kk_t * a_t)[:, :, None, :] + v_t[..., None] * k_t[:, :, None, :]
        y = jnp.einsum('bhvk,bhk->bhv', S, r_t)
        return S, y

    S0 = jnp.zeros((B, H, N, N), jnp.float32)
    xs = (jnp.moveaxis(r, 1, 0), jnp.moveaxis(w, 1, 0), jnp.moveaxis(k, 1, 0), jnp.moveaxis(v, 1, 0), jnp.moveaxis(kk, 1, 0), jnp.moveaxis(a, 1, 0))
    _, y = lax.scan(step, S0, xs)
    return jnp.moveaxis(y, 0, 1)


def rwkv7_mixer(h, norm_g, mu, w_r, w_k, w_v, w_o, w0, w1, w2, a0, a1, a2, g1, g2, k_k, k_a, r_k, gn_w, gn_b):
    B, L, D = h.shape
    H, N = RW_HEADS, RW_HEAD_DIM
    x = rmsnorm(h, norm_g)
    xp = jnp.pad(x, ((0, 0), (1, 1), (0, 0)))
    xx = 0.5 * (xp[:, :-2] + xp[:, 2:]) - x
    xr, xw, xk, xv, xa, xg = (x + xx * mu[j] for j in range(6))
    r = xr @ w_r
    k = xk @ w_k
    v = xv @ w_v
    g = jax.nn.sigmoid(xg @ g1) @ g2
    heads = lambda t: t.astype(jnp.float32).reshape(B, L, H, N)
    rh, vh = heads(r), heads(v)
    kk = heads(k * k_k)
    kk = kk * lax.rsqrt(jnp.maximum(jnp.sum(kk * kk, axis=-1, keepdims=True), 1e-24))
    r_kh = r_k.astype(jnp.float32).reshape(H, N)

    def direction_inputs(d):
        z = (w0[d] + jnp.tanh(xw @ w1[d]) @ w2[d]).astype(jnp.float32)
        decay = jnp.exp(-jnp.exp(-jax.nn.softplus(-z) - 0.5))
        a = jax.nn.sigmoid(a0[d] + (xa @ a1[d]) @ a2[d])
        kd = heads(k * (1.0 + (a - 1.0) * k_a))
        return heads(decay), kd, heads(a)

    w_f, k_fw, a_f = direction_inputs(0)
    w_b, k_bw, a_b = direction_inputs(1)
    y_f = rwkv7_scan(rh, w_f, k_fw, vh, kk, a_f)
    y_b = flip_seq(rwkv7_scan(flip_seq(rh), flip_seq(w_b), flip_seq(k_bw), flip_seq(vh), flip_seq(kk), flip_seq(a_b)))
    y = y_f + y_b
    mean = jnp.mean(y, axis=-1, keepdims=True)
    var = jnp.mean(jnp.square(y - mean), axis=-1, keepdims=True)
    yn = ((y - mean) * lax.rsqrt(var + RW_GN_EPS)).reshape(B, L, D) * gn_w + gn_b
    bonus = (jnp.sum(rh * k_fw * r_kh, axis=-1, keepdims=True) + jnp.sum(rh * k_bw * r_kh, axis=-1, keepdims=True)) * vh
    out = (yn + bonus.reshape(B, L, D)) * g
    return h + out.astype(h.dtype) @ w_o


def conv_glu_ffn(h, norm_g, w_in, conv_w, conv_b, w_out):
    x = rmsnorm(h, norm_g)
    u, v = jnp.split(x @ w_in, 2, axis=-1)
    up = jnp.pad(u, ((0, 0), (1, 1), (0, 0)))
    u = up[:, :-2] * conv_w[0] + u * conv_w[1] + up[:, 2:] * conv_w[2] + conv_b
    return h + (jax.nn.gelu(u) * v) @ w_out


def trunk(x, p):
    B = x.shape[0]
    meta = jnp.broadcast_to(p['meta_tokens'][None].astype(x.dtype), (B, N_META, D_MODEL))
    h = jnp.concatenate([meta, x], axis=1)
    lb_all = jnp.cumsum(jax.nn.softmax(p['hg_lower_bound'].astype(jnp.float32), axis=0), axis=0)
    for layer in range(DEPTH):
        j = layer // N_MIXERS
        if layer % N_MIXERS == 0:
            h = hgrn2_mixer(h, p['norm_mix'][layer], p['hg_w_in'][j], p['hg_w_out'][j], p['hg_onorm'][j], lb_all[j])
        else:
            h = rwkv7_mixer(h, p['norm_mix'][layer], p['rw_mu'][j], p['rw_w_r'][j], p['rw_w_k'][j], p['rw_w_v'][j], p['rw_w_o'][j],
                            p['rw_w0'][j], p['rw_w1'][j], p['rw_w2'][j], p['rw_a0'][j], p['rw_a1'][j], p['rw_a2'][j],
                            p['rw_g1'][j], p['rw_g2'][j], p['rw_k_k'][j], p['rw_k_a'][j], p['rw_r_k'][j], p['rw_gn_w'][j], p['rw_gn_b'][j])
        h = conv_glu_ffn(h, p['norm_ffn'][layer], p['ffn_w_in'][layer], p['ffn_conv_w'][layer], p['ffn_conv_b'][layer], p['ffn_w_out'][layer])
    return rmsnorm(h, p['norm_final'])[:, N_META:]


def setup_inputs(seed: int = 0) -> dict:
    key = jax.random.key(seed)
    ks = jax.random.split(key, 32)
    D, F = D_MODEL, D_FF

    def nrm(idx, shape, scale):
        return jax.random.normal(ks[idx], shape, jnp.float32) * scale

    return {
        'x_prompt': nrm(0, (BATCH, SEQ, D), 1.0),
        'x_sample': nrm(1, (DEC_BATCH, DEC_SEQ, D), 1.0),
        'meta_tokens': nrm(2, (N_META, D), 1.0),
        'norm_mix': 1.0 + nrm(3, (DEPTH, D), 0.05),
        'norm_ffn': 1.0 + nrm(4, (DEPTH, D), 0.05),
        'norm_final': 1.0 + nrm(5, (D,), 0.05),
        'hg_w_in': nrm(6, (N_HGRN, D, 5 * D), D ** -0.5),
        'hg_w_out': nrm(7, (N_HGRN, D, D), D ** -0.5),
        'hg_lower_bound': nrm(8, (N_HGRN + 1, D), 0.1),
        'hg_onorm': 1.0 + nrm(9, (N_HGRN, D), 0.05),
        'rw_mu': jax.random.uniform(ks[10], (N_RWKV, 6, D), jnp.float32),
        'rw_w_r': nrm(11, (N_RWKV, D, D), D ** -0.5),
        'rw_w_k': nrm(12, (N_RWKV, D, D), D ** -0.5),
        'rw_w_v': nrm(13, (N_RWKV, D, D), D ** -0.5),
        'rw_w_o': nrm(14, (N_RWKV, D, D), D ** -0.5),
        'rw_w0': jax.random.uniform(ks[15], (N_RWKV, 2, D), jnp.float32, minval=-6.0, maxval=-1.0),
        'rw_w1': nrm(16, (N_RWKV, 2, D, RW_DECAY_LORA), 0.5 * D ** -0.5),
        'rw_w2': nrm(17, (N_RWKV, 2, RW_DECAY_LORA, D), 0.1 * RW_DECAY_LORA ** -0.5),
        'rw_a0': nrm(18, (N_RWKV, 2, D), 0.1),
        'rw_a1': nrm(19, (N_RWKV, 2, D, RW_AAA_LORA), 0.5 * D ** -0.5),
        'rw_a2': nrm(20, (N_RWKV, 2, RW_AAA_LORA, D), 0.1 * RW_AAA_LORA ** -0.5),
        'rw_g1': nrm(21, (N_RWKV, D, RW_GATE_LORA), D ** -0.5),
        'rw_g2': nrm(22, (N_RWKV, RW_GATE_LORA, D), RW_GATE_LORA ** -0.5),
        'rw_k_k': 0.85 + nrm(23, (N_RWKV, D), 0.05),
        'rw_k_a': 1.0 + nrm(24, (N_RWKV, D), 0.05),
        'rw_r_k': nrm(25, (N_RWKV, D), 0.1),
        'rw_gn_w': 1.0 + nrm(26, (N_RWKV, D), 0.05),
        'rw_gn_b': nrm(27, (N_RWKV, D), 0.02),
        'ffn_w_in': nrm(28, (DEPTH, D, 2 * F), D ** -0.5),
        'ffn_conv_w': nrm(29, (DEPTH, 3, F), 3 ** -0.5),
        'ffn_conv_b': nrm(30, (DEPTH, F), 0.02),
        'ffn_w_out': nrm(31, (DEPTH, F, D), F ** -0.5),
    }


def reference(x_prompt, x_sample, meta_tokens, norm_mix, norm_ffn, norm_final, hg_w_in, hg_w_out, hg_lower_bound, hg_onorm,
              rw_mu, rw_w_r, rw_w_k, rw_w_v, rw_w_o, rw_w0, rw_w1, rw_w2, rw_a0, rw_a1, rw_a2, rw_g1, rw_g2,
              rw_k_k, rw_k_a, rw_r_k, rw_gn_w, rw_gn_b, ffn_w_in, ffn_conv_w, ffn_conv_b, ffn_w_out):
    p = {
        'meta_tokens': meta_tokens, 'norm_mix': norm_mix, 'norm_ffn': norm_ffn, 'norm_final': norm_final,
        'hg_w_in': hg_w_in, 'hg_w_out': hg_w_out, 'hg_lower_bound': hg_lower_bound, 'hg_onorm': hg_onorm,
        'rw_mu': rw_mu, 'rw_w_r': rw_w_r, 'rw_w_k': rw_w_k, 'rw_w_v': rw_w_v, 'rw_w_o': rw_w_o,
        'rw_w0': rw_w0, 'rw_w1': rw_w1, 'rw_w2': rw_w2, 'rw_a0': rw_a0, 'rw_a1': rw_a1, 'rw_a2': rw_a2,
        'rw_g1': rw_g1, 'rw_g2': rw_g2, 'rw_k_k': rw_k_k, 'rw_k_a': rw_k_a, 'rw_r_k': rw_r_k,
        'rw_gn_w': rw_gn_w, 'rw_gn_b': rw_gn_b,
        'ffn_w_in': ffn_w_in, 'ffn_conv_w': ffn_conv_w, 'ffn_conv_b': ffn_conv_b, 'ffn_w_out': ffn_w_out,
    }
    y_prompt = trunk(x_prompt, p)
    y_sample = trunk(x_sample, p)
    return (y_prompt, y_sample)
```

```cpp
#include <hip/hip_runtime.h>
#include <hip/hip_cooperative_groups.h>
#include <cstdio>
#include <cstdint>
namespace cg = cooperative_groups;

constexpr int D_ = 1024, FFN = 2816, TROWS = 33280, SLAB = 16640;
constexpr size_t SLABE = (size_t)SLAB * 1024;
constexpr float NEPS = 1e-6f;
__host__ __device__ __forceinline__ bool row_is_pad(int r) {
    int o;
    if (r < 8256) o = r; else if (r < 16512) o = r - 8256; else if (r < 16640) return true; else if (r < 33088) o = r - 16640; else return true;
    return o < 48;
}
__device__ __forceinline__ float bf2f(unsigned short v) { return __uint_as_float(((unsigned)v) << 16); }
typedef float f32x2_cv __attribute__((ext_vector_type(2)));
typedef __bf16 bf16x2_cv __attribute__((ext_vector_type(2)));
__device__ __forceinline__ unsigned pk2(float lo, float hi) { const f32x2_cv v = {lo, hi}; const bf16x2_cv b = __builtin_convertvector(v, bf16x2_cv); return __builtin_bit_cast(unsigned, b); }
__device__ __forceinline__ unsigned f2bf(float f) { return pk2(f, 0.f) & 0xffffu; }
__device__ __forceinline__ float sigmoidf_(float x) { return __builtin_amdgcn_rcpf(1.0f + __expf(-x)); }
namespace pg8 {
#define PG8_LAS __attribute__((address_space(3)))
typedef unsigned short bf16_t;
typedef short bf16x8 __attribute__((ext_vector_type(8)));
typedef float f32x4 __attribute__((ext_vector_type(4)));
typedef unsigned u32x4 __attribute__((ext_vector_type(4)));
constexpr int BM = 256, BK = 64, HALF = 128, HTB = HALF * BK * 2  , STAGE_BYTES = 8 * HTB, NXCD = 8, WGM = 8;

__host__ __device__ __forceinline__ int lds_byte(int r, int c) { const int st = (r >> 4) * 2 + (c >> 5), rr = r & 15, cc = c & 31, ob = rr * 64 + cc * 2; return st * 1024 + (ob ^ (((ob >> 9) & 1) << 5)); }
__host__ __device__ __forceinline__ void stage_rc(int b, int& R, int& C) { const int st = b / 1024, sb = b % 1024, swz = sb ^ (((sb >> 9) & 1) << 5); R = (st >> 1) * 16 + swz / 64; C = (st & 1) * 32 + (swz % 64) / 2; }
__host__ __device__ __forceinline__ int perm32(int rho) { const int n = rho >> 4, i = rho & 15; return 8 * (i >> 2) + 4 * n + (i & 3); }

struct Unit { int pm, pn; };
struct Gemm { const bf16_t* A; const bf16_t* Bt; int M, N, K, a_tile_rows, lda; unsigned a_off1, a_off2; };
__device__ __forceinline__ size_t a_unit_off(const Gemm& g, int pn) { return pn >= 8 ? (size_t)g.a_off2 : (pn >= 4 ? (size_t)g.a_off1 : (size_t)0); }

struct StaticOrder {
    int nM, nN, nwg, G, c;
    __host__ __device__ void init(int M, int N, int G_, int c_) { nM = M / BM; nN = N / BM; nwg = nM * nN; G = G_; c = c_; }
    __host__ __device__ bool next(int i, Unit& u) const {
        const long L = (long)i * G + c; if (L >= nwg) return false;
        int wgid = (int)L; { const int q = nwg / NXCD, r = nwg % NXCD, xcd = wgid % NXCD, off = wgid / NXCD; wgid = (xcd < r ? xcd * (q + 1) : r * (q + 1) + (xcd - r) * q) + off; }
        const int nig = WGM * nN, gid = wgid / nig, fm = gid * WGM, gsz = (nM - fm) < WGM ? (nM - fm) : WGM;
        u.pm = fm + ((wgid % nig) % gsz); u.pn = (wgid % nig) / gsz; return true;
    }
    __device__ __forceinline__ void a_ready(const Unit&) const {}
    __device__ __forceinline__ void done(const Unit&) const {}
};

struct BalOrder {
    int nM, nN, nwg, G, c, mode;
    __device__ bool next(int i, Unit& u) const {
        long L;
        if (G != 256) { L = (long)i * G + c; }
        else if (mode == 0) { if (i > 0 || c >= 130) return false; L = c; }
        else { if (i < 2) L = 256 * i + c; else { if (c < 130) return false; const int h = c - 130; if (i == 2) L = 512 + h; else if (i == 3) L = 638 + h; else if (i == 4 && h < 16) L = 764 + h; else return false; } }
        if (L >= nwg) return false;
        int wgid = (int)L; { const int q = nwg / NXCD, r = nwg % NXCD, xcd = wgid % NXCD, off = wgid / NXCD; wgid = (xcd < r ? xcd * (q + 1) : r * (q + 1) + (xcd - r) * q) + off; }
        const int nig = WGM * nN, gid = wgid / nig, fm = gid * WGM, gsz = (nM - fm) < WGM ? (nM - fm) : WGM;
        u.pm = fm + ((wgid % nig) % gsz); u.pn = (wgid % nig) / gsz; return true;
    }
    __device__ __forceinline__ void a_ready(const Unit&) const {}
    __device__ __forceinline__ void done(const Unit&) const {}
};

__device__ __forceinline__ unsigned cvt_pk_bf16(float lo, float hi) { return pk2(lo, hi); }
typedef float f32x2 __attribute__((ext_vector_type(2)));
__device__ __forceinline__ f32x2 gelu_pk(f32x2 v) {
    const f32x2 av = __builtin_elementwise_abs(v), d = av * 0.2316418882f + 1.0f;
    f32x2 t; t.x = __builtin_amdgcn_rcpf(d.x); t.y = __builtin_amdgcn_rcpf(d.y);
    f32x2 q = t * 0.5307027145f + (-0.7265760135f); q = q * t + 0.7107068705f; q = q * t + (-0.142248368f); q = q * t + 0.127414796f; q = q * t;
    const f32x2 s = (v * v) * (-0.72134752044f);
    f32x2 e; e.x = __builtin_amdgcn_exp2f(s.x); e.y = __builtin_amdgcn_exp2f(s.y);
    const f32x2 m = v * (q * e), r = v - m;
    f32x2 o; o.x = v.x < 0.f ? m.x : r.x; o.y = v.y < 0.f ? m.y : r.y; return o;
}


typedef unsigned u32x2 __attribute__((ext_vector_type(2)));
__device__ __forceinline__ u32x4 pack8(const f32x4 a, const f32x4 b) { u32x4 w; w.x = cvt_pk_bf16(a[0], a[1]); w.y = cvt_pk_bf16(a[2], a[3]); w.z = cvt_pk_bf16(b[0], b[1]); w.w = cvt_pk_bf16(b[2], b[3]); return w; }
__device__ __forceinline__ float silu_(float v) { return v * __builtin_amdgcn_rcpf(1.0f + __expf(-v)); }
__device__ __forceinline__ float gelu_tanh_(float x) { const float y = 1.5957691216f * (x + 0.044715f * x * x * x); return x * __builtin_amdgcn_rcpf(1.0f + __expf(-y)); }

__device__ __forceinline__ float row_ssq16(const float* part, int row) { const f32x4* p = (const f32x4*)(part + (size_t)row * 16); const f32x4 a = p[0], b = p[1], c = p[2], d = p[3];
    return (((a[0] + a[1]) + (a[2] + a[3])) + ((b[0] + b[1]) + (b[2] + b[3]))) + (((c[0] + c[1]) + (c[2] + c[3])) + ((d[0] + d[1]) + (d[2] + d[3]))); }

struct EpiHgIn {
    static constexpr bool PERM = true, AFTER_DRAIN = false;
    bf16_t* base; const float* ssq;
    __device__ __forceinline__ void operator()(const f32x4 (&acc)[2][2][4][2], const Unit& u, int wr, int wc, int fr, int fq) const {
        const int which = u.pn >> 2; const int colt = (u.pn & 3) * 256 + wc * 32 + 8 * fq;
        bf16_t* dst = base + (size_t)which * SLABE; const bool act = (which == 0) || (which == 4);
#pragma unroll
        for (int ai = 0; ai < 2; ++ai)
#pragma unroll
            for (int m = 0; m < 4; ++m) { const int row = u.pm * 256 + ai * 128 + wr * 64 + m * 16 + fr; const float rs = rsqrtf(ssq[row] * (1.0f / 1024.0f) + NEPS);
#pragma unroll
                for (int bj = 0; bj < 2; ++bj) { f32x4 v0 = acc[ai][bj][m][0] * rs, v1 = acc[ai][bj][m][1] * rs;
                    if (act) {
#pragma unroll
                        for (int e = 0; e < 4; ++e) { v0[e] = silu_(v0[e]); v1[e] = silu_(v1[e]); } }
                    *(u32x4*)(dst + (size_t)row * 1024 + colt + bj * 128) = pack8(v0, v1); } }
    }
};

struct EpiRes {
    static constexpr bool PERM = true, AFTER_DRAIN = false;
    const bf16_t* hin; bf16_t* hout; float* ssq; int row0;
    __device__ __forceinline__ void operator()(const f32x4 (&acc)[2][2][4][2], const Unit& u, int wr, int wc, int fr, int fq) const {
        const int col0 = u.pn * 256 + wc * 32 + 8 * fq;
#pragma unroll
        for (int ai = 0; ai < 2; ++ai)
#pragma unroll
            for (int m = 0; m < 4; ++m) { const int row = row0 + u.pm * 256 + ai * 128 + wr * 64 + m * 16 + fr; const bool pad = row_is_pad(row); float s = 0.f;
#pragma unroll
                for (int bj = 0; bj < 2; ++bj) { const size_t off = (size_t)row * 1024 + col0 + bj * 128; const u32x4 hv = *(const u32x4*)(hin + off);
                    f32x4 v0 = acc[ai][bj][m][0], v1 = acc[ai][bj][m][1];
                    v0[0] += __uint_as_float(hv.x << 16); v0[1] += __uint_as_float(hv.x & 0xffff0000u); v0[2] += __uint_as_float(hv.y << 16); v0[3] += __uint_as_float(hv.y & 0xffff0000u);
                    v1[0] += __uint_as_float(hv.z << 16); v1[1] += __uint_as_float(hv.z & 0xffff0000u); v1[2] += __uint_as_float(hv.w << 16); v1[3] += __uint_as_float(hv.w & 0xffff0000u);
#pragma unroll
                    for (int e = 0; e < 4; ++e) s += v0[e] * v0[e] + v1[e] * v1[e];
                    if (!pad) *(u32x4*)(hout + off) = pack8(v0, v1); }
                s += __shfl_xor(s, 16); s += __shfl_xor(s, 32);
                if (fq == 0) ssq[(size_t)row * 16 + u.pn * 4 + wc] = pad ? 0.f : s;
                if (m & 1) asm volatile("" ::: "memory"); }
    }
};

struct EpiFfnIn {
    static constexpr bool PERM = true, AFTER_DRAIN = false;
    bf16_t* act; const float* ssq; const float* cw; const float* cb; PG8_LAS float* edge;
    __device__ __forceinline__ void operator()(f32x4 (&acc)[2][2][4][2], const Unit& u, int wr, int wc, int fr, int fq) const {
        const int lane = fq * 16 + fr;
        const int rowt = u.pm * 254;
#pragma unroll
        for (int ai = 0; ai < 2; ++ai)
#pragma unroll
            for (int m = 0; m < 4; ++m) { const int row = rowt + ai * 128 + wr * 64 + m * 16 + fr; const f32x4 pv = *(const f32x4*)(ssq + (size_t)row * 16 + 4 * fq); float sq = (pv[0] + pv[1]) + (pv[2] + pv[3]); sq += __shfl_xor(sq, 16); sq += __shfl_xor(sq, 32);
                const float rs = rsqrtf(sq * (1.0f / 1024.0f) + NEPS);
#pragma unroll
                for (int bj = 0; bj < 2; ++bj)
#pragma unroll
                    for (int n = 0; n < 2; ++n) acc[ai][bj][m][n] = acc[ai][bj][m][n] * rs;
                asm volatile("" ::: "memory"); }
        const int colw = wc * 32 + 8 * fq;
        PG8_LAS float* edgeF = edge; PG8_LAS float* edgeL = edge + 512;
#pragma unroll
        for (int ai = 0; ai < 2; ++ai) { const int blk = 2 * ai + wr;
            if (fr == 0) {
#pragma unroll
                for (int n = 0; n < 2; ++n)
#pragma unroll
                    for (int e = 0; e < 4; ++e) edgeF[blk * 128 + colw + 4 * n + e] = acc[ai][0][0][n][e]; }
            if (fr == 15) {
#pragma unroll
                for (int n = 0; n < 2; ++n)
#pragma unroll
                    for (int e = 0; e < 4; ++e) edgeL[blk * 128 + colw + 4 * n + e] = acc[ai][0][3][n][e]; } }
        asm volatile("s_waitcnt lgkmcnt(0)" ::: "memory"); __builtin_amdgcn_s_barrier(); asm volatile("" ::: "memory");
        const int lprev = (lane & 48) | ((fr + 15) & 15), lnext = (lane & 48) | ((fr + 1) & 15);
        const int colg = u.pn * 128 + colw;
        const bool f0 = (fr == 0), f15 = (fr == 15);
#pragma unroll
        for (int ai = 0; ai < 2; ++ai) { const int blk = 2 * ai + wr;
#pragma unroll
            for (int n = 0; n < 2; ++n) {
                const f32x4 w0v = *(const f32x4*)(cw + colg + 4 * n), w1v = *(const f32x4*)(cw + FFN + colg + 4 * n), w2v = *(const f32x4*)(cw + 2 * FFN + colg + 4 * n), cbv = *(const f32x4*)(cb + colg + 4 * n);
                f32x4 res[4];
#pragma unroll
                for (int p = 0; p < 2; ++p) {
                    const f32x2 w0 = {w0v[2 * p], w0v[2 * p + 1]}, w1 = {w1v[2 * p], w1v[2 * p + 1]}, w2 = {w2v[2 * p], w2v[2 * p + 1]}, bb = {cbv[2 * p], cbv[2 * p + 1]};
                    f32x2 c[4], ps[4], ns[4];
#pragma unroll
                    for (int m = 0; m < 4; ++m) { c[m] = (f32x2){acc[ai][0][m][n][2 * p], acc[ai][0][m][n][2 * p + 1]};
                        ps[m] = (f32x2){__shfl(c[m].x, lprev), __shfl(c[m].y, lprev)}; ns[m] = (f32x2){__shfl(c[m].x, lnext), __shfl(c[m].y, lnext)}; }
                    f32x2 pe = {0.f, 0.f}, ne = {0.f, 0.f};
                    if (blk > 0) pe = (f32x2){edgeL[(blk - 1) * 128 + colw + 4 * n + 2 * p], edgeL[(blk - 1) * 128 + colw + 4 * n + 2 * p + 1]};
                    if (blk < 3) ne = (f32x2){edgeF[(blk + 1) * 128 + colw + 4 * n + 2 * p], edgeF[(blk + 1) * 128 + colw + 4 * n + 2 * p + 1]};
#pragma unroll
                    for (int m = 0; m < 4; ++m) {
                        const f32x2 pvm = f0 ? (m == 0 ? pe : ps[m == 0 ? 0 : m - 1]) : ps[m];
                        const f32x2 nvm = f15 ? (m == 3 ? ne : ns[m == 3 ? 3 : m + 1]) : ns[m];
                        f32x2 cu = w1 * c[m] + bb; cu = w0 * pvm + cu; cu = w2 * nvm + cu;
                        f32x2 tq = (cu * cu) * cu; tq = tq * 0.044715f + cu;
                        const f32x2 ea = tq * (-2.3022082f);
                        f32x2 dn; dn.x = __builtin_amdgcn_exp2f(ea.x); dn.y = __builtin_amdgcn_exp2f(ea.y); dn = dn + 1.0f;
                        f32x2 rc; rc.x = __builtin_amdgcn_rcpf(dn.x); rc.y = __builtin_amdgcn_rcpf(dn.y);
                        const f32x2 vv = {acc[ai][1][m][n][2 * p], acc[ai][1][m][n][2 * p + 1]};
                        const f32x2 o = (cu * rc) * vv;
                        res[m][2 * p] = o.x; res[m][2 * p + 1] = o.y; }
                }
#pragma unroll
                for (int m = 0; m < 4; ++m) { const int j = ai * 128 + wr * 64 + m * 16 + fr;
                    u32x2 w; w.x = cvt_pk_bf16(res[m][0], res[m][1]); w.y = cvt_pk_bf16(res[m][2], res[m][3]);
                    if (j >= 1 && j <= 254) *(u32x2*)(act + (size_t)(rowt + j) * FFN + colg + 4 * n) = w; }
                asm volatile("" ::: "memory");
            }
        }
        asm volatile("s_waitcnt lgkmcnt(0)" ::: "memory"); __builtin_amdgcn_s_barrier(); asm volatile("" ::: "memory");
    }
};

struct EpiRkv {
    static constexpr bool PERM = true, AFTER_DRAIN = false;
    bf16_t* base;
    __device__ __forceinline__ void operator()(const f32x4 (&acc)[2][2][4][2], const Unit& u, int wr, int wc, int fr, int fq) const {
        const int colw = wc * 32 + 8 * fq;
        bf16_t* dst0 = base + (size_t)(u.pn >> 2) * SLABE + (u.pn & 3) * 256 + colw;
#pragma unroll
        for (int ai = 0; ai < 2; ++ai)
#pragma unroll
            for (int m = 0; m < 4; ++m) { const int row = u.pm * 256 + ai * 128 + wr * 64 + m * 16 + fr; bf16_t* dst = dst0 + (size_t)row * 1024;
#pragma unroll
                for (int bj = 0; bj < 2; ++bj) *(u32x4*)(dst + bj * 128) = pack8(acc[ai][bj][m][0], acc[ai][bj][m][1]);
                asm volatile("" ::: "memory"); }
    }
};
struct EpiLora {
    static constexpr bool PERM = true, AFTER_DRAIN = false;
    bf16_t* hw; bf16_t* ha; bf16_t* hg;
    __device__ __forceinline__ void operator()(const f32x4 (&acc)[2][2][4][2], const Unit& u, int wr, int wc, int fr, int fq) const {
        const int colw = wc * 32 + 8 * fq;
#pragma unroll
        for (int ai = 0; ai < 2; ++ai)
#pragma unroll
            for (int m = 0; m < 4; ++m) { const int row = u.pm * 256 + ai * 128 + wr * 64 + m * 16 + fr;
                if (u.pn == 0) { f32x4 v0 = acc[ai][0][m][0], v1 = acc[ai][0][m][1];
#pragma unroll
                    for (int e = 0; e < 4; ++e) { v0[e] = 2.0f * __builtin_amdgcn_rcpf(1.0f + __expf(-2.0f * v0[e])) - 1.0f; v1[e] = 2.0f * __builtin_amdgcn_rcpf(1.0f + __expf(-2.0f * v1[e])) - 1.0f; }
                    *(u32x4*)(hw + (size_t)row * 128 + colw) = pack8(v0, v1);
                    *(u32x4*)(ha + (size_t)row * 128 + colw) = pack8(acc[ai][1][m][0], acc[ai][1][m][1]);
                } else {
#pragma unroll
                    for (int bj = 0; bj < 2; ++bj) { f32x4 v0 = acc[ai][bj][m][0], v1 = acc[ai][bj][m][1];
#pragma unroll
                        for (int e = 0; e < 4; ++e) { v0[e] = __builtin_amdgcn_rcpf(1.0f + __expf(-v0[e])); v1[e] = __builtin_amdgcn_rcpf(1.0f + __expf(-v1[e])); }
                        *(u32x4*)(hg + (size_t)row * 256 + bj * 128 + colw) = pack8(v0, v1); } }
                asm volatile("" ::: "memory"); }
    }
};

struct EpiGate {
    static constexpr bool PERM = true, AFTER_DRAIN = false;
    const bf16_t* yb; bf16_t* outb;
    __device__ __forceinline__ void operator()(const f32x4 (&acc)[2][2][4][2], const Unit& u, int wr, int wc, int fr, int fq) const {
        const int col0 = u.pn * 256 + wc * 32 + 8 * fq;
#pragma unroll
        for (int ai = 0; ai < 2; ++ai)
#pragma unroll
            for (int m = 0; m < 4; ++m) { const int row = u.pm * 256 + ai * 128 + wr * 64 + m * 16 + fr;
#pragma unroll
                for (int bj = 0; bj < 2; ++bj) { const size_t off = (size_t)row * 1024 + col0 + bj * 128; const u32x4 hv = *(const u32x4*)(yb + off);
                    f32x4 v0 = acc[ai][bj][m][0], v1 = acc[ai][bj][m][1];
                    v0[0] *= __uint_as_float(hv.x << 16); v0[1] *= __uint_as_float(hv.x & 0xffff0000u); v0[2] *= __uint_as_float(hv.y << 16); v0[3] *= __uint_as_float(hv.y & 0xffff0000u);
                    v1[0] *= __uint_as_float(hv.z << 16); v1[1] *= __uint_as_float(hv.z & 0xffff0000u); v1[2] *= __uint_as_float(hv.w << 16); v1[3] *= __uint_as_float(hv.w & 0xffff0000u);
                    *(u32x4*)(outb + off) = pack8(v0, v1); }
                asm volatile("" ::: "memory"); }
    }
};
template <class Epi, class Sched, bool ALIGN_EPI = false, bool SP2 = false>
__device__ __forceinline__ void gemm_phase(PG8_LAS unsigned char* lds, const Gemm g, const Sched& S, const Epi& E, int tid_in) {
    int tid_l = tid_in;
    const int tid = tid_l, wid = __builtin_amdgcn_readfirstlane(tid >> 6), lane = tid & 63, wr = wid >> 2, wc = wid & 3, fr = lane & 15, fq = lane >> 4;
    const int K = g.K, nt = K / BK;
    unsigned voffA[2], voffB[2];
#pragma unroll
    for (int i = 0; i < 2; ++i) { int R, C; stage_rc(tid * 16 + i * 8192, R, C); const int Rb = Epi::PERM ? ((R & ~31) + perm32(R & 31)) : R;
        voffA[i] = (unsigned)(R * g.lda + C) * 2u; voffB[i] = (unsigned)(Rb * K + C) * 2u; }
    const size_t kstep = (size_t)(BK * 2);
    const size_t hstep = (size_t)HALF * K * 2;
    const size_t hstepA = (size_t)HALF * g.lda * 2;
    const size_t tstepA = (size_t)g.a_tile_rows * g.lda * 2, tstepB = 2 * hstep;
    const unsigned ldsw = (unsigned)wid * 1024u;
    const int aoff = lds_byte(wr * 64 + fr, fq * 8), boff = lds_byte(wc * 32 + fr, fq * 8);
#define PG8_SA(b, h) (((b) * 2 + (h)) * HTB)
#define PG8_SB(b, h) ((4 + (b) * 2 + (h)) * HTB)
#define PG8_STAGE(bufoff, gbase, voff) do { _Pragma("unroll") for (int _i = 0; _i < 2; ++_i) \
        __builtin_amdgcn_global_load_lds((const unsigned*)((const char*)(gbase) + (voff)[_i]), (PG8_LAS unsigned*)(lds + (bufoff) + ldsw + _i * 8192), 16, 0, 0); } while (0)
#define PG8_LDA(dst, b, h) do { _Pragma("unroll") for (int m = 0; m < 4; ++m) _Pragma("unroll") for (int k = 0; k < 2; ++k) dst[m][k] = *(const PG8_LAS bf16x8*)(lds + PG8_SA(b, h) + aoff + m * 2048 + k * 1024); } while (0)
#define PG8_LDB(dst, b, h) do { _Pragma("unroll") for (int n = 0; n < 2; ++n) _Pragma("unroll") for (int k = 0; k < 2; ++k) dst[n][k] = *(const PG8_LAS bf16x8*)(lds + PG8_SB(b, h) + boff + n * 2048 + k * 1024); } while (0)
#define PG8_MMA(ai, bj, At, Bt) do { __builtin_amdgcn_s_setprio(1); _Pragma("unroll") for (int m = 0; m < 4; ++m) _Pragma("unroll") for (int n = 0; n < 2; ++n) _Pragma("unroll") for (int k = 0; k < 2; ++k) \
        acc[ai][bj][m][n] = __builtin_amdgcn_mfma_f32_16x16x32_bf16(Bt[n][k], At[m][k], acc[ai][bj][m][n], 0, 0, 0); __builtin_amdgcn_s_setprio(0); } while (0)
#define PG8_WAIT_V(n) asm volatile("s_waitcnt vmcnt(" #n ")" ::: "memory")
#define PG8_WAIT_L(n) asm volatile("s_waitcnt lgkmcnt(" #n ")" ::: "memory")
#define PG8_BAR __builtin_amdgcn_s_barrier()
#define PG8_SCHED __builtin_amdgcn_sched_barrier(0)
    Unit cur, nxt; int ui = 0;
    if (!S.next(0, cur)) return;
    f32x4 acc[2][2][4][2];
#pragma unroll
    for (int a = 0; a < 2; ++a)
#pragma unroll
        for (int b = 0; b < 2; ++b)
#pragma unroll
            for (int m = 0; m < 4; ++m)
#pragma unroll
                for (int n = 0; n < 2; ++n) acc[a][b][m][n] = (f32x4){0.f, 0.f, 0.f, 0.f};
    bf16x8 At[4][2], B0[2][2], B1[2][2];
    const char* cA = (const char*)g.A + (size_t)cur.pm * tstepA + a_unit_off(g, cur.pn); const char* cB = (const char*)g.Bt + (size_t)cur.pn * tstepB;
    S.a_ready(cur);
    if constexpr (SP2) {
        PG8_STAGE(PG8_SB(0, 0), cB, voffB); PG8_STAGE(PG8_SB(0, 1), cB + hstep, voffB); PG8_STAGE(PG8_SA(0, 0), cA, voffA); PG8_STAGE(PG8_SA(0, 1), cA + hstepA, voffA);
        if (wr == 1) PG8_BAR;
        PG8_WAIT_V(2); PG8_BAR;
        PG8_STAGE(PG8_SB(1, 0), cB + kstep, voffB); PG8_STAGE(PG8_SA(1, 0), cA + kstep, voffA); PG8_STAGE(PG8_SB(1, 1), cB + hstep + kstep, voffB);
        PG8_WAIT_V(6); PG8_BAR;
    } else {
        PG8_STAGE(PG8_SB(0, 0), cB, voffB); PG8_STAGE(PG8_SA(0, 0), cA, voffA); PG8_STAGE(PG8_SB(0, 1), cB + hstep, voffB); PG8_STAGE(PG8_SA(0, 1), cA + hstepA, voffA);
        if (wr == 1) PG8_BAR;
        PG8_WAIT_V(4); PG8_BAR;
        PG8_STAGE(PG8_SB(1, 0), cB + kstep, voffB); PG8_STAGE(PG8_SA(1, 0), cA + kstep, voffA); PG8_STAGE(PG8_SB(1, 1), cB + hstep + kstep, voffB);
        PG8_WAIT_V(6); PG8_BAR;
    }
    for (;;) {
        const bool has_next = S.next(ui + 1, nxt);
        const char* nA = has_next ? (const char*)g.A + (size_t)nxt.pm * tstepA + a_unit_off(g, nxt.pn) : cA; const char* nB = has_next ? (const char*)g.Bt + (size_t)nxt.pn * tstepB : cB;
#pragma unroll 1
        for (int t = 0; t < nt; t += 2) {
            const bool last = (t == nt - 2);
            const char* a1 = cA + (size_t)(t + 1) * kstep;
            const char* a2 = last ? nA : cA + (size_t)(t + 2) * kstep; const char* b2 = last ? nB : cB + (size_t)(t + 2) * kstep;
            const char* a3 = a2 + kstep; const char* b3 = b2 + kstep;
            if (last && has_next) S.a_ready(nxt);
            if constexpr (SP2) {
            PG8_LDB(B0, 0, 0); PG8_LDB(B1, 0, 1); PG8_SCHED; PG8_LDA(At, 0, 0); PG8_STAGE(PG8_SA(1, 1), a1 + hstepA, voffA);
            PG8_WAIT_V(8); PG8_WAIT_L(0); PG8_BAR; PG8_MMA(0, 0, At, B0); PG8_MMA(0, 1, At, B1); PG8_BAR; PG8_SCHED;
            PG8_LDA(At, 0, 1); PG8_STAGE(PG8_SB(0, 0), b2, voffB); PG8_STAGE(PG8_SB(0, 1), b2 + hstep, voffB); PG8_STAGE(PG8_SA(0, 0), a2, voffA);
            PG8_WAIT_V(8); PG8_WAIT_L(0); PG8_BAR; PG8_MMA(1, 0, At, B0); PG8_MMA(1, 1, At, B1); PG8_BAR; PG8_SCHED;
            PG8_LDB(B0, 1, 0); PG8_LDB(B1, 1, 1); PG8_SCHED; PG8_LDA(At, 1, 0); PG8_STAGE(PG8_SA(0, 1), a2 + hstepA, voffA);
            PG8_WAIT_V(8); PG8_WAIT_L(0); PG8_BAR; PG8_MMA(0, 0, At, B0); PG8_MMA(0, 1, At, B1); PG8_BAR; PG8_SCHED;
            PG8_LDA(At, 1, 1); PG8_STAGE(PG8_SB(1, 0), b3, voffB); PG8_STAGE(PG8_SB(1, 1), b3 + hstep, voffB); PG8_STAGE(PG8_SA(1, 0), a3, voffA);
            PG8_WAIT_V(8); PG8_WAIT_L(0); PG8_BAR; PG8_MMA(1, 0, At, B0); PG8_MMA(1, 1, At, B1); PG8_BAR; PG8_SCHED;
            } else {
            PG8_LDB(B0, 0, 0); PG8_SCHED; PG8_LDA(At, 0, 0); PG8_STAGE(PG8_SA(1, 1), a1 + hstepA, voffA);
            PG8_WAIT_L(8); PG8_BAR; PG8_WAIT_L(0); PG8_MMA(0, 0, At, B0); PG8_BAR; PG8_SCHED;
            PG8_LDB(B1, 0, 1); PG8_STAGE(PG8_SB(0, 0), b2, voffB);
            PG8_BAR; PG8_WAIT_L(0); PG8_MMA(0, 1, At, B1); PG8_BAR;
            PG8_LDA(At, 0, 1); PG8_STAGE(PG8_SA(0, 0), a2, voffA);
            PG8_BAR; PG8_WAIT_L(0); PG8_MMA(1, 0, At, B0); PG8_BAR; PG8_SCHED;
            PG8_STAGE(PG8_SB(0, 1), b2 + hstep, voffB);
            PG8_WAIT_V(6); PG8_BAR; PG8_MMA(1, 1, At, B1); PG8_BAR;
            PG8_LDB(B0, 1, 0); PG8_SCHED; PG8_LDA(At, 1, 0); PG8_STAGE(PG8_SA(0, 1), a2 + hstepA, voffA);
            PG8_WAIT_L(8); PG8_BAR; PG8_WAIT_L(0); PG8_MMA(0, 0, At, B0); PG8_BAR; PG8_SCHED;
            PG8_LDB(B1, 1, 1); PG8_STAGE(PG8_SB(1, 0), b3, voffB);
            PG8_BAR; PG8_WAIT_L(0); PG8_MMA(0, 1, At, B1); PG8_BAR;
            PG8_LDA(At, 1, 1); PG8_STAGE(PG8_SA(1, 0), a3, voffA);
            PG8_BAR; PG8_WAIT_L(0); PG8_MMA(1, 0, At, B0); PG8_BAR; PG8_SCHED;
            PG8_STAGE(PG8_SB(1, 1), b3 + hstep, voffB);
            PG8_WAIT_V(6); PG8_BAR; PG8_MMA(1, 1, At, B1); PG8_BAR;
            }
        }
        if constexpr (ALIGN_EPI) { if (wr == 0) PG8_BAR; }
        if constexpr (!Epi::AFTER_DRAIN) { E(acc, cur, wr, wc, fr, fq); S.done(cur); }
        if (!has_next) break;
#pragma unroll
        for (int a = 0; a < 2; ++a)
#pragma unroll
            for (int b = 0; b < 2; ++b)
#pragma unroll
                for (int m = 0; m < 4; ++m)
#pragma unroll
                    for (int n = 0; n < 2; ++n) acc[a][b][m][n] = (f32x4){0.f, 0.f, 0.f, 0.f};
        cur = nxt; cA = nA; cB = nB; ++ui;
        if constexpr (ALIGN_EPI) { if (wr == 1) PG8_BAR; }
    }
    PG8_WAIT_V(0);
    if constexpr (!ALIGN_EPI) { if (wr == 0) PG8_BAR; }
    PG8_BAR;
    if constexpr (Epi::AFTER_DRAIN) { E.fused(acc, cur, wr, wc, fr, fq, lds, wid, lane); S.done(cur); }
#undef PG8_SA
#undef PG8_SB
#undef PG8_STAGE
#undef PG8_LDA
#undef PG8_LDB
#undef PG8_MMA
#undef PG8_WAIT_V
#undef PG8_WAIT_L
#undef PG8_BAR
#undef PG8_SCHED
}
}

#define LAS __attribute__((address_space(3)))
typedef unsigned short bf16;
typedef short bf16x8_t __attribute__((ext_vector_type(8)));
typedef float f32x4_t __attribute__((ext_vector_type(4)));
typedef unsigned u32x4_t __attribute__((ext_vector_type(4)));
typedef unsigned u32x2_t __attribute__((ext_vector_type(2)));
constexpr int LDS_BYTES = 147456, RING_BYTES = 131072;

constexpr size_t DO_WLORA = 98041856 + 6291456, DO_HB = 0, DO_WHG = 68157440, DO_WHGO = 78643200, DO_WF0I = 80740352, DO_WF0O = 92274688, DO_WRW1 = 98041856, DO_WRWO = 113770496,
                 DO_WG2 = 115867648, DO_WF1I = 116391936, DO_WF1O = 127926272, DO_END = 133693440;
constexpr size_t WS_BAR = 720896, WS_SSQ = 0, WS_BETA = 1048576, WS_PA = 3211264, WS_PB = 5373952, WS_HW = 7536640, WS_HA = 11796480, WS_HG = 16056320, WS_BIG = 25165824, WS_SLOTB = 34078720,
                 WS_NEED = 268435456, WS_ACT = WS_NEED - (size_t)TROWS * FFN * 2, WS_HBNEW = 8388608;
static_assert(WS_BETA + 2 * (size_t)SLAB * 64 <= WS_PA && WS_PA + (size_t)TROWS * 64 <= WS_PB && WS_PB + (size_t)TROWS * 64 <= WS_HW && WS_HW + (size_t)SLAB * 256 <= WS_HA && WS_HA + (size_t)SLAB * 256 <= WS_HG && WS_HG + (size_t)SLAB * 512 <= WS_BIG, "small map");
static_assert(8388608 + (size_t)64 * 129 * 4608 <= 2 * WS_SLOTB && 8388608 + (size_t)32 * 257 * 4608 <= 2 * WS_SLOTB && WS_HW + (size_t)256 * 16512 * 4 <= WS_BIG && WS_BIG + 7 * WS_SLOTB <= WS_NEED && WS_HBNEW + (size_t)TROWS * 2048 <= WS_ACT && DO_END <= 134217728, "maps");

struct Args { const float* in[32]; float* out; unsigned char* ws; };
typedef const __attribute__((address_space(4))) Args* ArgP;
#define LAUNDER_ARGS(ap0) ({ ArgP _p = (ap0); asm volatile("" : "+s"(_p)); _p; })

__device__ __forceinline__ float wave_sum(float v) {
#pragma unroll
    for (int o = 1; o < 64; o <<= 1) v += __shfl_xor(v, o);
    return v;
}

__device__ __forceinline__ void tr_item(const float* W, int N, int Klim, int k0, int n0, bf16* WT, int ldk, int drow, int dcol, const float* sc, float* scr, int lane, const float* sc2 = nullptr) {
    if (k0 + 64 <= Klim) {
#pragma unroll 8
        for (int i = 0; i < 32; ++i) { const int kk = 2 * i + (lane >> 5); scr[kk * 33 + (lane & 31)] = W[(size_t)(k0 + kk) * N + n0 + (lane & 31)]; }
    } else {
#pragma unroll 8
        for (int i = 0; i < 32; ++i) { const int kk = 2 * i + (lane >> 5); const int k = k0 + kk; float v = 0.f; if (k < Klim) v = W[(size_t)k * N + n0 + (lane & 31)]; scr[kk * 33 + (lane & 31)] = v; }
    }
    asm volatile("s_waitcnt lgkmcnt(0)" ::: "memory");
    const int c = lane & 7;
    f32x4_t sa = (f32x4_t){1.f, 1.f, 1.f, 1.f}, sb = sa;
    if (sc) { sa = *(const f32x4_t*)(sc + k0 + 8 * c); sb = *(const f32x4_t*)(sc + k0 + 8 * c + 4);
        if (sc2) { sa = sa - *(const f32x4_t*)(sc2 + k0 + 8 * c); sb = sb - *(const f32x4_t*)(sc2 + k0 + 8 * c + 4); } }
#pragma unroll
    for (int j = 0; j < 4; ++j) { const int n = (lane >> 3) + 8 * j; const float* s = scr + (8 * c) * 33 + n;
        u32x4_t o; o.x = pk2(s[0 * 33] * sa[0], s[1 * 33] * sa[1]); o.y = pk2(s[2 * 33] * sa[2], s[3 * 33] * sa[3]); o.z = pk2(s[4 * 33] * sb[0], s[5 * 33] * sb[1]); o.w = pk2(s[6 * 33] * sb[2], s[7 * 33] * sb[3]);
        *(u32x4_t*)(WT + (size_t)(drow + n) * ldk + dcol + k0 + 8 * c) = o; }
    asm volatile("s_waitcnt lgkmcnt(0)" ::: "memory");
}

__device__ __forceinline__ void p0_prologue(ArgP ap, unsigned char* lds, int tid) {
    const int lane = tid & 63, wave = tid >> 6;
    float* scr = (float*)(lds + wave * 16384);
    int gdim = gridDim.x; asm volatile("" : "+s"(gdim));
    const int gw = blockIdx.x * 8 + wave, NGW = gdim * 8;
    unsigned char* dob = (unsigned char*)ap->out;
    bf16* WHG = (bf16*)(dob + DO_WHG); bf16* WHGO = (bf16*)(dob + DO_WHGO); bf16* WF0I = (bf16*)(dob + DO_WF0I); bf16* WF0O = (bf16*)(dob + DO_WF0O);
    bf16* WRW1 = (bf16*)(dob + DO_WRW1); bf16* WLORA = (bf16*)(dob + DO_WLORA); bf16* WRWO = (bf16*)(dob + DO_WRWO); bf16* WG2 = (bf16*)(dob + DO_WG2); bf16* WF1I = (bf16*)(dob + DO_WF1I); bf16* WF1O = (bf16*)(dob + DO_WF1O);
    const float* mu = ap->in[10];
    constexpr int I_HG = 16 * 160, I_SQ = 16 * 32, I_FI = 16 * 176, I_FO = 44 * 32, I_L64 = 16 * 2, I_G1 = 16 * 5, I_G2 = 4 * 32;
    constexpr int NITEMS = I_HG + I_SQ + 2 * I_FI + 2 * I_FO + 3 * I_SQ + 4 * I_L64 + 4 * I_L64 + 2 * I_G1 + I_SQ + I_G2;
    for (int it = gw; it < NITEMS; it += NGW) {
        int r = it;
        if (r < I_HG) { const int kb = r / 160, nb = r % 160; tr_item(ap->in[6], 5120, 1024, 64 * kb, 32 * nb, WHG, 1024, 32 * nb, 0, ap->in[3], scr, lane); continue; } r -= I_HG;
        if (r < I_SQ) { const int kb = r / 32, nb = r % 32; tr_item(ap->in[7], 1024, 1024, 64 * kb, 32 * nb, WHGO, 1024, 32 * nb, 0, nullptr, scr, lane); continue; } r -= I_SQ;
        if (r < 2 * I_FI) { const int l = r / I_FI; r -= l * I_FI; const int kb = r / 176, nb = r % 176; const int n0 = 32 * nb; const int half = n0 / FFN, c = n0 % FFN;
            const int drow = 256 * (c / 128) + 128 * half + (c % 128);
            tr_item(ap->in[28] + (size_t)l * 1024 * 5632, 5632, 1024, 64 * kb, n0, l ? WF1I : WF0I, 1024, drow, 0, ap->in[4] + l * 1024, scr, lane); continue; } r -= 2 * I_FI;
        if (r < 2 * I_FO) { const int l = r / I_FO; r -= l * I_FO; const int kb = r / 32, nb = r % 32;
            tr_item(ap->in[31] + (size_t)l * 2816 * 1024, 1024, 2816, 64 * kb, 32 * nb, l ? WF1O : WF0O, 2816, 32 * nb, 0, nullptr, scr, lane); continue; } r -= 2 * I_FO;
        if (r < 3 * I_SQ) { const int m3 = r / I_SQ; r -= m3 * I_SQ; const int kb = r / 32, nb = r % 32;
            tr_item(ap->in[11 + m3], 1024, 1024, 64 * kb, 32 * nb, WRW1, 1024, m3 * 1024 + 32 * nb, 0, nullptr, scr, lane); continue; } r -= 3 * I_SQ;
        if (r < 4 * I_L64) { const int d = r / (2 * I_L64); r -= d * 2 * I_L64; const int half = r / I_L64; r -= half * I_L64; const int kb = r / 2, nb = r % 2;
            tr_item(ap->in[16] + (size_t)d * 1024 * 64, 64, 1024, 64 * kb, 32 * nb, WLORA, 2048, d * 64 + 32 * nb, half * 1024, half ? mu + 1 * 1024 : nullptr, scr, lane, mu); continue; } r -= 4 * I_L64;
        if (r < 4 * I_L64) { const int d = r / (2 * I_L64); r -= d * 2 * I_L64; const int half = r / I_L64; r -= half * I_L64; const int kb = r / 2, nb = r % 2;
            tr_item(ap->in[19] + (size_t)d * 1024 * 64, 64, 1024, 64 * kb, 32 * nb, WLORA, 2048, 128 + d * 64 + 32 * nb, half * 1024, half ? mu + 4 * 1024 : nullptr, scr, lane, mu); continue; } r -= 4 * I_L64;
        if (r < 2 * I_G1) { const int half = r / I_G1; r -= half * I_G1; const int kb = r / 5, nb = r % 5;
            tr_item(ap->in[21], 160, 1024, 64 * kb, 32 * nb, WLORA, 2048, 256 + 32 * nb, half * 1024, half ? mu + 5 * 1024 : nullptr, scr, lane, mu); continue; } r -= 2 * I_G1;
        if (r < I_SQ) { const int kb = r / 32, nb = r % 32; tr_item(ap->in[14], 1024, 1024, 64 * kb, 32 * nb, WRWO, 1024, 32 * nb, 0, nullptr, scr, lane); continue; } r -= I_SQ;
        { const int kb = r / 32, nb = r % 32; tr_item(ap->in[22], 1024, 160, 64 * kb, 32 * nb, WG2, 256, 32 * nb, 0, nullptr, scr, lane); }
    }
    {
        const int gt = blockIdx.x * 512 + tid, NGT = gdim * 512;
        for (int i = gt; i < 96 * 256; i += NGT) { const int rr = i >> 8, cc = i & 255;
            unsigned zz = 0u; asm volatile("" : "+v"(zz)); *(u32x4_t*)(WLORA + (size_t)(416 + rr) * 2048 + cc * 8) = (u32x4_t){zz, zz, zz, zz}; }
    }
    bf16* HB = (bf16*)(dob + DO_HB); float* ssq0 = (float*)(ap->ws + WS_SSQ);
    for (int r = gw; r < TROWS; r += NGW) {
        int o, tokbase; bool pad = false;
        if (r < 8256) { o = r; tokbase = 16384; } else if (r < 16512) { o = r - 8256; tokbase = 24576; } else if (r < 16640) { pad = true; o = 0; tokbase = 0; }
        else if (r < 33088) { o = r - 16640; tokbase = 0; } else { pad = true; o = 0; tokbase = 0; }
        if (o < 48) pad = true;
        const float* src = nullptr;
        if (!pad) { if (o < 64) src = ap->in[2] + (size_t)(o - 48) * 1024; else { const int g = tokbase + o - 64; src = (g < 16384) ? ap->in[0] + (size_t)g * 1024 : ap->in[1] + (size_t)(g - 16384) * 1024; } }
        float s = 0.f;
#pragma unroll
        for (int j = 0; j < 4; ++j) { f32x4_t v = (f32x4_t){0.f, 0.f, 0.f, 0.f}; if (src) v = *(const f32x4_t*)(src + 4 * lane + 256 * j);
            s += v[0] * v[0] + v[1] * v[1] + v[2] * v[2] + v[3] * v[3];
            u32x2_t w; w.x = pk2(v[0], v[1]); w.y = pk2(v[2], v[3]); *(u32x2_t*)(HB + (size_t)r * 1024 + 4 * lane + 256 * j) = w; }
        s = wave_sum(s); if (lane == 0) ssq0[r] = s;
    }
}

#define XB_TMO      128
#define XB_XCNT(j)  (256  + 64 * (j))
#define XB_XSUB(j)  (1280 + 64 * (j))
#define XB_XGEN(j)  (2304 + 64 * (j))
#define XB_TOP      3328
#define XB_TOPGEN   3392
#define XCD_BAR_WORDS 3456
#define XB_SPIN_CAP (1u << 18)

__device__ __forceinline__ unsigned xb_ld(unsigned* p)              { return __hip_atomic_load(p, __ATOMIC_RELAXED, __HIP_MEMORY_SCOPE_AGENT); }
__device__ __forceinline__ unsigned xb_add(unsigned* p, unsigned v) { return __hip_atomic_fetch_add(p, v, __ATOMIC_RELAXED, __HIP_MEMORY_SCOPE_AGENT); }
__device__ __forceinline__ unsigned xb_xcc_id() { return (unsigned)__builtin_amdgcn_s_getreg((3 << 11) | 20) & 0xFu; }
#define XB_SPIN(cond, bar) do { unsigned _sp = 0; while (cond) { __builtin_amdgcn_s_sleep(1); \
    if ((++_sp & 255u) == 0u) { if (xb_ld(&(bar)[XB_TMO])) break; if (_sp > XB_SPIN_CAP) { atomicAdd(&(bar)[XB_TMO], 1u); break; } } } } while (0)

struct XcdBarrier {
    unsigned* bar; unsigned x;
    volatile LAS unsigned* st;
};

__device__ __forceinline__ XcdBarrier xcd_barrier_post(unsigned* bar, volatile LAS unsigned* st) {
    XcdBarrier b; b.bar = bar; b.x = xb_xcc_id(); b.st = st;
    if (threadIdx.x == 0) (void)xb_add(&bar[XB_XCNT(b.x)], 1u);
    return b;
}
__device__ __forceinline__ void xcd_barrier_complete(unsigned* bar, unsigned x, unsigned& nloc, unsigned& nx) {
    const unsigned G = gridDim.x * gridDim.y * gridDim.z;
    unsigned sum, cnt, mine, sp = 0u;
    for (;;) {
        sum = 0u; cnt = 0u; mine = 0u;
#pragma unroll
        for (unsigned j = 0; j < 16; ++j) { const unsigned c = xb_ld(&bar[XB_XCNT(j)]); sum += c; cnt += (c > 0u) ? 1u : 0u; mine = (j == x) ? c : mine; }
        if (sum == G) break;
        __builtin_amdgcn_s_sleep(1);
        if ((++sp & 255u) == 0u) { if (xb_ld(&bar[XB_TMO])) break; if (sp > XB_SPIN_CAP) { atomicAdd(&bar[XB_TMO], 1u); break; } }
    }
    nloc = mine > 0u ? mine : 1u; nx = cnt > 0u ? cnt : 1u;
}

__device__ __forceinline__ void xcd_barrier(const XcdBarrier& b, int tid_) {
    asm volatile("s_waitcnt vmcnt(0)" ::: "memory");
    __syncthreads();
    if (tid_ == 0) {
        unsigned* bar = b.bar;
        __builtin_amdgcn_s_waitcnt(0);
        unsigned nloc = b.st[0], nx = b.st[1];
        if (nloc == 0u) { xcd_barrier_complete(bar, b.x, nloc, nx); b.st[0] = nloc; b.st[1] = nx; }
        const unsigned old = xb_add(&bar[XB_XSUB(b.x)], 1u);
        const unsigned gen = old / nloc;
        if (old + 1u == (gen + 1u) * nloc) {
            __builtin_amdgcn_fence(__ATOMIC_RELEASE, "agent");
            asm volatile("s_waitcnt vmcnt(0)" ::: "memory");
            const unsigned og = xb_add(&bar[XB_TOP], 1u);
            const unsigned tg = og / nx;
            if (og + 1u == (tg + 1u) * nx) xb_add(&bar[XB_TOPGEN], 1u);
            else XB_SPIN(xb_ld(&bar[XB_TOPGEN]) == tg, bar);
            __builtin_amdgcn_fence(__ATOMIC_ACQUIRE, "agent");
            xb_add(&bar[XB_XGEN(b.x)], 1u);
            asm volatile("s_waitcnt vmcnt(0)" ::: "memory");
        } else {
            XB_SPIN(xb_ld(&bar[XB_XGEN(b.x)]) == gen, bar);
            __builtin_amdgcn_fence(__ATOMIC_ACQUIRE, "agent");
            asm volatile("s_waitcnt vmcnt(0)" ::: "memory");
        }
    }
    __syncthreads();
}

template <class Epi, bool ALIGN>
__device__ __forceinline__ void run_gemm(unsigned char* lds, const bf16* A, const bf16* Bt, int nM, int nN, int K, int a_tile_rows, const Epi& E, int tid) {
    asm volatile("" : "+s"(K));
    pg8::Gemm g{A, Bt, nM * 256, nN * 256, K, a_tile_rows, K, 0u, 0u}; pg8::StaticOrder S; S.init(nM * 256, nN * 256, (int)gridDim.x, (int)blockIdx.x);
    pg8::gemm_phase<Epi, pg8::StaticOrder, ALIGN, true>((PG8_LAS unsigned char*)lds, g, S, E, tid);
}
template <class Epi>
__device__ __forceinline__ void run_gemm_list(unsigned char* lds, const bf16* A, const bf16* Bt, int K, int lda, unsigned a_off1, unsigned a_off2, const pg8::BalOrder& S, const Epi& E, int tid) {
    asm volatile("" : "+s"(K));
    pg8::Gemm g{A, Bt, 0, 0, K, 256, lda, a_off1, a_off2};
    pg8::gemm_phase<Epi, pg8::BalOrder, true, true>((PG8_LAS unsigned char*)lds, g, S, E, tid);
}

template <bool PA>
__device__ __forceinline__ void hgrn_scan(unsigned char* lds, const bf16* Q, const bf16* FFb, const bf16* FBb, const bf16* Ib, bf16* OFb, bf16* OBb, const float* lbp, float* segm, int slab, int tid) {
    const int lane = tid & 63, wave = tid >> 6, r16 = lane & 15, kq = lane >> 4;
    bf16* qin = (bf16*)lds;
    bf16* kin = qin + 64 * 136;
    bf16* kinT = kin + 64 * 136;
    bf16* Pm = kinT + 128 * 72;
    bf16* iT = Pm + 64 * 72;
    bf16* SbT = iT + 128 * 72;
    float* tot = (float*)(SbT + 128 * 136);
    float* c1 = tot + 512; float* c2 = c1 + 128; float* gtv = c2 + 128;
    const int G = slab == 0 ? 8 : 16, nch = slab == 0 ? 129 : 257;
    const int c = tid & 127, seg = tid >> 7;
    const int jr = tid >> 3, part = tid & 7;
    for (int item = blockIdx.x; item < 256; item += gridDim.x) {
        const int g = item % G, strm = item / G; const int p0 = g == 0 ? 0 : 1 + 16 * g, p1 = 17 + 16 * g;
        if (PA && g == G - 1) continue;
        const int dir = strm & 1, head = (strm >> 1) & 7, sq = strm >> 4;
        const int seqbase = sq * 8256;
        const bf16* Fp = dir ? FBb : FFb; bf16* Op = dir ? OBb : OFb;
        const int hc = head * 128 + c;
        const float l0 = lbp[hc], l1 = lbp[1024 + hc]; const float lb = 1.0f / (1.0f + __expf(l1 - l0));
        f32x4_t S[8];
#pragma unroll
        for (int vt = 0; vt < 8; ++vt) S[vt] = (f32x4_t){0.f, 0.f, 0.f, 0.f};
        float gprod = 1.f;
        float* myPsi = segm + (size_t)item * 16512; float* myG = myPsi + 16384;
        if (!PA) {
            for (int gg = 0; gg < g; ++gg) { const float* Psi = segm + (size_t)(strm * G + gg) * 16512; const float* Gv = Psi + 16384;
#pragma unroll
                for (int e = 0; e < 4; ++e) { const int kr = 16 * wave + 4 * kq + e; const float gk = Gv[kr];
#pragma unroll
                    for (int vt = 0; vt < 8; ++vt) S[vt][e] = gk * S[vt][e] + Psi[kr * 128 + 16 * vt + r16]; } }
        }
        unsigned short qraw[16], fraw[16];
        { const int cbase = seqbase + (dir ? nch - 1 - p0 : p0) * 64;
#pragma unroll
          for (int jj = 0; jj < 16; ++jj) { const int j = 16 * seg + jj; const size_t row = cbase + (dir ? 63 - j : j); qraw[jj] = PA ? (unsigned short)0 : Q[row * 1024 + hc]; fraw[jj] = Fp[row * 1024 + hc]; } }
        __syncthreads();
        for (int p = p0; p < p1; ++p) {
            const int cidx = dir ? nch - 1 - p : p; const int cbase = seqbase + cidx * 64;
            float bl[16], kvv[16], qv[16]; float run = 1.f;
#pragma unroll
            for (int jj = 0; jj < 16; ++jj) { const float f = bf2f(fraw[jj]); const float fg = lb + (1.0f - lb) * sigmoidf_(f); run *= fg; bl[jj] = run; kvv[jj] = 1.0f - fg; qv[jj] = bf2f(qraw[jj]); }
            tot[seg * 128 + c] = run;
            { const size_t row = cbase + (dir ? 63 - jr : jr);
              const u32x4_t w0 = *(const u32x4_t*)(Ib + row * 1024 + head * 128 + part * 16), w1 = *(const u32x4_t*)(Ib + row * 1024 + head * 128 + part * 16 + 8);
              const unsigned wa[8] = {w0.x, w0.y, w0.z, w0.w, w1.x, w1.y, w1.z, w1.w};
#pragma unroll
              for (int q = 0; q < 8; ++q) { iT[(part * 16 + 2 * q) * 72 + jr] = (bf16)(wa[q] & 0xffff); iT[(part * 16 + 2 * q + 1) * 72 + jr] = (bf16)(wa[q] >> 16); } }
            if (p + 1 < p1) { const int nb = seqbase + (dir ? nch - 2 - p : p + 1) * 64;
#pragma unroll
                for (int jj = 0; jj < 16; ++jj) { const int j = 16 * seg + jj; const size_t row = nb + (dir ? 63 - j : j); qraw[jj] = PA ? (unsigned short)0 : Q[row * 1024 + hc]; fraw[jj] = Fp[row * 1024 + hc]; } }
            __syncthreads();
            const float t0 = tot[c], t1 = tot[128 + c], t2 = tot[256 + c], t3 = tot[384 + c];
            const float off = seg == 0 ? 1.f : (seg == 1 ? t0 : (seg == 2 ? t0 * t1 : t0 * t1 * t2));
            const float aref = t0 * t1, alast = (t0 * t1) * (t2 * t3); const float iaref = __builtin_amdgcn_rcpf(aref);
#pragma unroll
            for (int jj = 0; jj < 16; ++jj) { const int j = 16 * seg + jj; const float at = off * bl[jj];
                const float ke = kvv[jj] * (aref * __builtin_amdgcn_rcpf(at)); const bf16 kb = (bf16)f2bf(ke); kinT[c * 72 + j] = kb;
                if (!PA) { const float qe = qv[jj] * (at * iaref); qin[j * 136 + c] = (bf16)f2bf(qe); kin[j * 136 + c] = kb; } }
            if (seg == 0) { c1[c] = aref; c2[c] = alast * iaref; gtv[c] = alast; gprod *= alast; }
            __syncthreads();
            if (!PA) {
                { const int cc = 16 * wave + 4 * kq; const float s0 = c1[cc], s1 = c1[cc + 1], s2 = c1[cc + 2], s3 = c1[cc + 3];
#pragma unroll
                  for (int vt = 0; vt < 8; ++vt) { u32x2_t w; w.x = pk2(s0 * S[vt][0], s1 * S[vt][1]); w.y = pk2(s2 * S[vt][2], s3 * S[vt][3]); *(u32x2_t*)(SbT + (16 * vt + r16) * 136 + cc) = w; } }
                { const int tt = wave >> 1;
#pragma unroll
                  for (int si = 0; si < 2; ++si) { const int ss = 2 * (wave & 1) + si; f32x4_t ac = (f32x4_t){0.f, 0.f, 0.f, 0.f};
#pragma unroll
                      for (int kk = 0; kk < 4; ++kk) { const bf16x8_t av = *(const bf16x8_t*)(qin + (16 * tt + r16) * 136 + 32 * kk + 8 * kq); const bf16x8_t bv = *(const bf16x8_t*)(kin + (16 * ss + r16) * 136 + 32 * kk + 8 * kq);
                          ac = __builtin_amdgcn_mfma_f32_16x16x32_bf16(av, bv, ac, 0, 0, 0); }
#pragma unroll
                      for (int e = 0; e < 4; ++e) { const int t = 16 * tt + 4 * kq + e, s = 16 * ss + r16; Pm[t * 72 + s] = (bf16)f2bf(s <= t ? ac[e] : 0.f); } } }
                __syncthreads();
            }
            f32x4_t kv[8];
            { const bf16x8_t a0 = *(const bf16x8_t*)(kinT + (16 * wave + r16) * 72 + 8 * kq), a1 = *(const bf16x8_t*)(kinT + (16 * wave + r16) * 72 + 32 + 8 * kq);
#pragma unroll
              for (int vt = 0; vt < 8; ++vt) { kv[vt] = (f32x4_t){0.f, 0.f, 0.f, 0.f};
                  kv[vt] = __builtin_amdgcn_mfma_f32_16x16x32_bf16(a0, *(const bf16x8_t*)(iT + (16 * vt + r16) * 72 + 8 * kq), kv[vt], 0, 0, 0);
                  kv[vt] = __builtin_amdgcn_mfma_f32_16x16x32_bf16(a1, *(const bf16x8_t*)(iT + (16 * vt + r16) * 72 + 32 + 8 * kq), kv[vt], 0, 0, 0); } }
            if (!PA) { const int tt = wave & 3;
#pragma unroll
                for (int vi = 0; vi < 4; ++vi) { const int vt = 4 * (wave >> 2) + vi; f32x4_t o = (f32x4_t){0.f, 0.f, 0.f, 0.f};
#pragma unroll
                    for (int kk = 0; kk < 2; ++kk) o = __builtin_amdgcn_mfma_f32_16x16x32_bf16(*(const bf16x8_t*)(Pm + (16 * tt + r16) * 72 + 32 * kk + 8 * kq), *(const bf16x8_t*)(iT + (16 * vt + r16) * 72 + 32 * kk + 8 * kq), o, 0, 0, 0);
#pragma unroll
                    for (int kk = 0; kk < 4; ++kk) o = __builtin_amdgcn_mfma_f32_16x16x32_bf16(*(const bf16x8_t*)(qin + (16 * tt + r16) * 136 + 32 * kk + 8 * kq), *(const bf16x8_t*)(SbT + (16 * vt + r16) * 136 + 32 * kk + 8 * kq), o, 0, 0, 0);
#pragma unroll
                    for (int e = 0; e < 4; ++e) kin[(16 * tt + 4 * kq + e) * 136 + 16 * vt + r16] = (bf16)f2bf(o[e]); } }
            { const int cc = 16 * wave + 4 * kq;
#pragma unroll
              for (int e = 0; e < 4; ++e) { const float ge = gtv[cc + e], ce = c2[cc + e];
#pragma unroll
                  for (int vt = 0; vt < 8; ++vt) S[vt][e] = ge * S[vt][e] + ce * kv[vt][e]; } }
            __syncthreads();
            if (!PA) { const size_t row = cbase + (dir ? 63 - jr : jr);
                *(u32x4_t*)(Op + row * 1024 + head * 128 + part * 16) = *(const u32x4_t*)(kin + jr * 136 + part * 16);
                *(u32x4_t*)(Op + row * 1024 + head * 128 + part * 16 + 8) = *(const u32x4_t*)(kin + jr * 136 + part * 16 + 8); }
        }
        if (PA) {
#pragma unroll
            for (int e = 0; e < 4; ++e) { const int kr = 16 * wave + 4 * kq + e;
#pragma unroll
                for (int vt = 0; vt < 8; ++vt) myPsi[kr * 128 + 16 * vt + r16] = S[vt][e]; }
            if (seg == 0) myG[c] = gprod;
        }
    }
}

__device__ __forceinline__ void hgrn_gate(const bf16* OFb, const bf16* OBb, bf16* G, const float* onorm, int tid) {
    const int lane = tid & 63, wave = tid >> 6; const int gw = blockIdx.x * 8 + wave, NGW = gridDim.x * 8;
    for (int r = gw; r < SLAB; r += NGW) {
        const size_t off = (size_t)r * 1024 + 16 * lane;
        float o[16], g[16]; float ss = 0.f;
#pragma unroll
        for (int h = 0; h < 2; ++h) { const u32x4_t a = *(const u32x4_t*)(OFb + off + 8 * h), b = *(const u32x4_t*)(OBb + off + 8 * h), gg = *(const u32x4_t*)(G + off + 8 * h);
            const unsigned aw[4] = {a.x, a.y, a.z, a.w}, bw[4] = {b.x, b.y, b.z, b.w}, gw4[4] = {gg.x, gg.y, gg.z, gg.w};
#pragma unroll
            for (int q = 0; q < 4; ++q) { o[8 * h + 2 * q] = __uint_as_float(aw[q] << 16) + __uint_as_float(bw[q] << 16); o[8 * h + 2 * q + 1] = __uint_as_float(aw[q] & 0xffff0000u) + __uint_as_float(bw[q] & 0xffff0000u);
                g[8 * h + 2 * q] = __uint_as_float(gw4[q] << 16); g[8 * h + 2 * q + 1] = __uint_as_float(gw4[q] & 0xffff0000u); } }
#pragma unroll
        for (int i = 0; i < 16; ++i) ss += o[i] * o[i];
        ss += __shfl_xor(ss, 1); ss += __shfl_xor(ss, 2); ss += __shfl_xor(ss, 4);
        const float rs = rsqrtf(ss * (1.0f / 128.0f) + NEPS);
        float res[16];
#pragma unroll
        for (int i = 0; i < 16; ++i) res[i] = o[i] * rs * onorm[16 * lane + i] * g[i];
#pragma unroll
        for (int h = 0; h < 2; ++h) { u32x4_t w; w.x = pk2(res[8 * h], res[8 * h + 1]); w.y = pk2(res[8 * h + 2], res[8 * h + 3]); w.z = pk2(res[8 * h + 4], res[8 * h + 5]); w.w = pk2(res[8 * h + 6], res[8 * h + 7]);
            *(u32x4_t*)(G + off + 8 * h) = w; }
    }
}

__device__ __forceinline__ void rwkv_mix(const bf16* HB, const float* ssq, const float* gain, const float* mu, bf16* P0, bf16* P1, int row0, int tid) {
    const int lane = tid & 63, wave = tid >> 6; const int gw = blockIdx.x * 8 + wave, NGW = gridDim.x * 8;
    for (int lr = gw; lr < SLAB; lr += NGW) {
        const int r = row0 + lr; const bool pad = row_is_pad(r);
        const float rs = rsqrtf(pg8::row_ssq16(ssq, r) * (1.0f / 1024.0f) + NEPS);
        const float rsm = (r > 0) ? rsqrtf(pg8::row_ssq16(ssq, r - 1) * (1.0f / 1024.0f) + NEPS) : 0.f;
        const float rsp = (r < TROWS - 1) ? rsqrtf(pg8::row_ssq16(ssq, r + 1) * (1.0f / 1024.0f) + NEPS) : 0.f;
#pragma unroll
        for (int h = 0; h < 2; ++h) { const int col = 16 * lane + 8 * h; const size_t off = (size_t)r * 1024 + col;
            u32x4_t a = *(const u32x4_t*)(HB + off), am = (u32x4_t){0u, 0u, 0u, 0u}, ap = (u32x4_t){0u, 0u, 0u, 0u};
            if (r > 0) am = *(const u32x4_t*)(HB + off - 1024);
            if (r < TROWS - 1) ap = *(const u32x4_t*)(HB + off + 1024);
            const unsigned aw[4] = {a.x, a.y, a.z, a.w}, mw[4] = {am.x, am.y, am.z, am.w}, pw[4] = {ap.x, ap.y, ap.z, ap.w};
            float xr[8], xk[8], xv[8], xx[8];
            const f32x4_t ga = *(const f32x4_t*)(gain + col), gb = *(const f32x4_t*)(gain + col + 4);
            const f32x4_t ra = *(const f32x4_t*)(mu + col), rb = *(const f32x4_t*)(mu + col + 4), ka = *(const f32x4_t*)(mu + 2048 + col), kb = *(const f32x4_t*)(mu + 2048 + col + 4), va = *(const f32x4_t*)(mu + 3072 + col), vb = *(const f32x4_t*)(mu + 3072 + col + 4);
            const float keep = pad ? 0.f : 1.f;
#pragma unroll
            for (int q = 0; q < 4; ++q) {
#pragma unroll
                for (int hh = 0; hh < 2; ++hh) { const int i8 = 2 * q + hh; const float g0 = (i8 < 4 ? ga[i8 & 3] : gb[i8 & 3]) * keep;
                    const float mr = i8 < 4 ? ra[i8 & 3] : rb[i8 & 3], mk = i8 < 4 ? ka[i8 & 3] : kb[i8 & 3], mv = i8 < 4 ? va[i8 & 3] : vb[i8 & 3];
                    const float x0 = (hh ? __uint_as_float(aw[q] & 0xffff0000u) : __uint_as_float(aw[q] << 16)) * rs * g0;
                    const float m0 = (hh ? __uint_as_float(mw[q] & 0xffff0000u) : __uint_as_float(mw[q] << 16)) * rsm * g0;
                    const float p0 = (hh ? __uint_as_float(pw[q] & 0xffff0000u) : __uint_as_float(pw[q] << 16)) * rsp * g0;
                    const float d0 = 0.5f * (m0 + p0) - x0;
                    xx[i8] = d0; xr[i8] = x0 + d0 * mr; xk[i8] = x0 + d0 * mk; xv[i8] = x0 + d0 * mv; } }
            u32x4_t w; w.x = pk2(xr[0], xr[1]); w.y = pk2(xr[2], xr[3]); w.z = pk2(xr[4], xr[5]); w.w = pk2(xr[6], xr[7]);
            *(u32x4_t*)(P0 + (size_t)lr * 2048 + col) = w;
            w.x = pk2(xx[0], xx[1]); w.y = pk2(xx[2], xx[3]); w.z = pk2(xx[4], xx[5]); w.w = pk2(xx[6], xx[7]);
            *(u32x4_t*)(P0 + (size_t)lr * 2048 + 1024 + col) = w;
            w.x = pk2(xk[0], xk[1]); w.y = pk2(xk[2], xk[3]); w.z = pk2(xk[4], xk[5]); w.w = pk2(xk[6], xk[7]);
            *(u32x4_t*)(P1 + (size_t)lr * 2048 + col) = w;
            w.x = pk2(xv[0], xv[1]); w.y = pk2(xv[2], xv[3]); w.z = pk2(xv[4], xv[5]); w.w = pk2(xv[6], xv[7]);
            *(u32x4_t*)(P1 + (size_t)lr * 2048 + 1024 + col) = w; }
    }
}

__device__ __forceinline__ void rwkv_scan_seq(unsigned char* lds, const bf16* Rb, const bf16* Kb, const bf16* Vb, const bf16* HWb, const bf16* HAb, bf16* OFb, bf16* OBb, float* beta,
                                              ArgP a, int slab, int tid) {
    float* w2s = (float*)lds; float* a2s = w2s + 4096; float* rS = a2s + 4096; float* kdS = rS + 4096; float* vS = kdS + 4096; float* wS = vS + 4096; float* kkS = wS + 4096; float* kkaS = kkS + 4096;
    const int nitems = (slab == 0 ? 2 : 1) * 32, nch = slab == 0 ? 129 : 257;
    const int j = tid >> 3, part = tid & 7, c8 = part * 8;
    for (int item = blockIdx.x; item < nitems; item += gridDim.x) {
        const int d = item & 1, head = (item >> 1) & 15, sq = item >> 5; const int seqbase = sq * 8256; const int hc8 = head * 64 + c8;
        bf16* Op = d ? OBb : OFb;
        const float* w0 = a->in[15] + d * 1024; const float* w2 = a->in[17] + (size_t)d * 64 * 1024; const float* a0 = a->in[18] + d * 1024; const float* a2 = a->in[20] + (size_t)d * 64 * 1024;
        const float* pkk = a->in[23]; const float* pka = a->in[24]; const float* prk = a->in[25];
        __syncthreads();
        for (int i = tid; i < 4096; i += 512) { const int l = i >> 6, cc = i & 63; w2s[i] = w2[(size_t)l * 1024 + head * 64 + cc]; a2s[i] = a2[(size_t)l * 1024 + head * 64 + cc]; }
        float s[8];
#pragma unroll
        for (int e = 0; e < 8; ++e) s[e] = 0.f;
        __syncthreads();
        for (int p = 0; p < nch; ++p) {
            const int cidx = d ? nch - 1 - p : p; const int cbase = seqbase + cidx * 64;
            const size_t row = cbase + (d ? 63 - j : j);
            asm volatile("" ::: "memory");
            float w0c[8], a0c[8];
#pragma unroll
            for (int e = 0; e < 8; ++e) { w0c[e] = w0[hc8 + e]; a0c[e] = a0[hc8 + e]; }
            const u32x4_t rw = *(const u32x4_t*)(Rb + row * 1024 + hc8), kw = *(const u32x4_t*)(Kb + row * 1024 + hc8), vw = *(const u32x4_t*)(Vb + row * 1024 + hc8);
            const unsigned rwa[4] = {rw.x, rw.y, rw.z, rw.w}, kwa[4] = {kw.x, kw.y, kw.z, kw.w}, vwa[4] = {vw.x, vw.y, vw.z, vw.w};
            float rv[8], kv[8], vv[8], z[8], aa[8];
#pragma unroll
            for (int q = 0; q < 4; ++q) { rv[2 * q] = __uint_as_float(rwa[q] << 16); rv[2 * q + 1] = __uint_as_float(rwa[q] & 0xffff0000u); kv[2 * q] = __uint_as_float(kwa[q] << 16); kv[2 * q + 1] = __uint_as_float(kwa[q] & 0xffff0000u);
                vv[2 * q] = __uint_as_float(vwa[q] << 16); vv[2 * q + 1] = __uint_as_float(vwa[q] & 0xffff0000u); }
#pragma unroll
            for (int e = 0; e < 8; ++e) { z[e] = w0c[e]; aa[e] = a0c[e]; }
#pragma unroll 1
            for (int l8 = 0; l8 < 8; ++l8) { const u32x4_t hw = *(const u32x4_t*)(HWb + row * 128 + d * 64 + 8 * l8), ha = *(const u32x4_t*)(HAb + row * 128 + d * 64 + 8 * l8);
                const unsigned hwa[4] = {hw.x, hw.y, hw.z, hw.w}, haa[4] = {ha.x, ha.y, ha.z, ha.w};
#pragma unroll
                for (int q = 0; q < 4; ++q) {
#pragma unroll
                    for (int hh = 0; hh < 2; ++hh) { const int l = 8 * l8 + 2 * q + hh; const float hwv = hh ? __uint_as_float(hwa[q] & 0xffff0000u) : __uint_as_float(hwa[q] << 16); const float hav = hh ? __uint_as_float(haa[q] & 0xffff0000u) : __uint_as_float(haa[q] << 16);
                        const f32x4_t wa = *(const f32x4_t*)(w2s + l * 64 + c8), wb = *(const f32x4_t*)(w2s + l * 64 + c8 + 4), xa = *(const f32x4_t*)(a2s + l * 64 + c8), xb = *(const f32x4_t*)(a2s + l * 64 + c8 + 4);
#pragma unroll
                        for (int e = 0; e < 4; ++e) { z[e] += hwv * wa[e]; z[4 + e] += hwv * wb[e]; aa[e] += hav * xa[e]; aa[4 + e] += hav * xb[e]; }
                        if (hh) asm volatile("" ::: "memory"); } } }
            asm volatile("" ::: "memory");
            float kkc[8], kac[8], rkc[8];
#pragma unroll
            for (int e = 0; e < 8; ++e) { kkc[e] = pkk[hc8 + e]; kac[e] = pka[hc8 + e]; rkc[e] = prk[hc8 + e]; }
            float kk[8], ss = 0.f, bsum = 0.f;
#pragma unroll
            for (int e = 0; e < 8; ++e) { kk[e] = kv[e] * kkc[e]; ss += kk[e] * kk[e]; }
            ss += __shfl_xor(ss, 1); ss += __shfl_xor(ss, 2); ss += __shfl_xor(ss, 4);
            const float inv = rsqrtf(fmaxf(ss, 1e-24f));
#pragma unroll
            for (int e = 0; e < 8; ++e) { const float av = sigmoidf_(aa[e]); const float wv = __expf(-0.6065306597f * sigmoidf_(z[e])); const float kd = kv[e] * (1.0f + (av - 1.0f) * kac[e]); const float kkn = kk[e] * inv;
                bsum += rv[e] * kd * rkc[e];
                rS[j * 64 + c8 + e] = rv[e]; kdS[j * 64 + c8 + e] = kd; vS[j * 64 + c8 + e] = vv[e]; wS[j * 64 + c8 + e] = wv; kkS[j * 64 + c8 + e] = kkn; kkaS[j * 64 + c8 + e] = kkn * av; }
            bsum += __shfl_xor(bsum, 1); bsum += __shfl_xor(bsum, 2); bsum += __shfl_xor(bsum, 4);
            if (part == 0) beta[((size_t)d * SLAB + row) * 16 + head] = bsum;
            __syncthreads();
#pragma unroll 1
            for (int st = 0; st < 64; ++st) {
                const f32x4_t k0 = *(const f32x4_t*)(kkS + st * 64 + c8), k1 = *(const f32x4_t*)(kkS + st * 64 + c8 + 4);
                const f32x4_t wv0 = *(const f32x4_t*)(wS + st * 64 + c8), wv1 = *(const f32x4_t*)(wS + st * 64 + c8 + 4);
                const f32x4_t ka0 = *(const f32x4_t*)(kkaS + st * 64 + c8), ka1 = *(const f32x4_t*)(kkaS + st * 64 + c8 + 4);
                const f32x4_t kd0 = *(const f32x4_t*)(kdS + st * 64 + c8), kd1 = *(const f32x4_t*)(kdS + st * 64 + c8 + 4);
                const f32x4_t r0 = *(const f32x4_t*)(rS + st * 64 + c8), r1 = *(const f32x4_t*)(rS + st * 64 + c8 + 4);
                const float vi = vS[st * 64 + j];
                float sa = 0.f;
#pragma unroll
                for (int e = 0; e < 4; ++e) sa += s[e] * k0[e] + s[4 + e] * k1[e];
                sa += __shfl_xor(sa, 1); sa += __shfl_xor(sa, 2); sa += __shfl_xor(sa, 4);
                float y = 0.f;
#pragma unroll
                for (int e = 0; e < 4; ++e) { s[e] = s[e] * wv0[e] - sa * ka0[e] + vi * kd0[e]; s[4 + e] = s[4 + e] * wv1[e] - sa * ka1[e] + vi * kd1[e]; y += s[e] * r0[e] + s[4 + e] * r1[e]; }
                y += __shfl_xor(y, 1); y += __shfl_xor(y, 2); y += __shfl_xor(y, 4);
                if (part == 0) { const size_t orow = cbase + (d ? 63 - st : st); Op[orow * 1024 + head * 64 + j] = (bf16)f2bf(y); }
            }
            __syncthreads();
        }
    }
}

__device__ __forceinline__ void mm2(f32x4_t (&acc)[2], const bf16* A, const bf16* Bt, int mt, int ntb, int r16, int kq) {
#pragma unroll
    for (int kk = 0; kk < 2; ++kk) { const bf16x8_t av = *(const bf16x8_t*)(A + (16 * mt + r16) * 72 + 32 * kk + 8 * kq);
#pragma unroll
        for (int i = 0; i < 2; ++i) { const bf16x8_t bv = *(const bf16x8_t*)(Bt + (16 * (ntb + i) + r16) * 72 + 32 * kk + 8 * kq); acc[i] = __builtin_amdgcn_mfma_f32_16x16x32_bf16(av, bv, acc[i], 0, 0, 0); } }
}
__device__ __forceinline__ void st_rm(bf16* dst, const f32x4_t (&acc)[2], int mt, int ntb, int r16, int kq) {
#pragma unroll
    for (int i = 0; i < 2; ++i) { const unsigned w0 = pk2(acc[i][0], acc[i][1]), w1 = pk2(acc[i][2], acc[i][3]); bf16* d = dst + (16 * mt + 4 * kq) * 72 + 16 * (ntb + i) + r16;
        d[0] = (bf16)(w0 & 0xffffu); d[72] = (bf16)(w0 >> 16); d[144] = (bf16)(w1 & 0xffffu); d[216] = (bf16)(w1 >> 16); }
}
__device__ __forceinline__ void st_tr(bf16* dst, const f32x4_t (&acc)[2], int mt, int ntb, int r16, int kq) {
#pragma unroll
    for (int i = 0; i < 2; ++i) { u32x2_t w; w.x = pk2(acc[i][0], acc[i][1]); w.y = pk2(acc[i][2], acc[i][3]); *(u32x2_t*)(dst + (16 * (ntb + i) + r16) * 72 + 16 * mt + 4 * kq) = w; }
}
template <bool PA>
__device__ __forceinline__ void rwkv_scan_chunk(unsigned char* lds, const bf16* Rb, const bf16* Kb, const bf16* Vb, const bf16* HWb, const bf16* HAb, bf16* OFb, bf16* OBb, float* beta, float* segm, bf16* tbuf,
                                                ArgP a, int slab, int tid) {
    bf16* M = (bf16*)lds;
#define MAT(i) (M + (i) * 4608)
    bf16* w2T = MAT(13); bf16* a2T = MAT(14); float* wc = (float*)MAT(15); float* cst = wc + 64;
    float* zbuf = (float*)MAT(0); float* abuf = zbuf + 4096;
    float* cumb = (float*)MAT(10); float* segtot = cumb + 4096;
    const int nch = slab == 0 ? 129 : 257, G = slab == 0 ? 4 : 8, nitems = 256, NCHA = nch;
    const int lane = tid & 63, wave = tid >> 6, r16 = lane & 15, kq = lane >> 4, mt = wave >> 1, ntb = 2 * (wave & 1);
    const int j = tid >> 3, part = tid & 7, c8 = part * 8;
    const int tunit = ((j >> 3) + 1) * (4 * (j >> 3) + (j & 7)) + part; const bool tlow = part <= (j >> 3);
    for (int item = blockIdx.x; item < nitems; item += gridDim.x) {
        const int g = item % G, strm = item / G; const int p0 = g == 0 ? 0 : 1 + 32 * g, p1 = 33 + 32 * g;
        const bool haveT = !PA;
        const int d = strm & 1, head = (strm >> 1) & 15, sq = strm >> 5; const int seqbase = sq * 8256; const int hc8 = head * 64 + c8;
        bf16* Op = d ? OBb : OFb;
        const float* w0 = a->in[15] + d * 1024; const float* w2 = a->in[17] + (size_t)d * 64 * 1024; const float* a0 = a->in[18] + d * 1024; const float* a2 = a->in[20] + (size_t)d * 64 * 1024;
        __syncthreads();
        if (tid < 320) { const int wch = tid >> 6, cc = tid & 63; const float* src = wch == 0 ? w0 : (wch == 1 ? a0 : (wch == 2 ? a->in[23] : (wch == 3 ? a->in[24] : a->in[25]))); cst[tid] = src[head * 64 + cc]; }
        for (int i = tid; i < 4096; i += 512) { const int l = i >> 6, cc = i & 63; w2T[cc * 72 + l] = (bf16)f2bf(w2[(size_t)l * 1024 + head * 64 + cc]); a2T[cc * 72 + l] = (bf16)f2bf(a2[(size_t)l * 1024 + head * 64 + cc]); }
        f32x4_t Sacc[2], S2acc[2]; Sacc[0] = (f32x4_t){0.f, 0.f, 0.f, 0.f}; Sacc[1] = Sacc[0];
#pragma unroll
        for (int i = 0; i < 2; ++i)
#pragma unroll
            for (int e = 0; e < 4; ++e) S2acc[i][e] = (16 * mt + 4 * kq + e == 16 * (ntb + i) + r16) ? 1.f : 0.f;
        __syncthreads();
        if (!PA) {
            for (int gg = 0; gg < g; ++gg) {
                const float* Psi = segm + (size_t)(strm * G + gg) * 8192; const float* Phi = Psi + 4096;
                { const f32x4_t q0 = *(const f32x4_t*)(Phi + j * 64 + c8), q1 = *(const f32x4_t*)(Phi + j * 64 + c8 + 4);
#pragma unroll
                  for (int e = 0; e < 4; ++e) { MAT(1)[(c8 + e) * 72 + j] = (bf16)f2bf(q0[e]); MAT(1)[(c8 + 4 + e) * 72 + j] = (bf16)f2bf(q1[e]); } }
                st_rm(MAT(0), Sacc, mt, ntb, r16, kq);
                __syncthreads();
#pragma unroll
                for (int i = 0; i < 2; ++i)
#pragma unroll
                    for (int e = 0; e < 4; ++e) Sacc[i][e] = Psi[(16 * mt + 4 * kq + e) * 64 + 16 * (ntb + i) + r16];
                mm2(Sacc, MAT(0), MAT(1), mt, ntb, r16, kq);
                __syncthreads();
            }
        }
        for (int p = p0; p < p1; ++p) {
            const int cidx = d ? nch - 1 - p : p; const int cbase = seqbase + cidx * 64;
            float rv[8], kk[8], av[8], kd[8], lw[8]; u32x4_t tld = (u32x4_t){0u, 0u, 0u, 0u}, vraw = (u32x4_t){0u, 0u, 0u, 0u};
            {
                const size_t row = cbase + (d ? 63 - j : j);
                asm volatile("" ::: "memory");
                if (haveT && tlow) tld = *(const u32x4_t*)(tbuf + ((size_t)strm * NCHA + p) * 2304 + tunit * 8);
                *(u32x4_t*)(MAT(4) + j * 72 + c8) = *(const u32x4_t*)(HWb + row * 128 + d * 64 + c8);
                *(u32x4_t*)(MAT(5) + j * 72 + c8) = *(const u32x4_t*)(HAb + row * 128 + d * 64 + c8);
                const u32x4_t rw = *(const u32x4_t*)(Rb + row * 1024 + hc8), kw = *(const u32x4_t*)(Kb + row * 1024 + hc8), vw = *(const u32x4_t*)(Vb + row * 1024 + hc8);
                __syncthreads();
                { f32x4_t za[2], xa[2]; za[0] = (f32x4_t){0.f, 0.f, 0.f, 0.f}; za[1] = za[0]; xa[0] = za[0]; xa[1] = za[0];
                  mm2(za, MAT(4), w2T, mt, ntb, r16, kq); mm2(xa, MAT(5), a2T, mt, ntb, r16, kq);
#pragma unroll
                  for (int i = 0; i < 2; ++i)
#pragma unroll
                      for (int e = 0; e < 4; ++e) { zbuf[(16 * mt + 4 * kq + e) * 64 + 16 * (ntb + i) + r16] = za[i][e]; abuf[(16 * mt + 4 * kq + e) * 64 + 16 * (ntb + i) + r16] = xa[i][e]; } }
                __syncthreads();
                const unsigned rwa[4] = {rw.x, rw.y, rw.z, rw.w}, kwa[4] = {kw.x, kw.y, kw.z, kw.w};
                float kv[8], z[8], aa[8];
#pragma unroll
                for (int q = 0; q < 4; ++q) { rv[2 * q] = __uint_as_float(rwa[q] << 16); rv[2 * q + 1] = __uint_as_float(rwa[q] & 0xffff0000u); kv[2 * q] = __uint_as_float(kwa[q] << 16); kv[2 * q + 1] = __uint_as_float(kwa[q] & 0xffff0000u);
                }
                vraw = vw;
                { const f32x4_t z0 = *(const f32x4_t*)(zbuf + j * 64 + c8), z1 = *(const f32x4_t*)(zbuf + j * 64 + c8 + 4), x0 = *(const f32x4_t*)(abuf + j * 64 + c8), x1 = *(const f32x4_t*)(abuf + j * 64 + c8 + 4);
#pragma unroll
                  for (int e = 0; e < 4; ++e) { z[e] = cst[c8 + e] + z0[e]; z[4 + e] = cst[c8 + 4 + e] + z1[e]; aa[e] = cst[64 + c8 + e] + x0[e]; aa[4 + e] = cst[64 + c8 + 4 + e] + x1[e]; } }
                asm volatile("" ::: "memory");
                float ss = 0.f, bsum = 0.f;
#pragma unroll
                for (int e = 0; e < 8; ++e) { kk[e] = kv[e] * cst[128 + c8 + e]; ss += kk[e] * kk[e]; }
                ss += __shfl_xor(ss, 1); ss += __shfl_xor(ss, 2); ss += __shfl_xor(ss, 4);
                const float inv = rsqrtf(fmaxf(ss, 1e-24f));
#pragma unroll
                for (int e = 0; e < 8; ++e) { av[e] = sigmoidf_(aa[e]); lw[e] = -0.6065306597f * sigmoidf_(z[e]); kd[e] = kv[e] * (1.0f + (av[e] - 1.0f) * cst[192 + c8 + e]); kk[e] *= inv; bsum += rv[e] * kd[e] * cst[256 + c8 + e]; }
                bsum += __shfl_xor(bsum, 1); bsum += __shfl_xor(bsum, 2); bsum += __shfl_xor(bsum, 4);
                if (!PA && part == 0) beta[((size_t)d * SLAB + row) * 16 + head] = bsum;
                *(f32x4_t*)(cumb + j * 64 + c8) = (f32x4_t){lw[0], lw[1], lw[2], lw[3]}; *(f32x4_t*)(cumb + j * 64 + c8 + 4) = (f32x4_t){lw[4], lw[5], lw[6], lw[7]};
            }
            __syncthreads();
            { const int c = tid & 63, sg = tid >> 6; float run = 0.f;
#pragma unroll
              for (int i = 0; i < 8; ++i) { run += cumb[(8 * sg + i) * 64 + c]; cumb[(8 * sg + i) * 64 + c] = run; }
              segtot[sg * 64 + c] = run; }
            __syncthreads();
            { const int c = tid & 63, sg = tid >> 6; float off = 0.f;
#pragma unroll
              for (int s = 0; s < 7; ++s) off += (s < sg) ? segtot[s * 64 + c] : 0.f;
#pragma unroll
              for (int i = 0; i < 8; ++i) cumb[(8 * sg + i) * 64 + c] += off; }
            __syncthreads();
            {
                const f32x4_t c0 = *(const f32x4_t*)(cumb + j * 64 + c8), c1 = *(const f32x4_t*)(cumb + j * 64 + c8 + 4);
                float ah[8], bh[8], kh[8], rh[8];
#pragma unroll
                for (int e = 0; e < 8; ++e) { const float cu = e < 4 ? c0[e & 3] : c1[e & 3]; const float Wt = __expf(cu), iW = __expf(-cu), Wm1 = __expf(cu - lw[e]);
                    ah[e] = kk[e] * Wm1; bh[e] = -(kk[e] * av[e]) * iW; kh[e] = kd[e] * iW; rh[e] = rv[e] * Wt;
                    if (j == 63) wc[c8 + e] = Wt; }
                u32x4_t w;
                w.x = pk2(ah[0], ah[1]); w.y = pk2(ah[2], ah[3]); w.z = pk2(ah[4], ah[5]); w.w = pk2(ah[6], ah[7]); *(u32x4_t*)(MAT(0) + j * 72 + c8) = w;
                u32x4_t wb, wk;
                wb.x = pk2(bh[0], bh[1]); wb.y = pk2(bh[2], bh[3]); wb.z = pk2(bh[4], bh[5]); wb.w = pk2(bh[6], bh[7]); *(u32x4_t*)(MAT(1) + j * 72 + c8) = wb;
                wk.x = pk2(kh[0], kh[1]); wk.y = pk2(kh[2], kh[3]); wk.z = pk2(kh[4], kh[5]); wk.w = pk2(kh[6], kh[7]); *(u32x4_t*)(MAT(2) + j * 72 + c8) = wk;
                w.x = pk2(rh[0], rh[1]); w.y = pk2(rh[2], rh[3]); w.z = pk2(rh[4], rh[5]); w.w = pk2(rh[6], rh[7]); *(u32x4_t*)(MAT(3) + j * 72 + c8) = w;
                { const unsigned wba[4] = {wb.x, wb.y, wb.z, wb.w}, wka[4] = {wk.x, wk.y, wk.z, wk.w}, wva[4] = {vraw.x, vraw.y, vraw.z, vraw.w};
#pragma unroll
                  for (int q = 0; q < 4; ++q) { bf16* d4 = MAT(4) + (c8 + 2 * q) * 72 + j; bf16* d5 = MAT(5) + (c8 + 2 * q) * 72 + j; bf16* d6 = MAT(6) + (c8 + 2 * q) * 72 + j;
                      d4[0] = (bf16)(wba[q] & 0xffffu); d4[72] = (bf16)(wba[q] >> 16); d5[0] = (bf16)(wka[q] & 0xffffu); d5[72] = (bf16)(wka[q] >> 16); d6[0] = (bf16)(wva[q] & 0xffffu); d6[72] = (bf16)(wva[q] >> 16); } }
                if (haveT) *(u32x4_t*)(MAT(9) + j * 72 + c8) = tld;
                st_rm(MAT(7), Sacc, mt, ntb, r16, kq);
                if (PA) st_rm(MAT(12), S2acc, mt, ntb, r16, kq);
            }
            __syncthreads();
            f32x4_t Pacc[2], Tacc[2], Xacc[2], Yacc[2], tmp[2];
            const f32x4_t z4 = (f32x4_t){0.f, 0.f, 0.f, 0.f};
            Tacc[0] = z4; Tacc[1] = z4;
            if (!haveT) {
            Pacc[0] = z4; Pacc[1] = z4; mm2(Pacc, MAT(0), MAT(1), mt, ntb, r16, kq);
#pragma unroll
            for (int i = 0; i < 2; ++i)
#pragma unroll
                for (int e = 0; e < 4; ++e) { const int t = 16 * mt + 4 * kq + e, s = 16 * (ntb + i) + r16; Pacc[i][e] = (s < t) ? Pacc[i][e] : 0.f; Tacc[i][e] = Pacc[i][e] + ((s == t) ? 1.f : 0.f); }
            st_rm(MAT(8), Pacc, mt, ntb, r16, kq); st_tr(MAT(9), Pacc, mt, ntb, r16, kq);
            }
            tmp[0] = z4; tmp[1] = z4; mm2(tmp, MAT(0), MAT(2), mt, ntb, r16, kq);
#pragma unroll
            for (int i = 0; i < 2; ++i)
#pragma unroll
                for (int e = 0; e < 4; ++e) { const int t = 16 * mt + 4 * kq + e, s = 16 * (ntb + i) + r16; tmp[i][e] = (s < t) ? tmp[i][e] : 0.f; }
            st_rm(MAT(10), tmp, mt, ntb, r16, kq);
            f32x4_t X2acc[2]; X2acc[0] = z4; X2acc[1] = z4;
            if (PA) mm2(X2acc, MAT(0), MAT(12), mt, ntb, r16, kq);
            if (!PA) {
            tmp[0] = z4; tmp[1] = z4; mm2(tmp, MAT(3), MAT(1), mt, ntb, r16, kq);
#pragma unroll
            for (int i = 0; i < 2; ++i)
#pragma unroll
                for (int e = 0; e < 4; ++e) { const int t = 16 * mt + 4 * kq + e, s = 16 * (ntb + i) + r16; tmp[i][e] = (s <= t) ? tmp[i][e] : 0.f; }
            st_rm(MAT(11), tmp, mt, ntb, r16, kq);
            tmp[0] = z4; tmp[1] = z4; mm2(tmp, MAT(3), MAT(2), mt, ntb, r16, kq);
#pragma unroll
            for (int i = 0; i < 2; ++i)
#pragma unroll
                for (int e = 0; e < 4; ++e) { const int t = 16 * mt + 4 * kq + e, s = 16 * (ntb + i) + r16; tmp[i][e] = (s <= t) ? tmp[i][e] : 0.f; }
            st_rm(MAT(12), tmp, mt, ntb, r16, kq);
            }
            Xacc[0] = z4; Xacc[1] = z4; mm2(Xacc, MAT(0), MAT(7), mt, ntb, r16, kq);
            Yacc[0] = z4; Yacc[1] = z4; if (!PA) mm2(Yacc, MAT(3), MAT(7), mt, ntb, r16, kq);
            __syncthreads();
            if (!haveT) {
            tmp[0] = z4; tmp[1] = z4; mm2(tmp, MAT(8), MAT(9), mt, ntb, r16, kq);
            st_rm(MAT(0), tmp, mt, ntb, r16, kq); st_tr(MAT(1), tmp, mt, ntb, r16, kq); st_rm(MAT(2), Tacc, mt, ntb, r16, kq);
            __syncthreads();
#pragma unroll
            for (int i = 1; i <= 5; ++i) {
                bf16* Pc = (i & 1) ? MAT(0) : MAT(8); bf16* PcT = (i & 1) ? MAT(1) : MAT(9); bf16* Pn = (i & 1) ? MAT(8) : MAT(0); bf16* PnT = (i & 1) ? MAT(9) : MAT(1);
                bf16* Tc = (i & 1) ? MAT(2) : MAT(3); bf16* Tn = (i & 1) ? MAT(3) : MAT(2);
                mm2(Tacc, Tc, PcT, mt, ntb, r16, kq);
                if (i < 5) { tmp[0] = z4; tmp[1] = z4; mm2(tmp, Pc, PcT, mt, ntb, r16, kq); st_rm(Pn, tmp, mt, ntb, r16, kq); st_tr(PnT, tmp, mt, ntb, r16, kq); }
                st_rm(Tn, Tacc, mt, ntb, r16, kq);
                __syncthreads();
            }
            }
            if (PA && tlow) *(u32x4_t*)(tbuf + ((size_t)strm * NCHA + p) * 2304 + tunit * 8) = *(const u32x4_t*)(MAT(3) + j * 72 + c8);
            const bf16* Tm = haveT ? MAT(9) : MAT(3);
            mm2(Xacc, MAT(10), MAT(6), mt, ntb, r16, kq);
            st_tr(MAT(7), Xacc, mt, ntb, r16, kq);
            if (PA) st_tr(MAT(11), X2acc, mt, ntb, r16, kq);
            __syncthreads();
            tmp[0] = z4; tmp[1] = z4; mm2(tmp, Tm, MAT(7), mt, ntb, r16, kq);
            st_tr(MAT(8), tmp, mt, ntb, r16, kq);
            if (PA) { tmp[0] = z4; tmp[1] = z4; mm2(tmp, MAT(3), MAT(11), mt, ntb, r16, kq); st_tr(MAT(12), tmp, mt, ntb, r16, kq); }
            __syncthreads();
            if (!PA) { mm2(Yacc, MAT(11), MAT(8), mt, ntb, r16, kq); mm2(Yacc, MAT(12), MAT(6), mt, ntb, r16, kq);
            st_rm(MAT(7), Yacc, mt, ntb, r16, kq); }
            if (PA) mm2(S2acc, MAT(12), MAT(4), mt, ntb, r16, kq);
            mm2(Sacc, MAT(8), MAT(4), mt, ntb, r16, kq); mm2(Sacc, MAT(6), MAT(5), mt, ntb, r16, kq);
#pragma unroll
            for (int i = 0; i < 2; ++i) { const float wk = wc[16 * (ntb + i) + r16];
#pragma unroll
                for (int e = 0; e < 4; ++e) { Sacc[i][e] *= wk; S2acc[i][e] *= wk; } }
            __syncthreads();
            if (!PA) { const size_t orow = cbase + (d ? 63 - j : j); *(u32x4_t*)(Op + orow * 1024 + hc8) = *(const u32x4_t*)(MAT(7) + j * 72 + c8); }
        }
        if (PA) { float* Psi = segm + (size_t)item * 8192; float* Phi = Psi + 4096;
#pragma unroll
            for (int i = 0; i < 2; ++i)
#pragma unroll
                for (int e = 0; e < 4; ++e) { Psi[(16 * mt + 4 * kq + e) * 64 + 16 * (ntb + i) + r16] = Sacc[i][e]; Phi[(16 * mt + 4 * kq + e) * 64 + 16 * (ntb + i) + r16] = S2acc[i][e]; } }
    }
#undef MAT
}

__device__ __forceinline__ void rwkv_gn(bf16* OFb, const bf16* OBb, const bf16* Vb, const float* beta, const float* gnw, const float* gnb, int tid) {
    const int lane = tid & 63, wave = tid >> 6; const int gw = blockIdx.x * 8 + wave, NGW = gridDim.x * 8;
    for (int r = gw; r < SLAB; r += NGW) {
        const size_t off = (size_t)r * 1024 + 16 * lane; const int head = lane >> 2;
        float y[16], v[16]; float sm = 0.f;
#pragma unroll
        for (int h = 0; h < 2; ++h) { const u32x4_t a = *(const u32x4_t*)(OFb + off + 8 * h), b = *(const u32x4_t*)(OBb + off + 8 * h), vv = *(const u32x4_t*)(Vb + off + 8 * h);
            const unsigned aw[4] = {a.x, a.y, a.z, a.w}, bw[4] = {b.x, b.y, b.z, b.w}, vw[4] = {vv.x, vv.y, vv.z, vv.w};
#pragma unroll
            for (int q = 0; q < 4; ++q) { y[8 * h + 2 * q] = __uint_as_float(aw[q] << 16) + __uint_as_float(bw[q] << 16); y[8 * h + 2 * q + 1] = __uint_as_float(aw[q] & 0xffff0000u) + __uint_as_float(bw[q] & 0xffff0000u);
                v[8 * h + 2 * q] = __uint_as_float(vw[q] << 16); v[8 * h + 2 * q + 1] = __uint_as_float(vw[q] & 0xffff0000u); } }
#pragma unroll
        for (int i = 0; i < 16; ++i) sm += y[i];
        sm += __shfl_xor(sm, 1); sm += __shfl_xor(sm, 2);
        const float mean = sm * (1.0f / 64.0f); float sv = 0.f;
#pragma unroll
        for (int i = 0; i < 16; ++i) { const float dd = y[i] - mean; sv += dd * dd; }
        sv += __shfl_xor(sv, 1); sv += __shfl_xor(sv, 2);
        const float rs = rsqrtf(sv * (1.0f / 64.0f) + 64e-5f);
        const float bt = beta[(size_t)r * 16 + head] + beta[((size_t)SLAB + r) * 16 + head];
        float res[16];
#pragma unroll
        for (int i = 0; i < 16; ++i) res[i] = (y[i] - mean) * rs * gnw[16 * lane + i] + gnb[16 * lane + i] + bt * v[i];
#pragma unroll
        for (int h = 0; h < 2; ++h) { u32x4_t w; w.x = pk2(res[8 * h], res[8 * h + 1]); w.y = pk2(res[8 * h + 2], res[8 * h + 3]); w.z = pk2(res[8 * h + 4], res[8 * h + 5]); w.w = pk2(res[8 * h + 6], res[8 * h + 7]);
            *(u32x4_t*)(OFb + off + 8 * h) = w; }
    }
}

__device__ __forceinline__ void final_norm(const bf16* HBN, const float* ssq, const float* gain, float* out, int tid) {
    const int lane = tid & 63, wave = tid >> 6; const int gw = blockIdx.x * 8 + wave, NGW = gridDim.x * 8;
    for (int g = gw; g < 32768; g += NGW) {
        const int row = (g < 16384) ? 16640 + 64 + g : (g < 24576 ? 64 + (g - 16384) : 8256 + 64 + (g - 24576));
        const float rs = rsqrtf(pg8::row_ssq16(ssq, row) * (1.0f / 1024.0f) + NEPS);
#pragma unroll
        for (int jx = 0; jx < 4; ++jx) { const int col = 4 * lane + 256 * jx; const u32x2_t w = *(const u32x2_t*)(HBN + (size_t)row * 1024 + col); const f32x4_t gg = *(const f32x4_t*)(gain + col);
            f32x4_t o; o[0] = __uint_as_float(w.x << 16) * rs * gg[0]; o[1] = __uint_as_float(w.x & 0xffff0000u) * rs * gg[1]; o[2] = __uint_as_float(w.y << 16) * rs * gg[2]; o[3] = __uint_as_float(w.y & 0xffff0000u) * rs * gg[3];
            *(f32x4_t*)(out + (size_t)g * 1024 + col) = o; }
    }
}

#ifndef PHM
#define PHM 4095
#endif
__global__ void __launch_bounds__(512, 2) fwd_mega(Args a_) {
    ArgP ap0 = (ArgP)__builtin_amdgcn_kernarg_segment_ptr();
    extern __shared__ __attribute__((aligned(16))) unsigned char lds[];
    cg::grid_group grid = cg::this_grid();
    PG8_LAS float* edge = (PG8_LAS float*)((PG8_LAS unsigned char*)lds + RING_BYTES);
    volatile LAS unsigned* bst = (volatile LAS unsigned*)((LAS unsigned char*)lds + LDS_BYTES - 16);
    const int wave_s = __builtin_amdgcn_readfirstlane(threadIdx.x >> 6);
    if (threadIdx.x < 4) bst[threadIdx.x] = 0u;
    __syncthreads();
    XcdBarrier xbar = xcd_barrier_post((unsigned*)(ap0->ws + WS_BAR), bst);
    grid.sync();
#pragma unroll 1
    for (int phc = 0; phc < 30; ++phc) {
        int ph = phc; asm volatile("" : "+s"(ph));
        int kind = 15, slab = 0;
        if (ph == 0) kind = 0;
        else if (ph <= 10) { const int q = (ph - 1) % 5; slab = (ph - 1) / 5; kind = q == 0 ? 1 : (q == 1 ? 14 : (q == 2 ? 2 : (q == 3 ? 3 : 4))); }
        else if (ph == 11) kind = 5; else if (ph == 12) kind = 6;
        else if (ph <= 26) { kind = 7 + (ph - 13) % 7; slab = (ph - 13) / 7; }
        else if (ph == 27) { kind = 5; slab = 1; } else if (ph == 28) { kind = 6; slab = 1; }
        ArgP ap = LAUNDER_ARGS(ap0);
        unsigned char* dob = (unsigned char*)ap->out; unsigned char* ws = ap->ws;
        bf16* HB = (bf16*)(dob + DO_HB); float* ssq = (float*)(ws + WS_SSQ); bf16* BIG = (bf16*)(ws + WS_BIG);
        unsigned zl = 0u; asm volatile("" : "+v"(zl));
        const int tid = wave_s * 64 + (int)__builtin_amdgcn_mbcnt_hi(~0u, __builtin_amdgcn_mbcnt_lo(~0u, zl));
        const int row0 = slab * SLAB;
        switch (kind) {
        case 0: if (PHM & 1) p0_prologue(ap, lds, tid); break;
        case 1: { pg8::EpiHgIn E{BIG, ssq + row0};
                  if (PHM & 2) run_gemm<pg8::EpiHgIn, true>(lds, HB + (size_t)row0 * 1024, (const bf16*)(dob + DO_WHG), 65, 20, 1024, 256, E, tid); } break;
        case 2: if (PHM & 4) hgrn_scan<false>(lds, BIG, BIG + SLABE, BIG + 2 * SLABE, BIG + 3 * SLABE, BIG + 5 * SLABE, BIG + 6 * SLABE, ap->in[8], (float*)(ws + WS_HW), slab, tid); break;
        case 14: if (PHM & 4) hgrn_scan<true>(lds, BIG, BIG + SLABE, BIG + 2 * SLABE, BIG + 3 * SLABE, BIG + 5 * SLABE, BIG + 6 * SLABE, ap->in[8], (float*)(ws + WS_HW), slab, tid); break;
        case 3: if (PHM & 8) hgrn_gate(BIG + 5 * SLABE, BIG + 6 * SLABE, BIG + 4 * SLABE, ap->in[9], tid); break;
        case 4: case 6: case 13: {
                  const bf16* A; const bf16* Bt; int nM, K, r0; float* sq; bf16* hout = HB;
                  if (kind == 4) { A = BIG + 4 * SLABE; Bt = (const bf16*)(dob + DO_WHGO); nM = 65; K = 1024; r0 = row0; sq = (float*)(ws + WS_PA); }
                  else if (kind == 13) { A = BIG; Bt = (const bf16*)(dob + DO_WRWO); nM = 65; K = 1024; r0 = row0; sq = (float*)(ws + WS_PA); }
                  else { A = (const bf16*)(ws + WS_ACT); Bt = (const bf16*)(dob + (slab ? DO_WF1O : DO_WF0O)); nM = 130; K = 2816; r0 = 0; sq = (float*)(ws + WS_PB); if (slab) hout = (bf16*)(ws + WS_HBNEW); }
                  pg8::EpiRes E{HB, hout, sq, r0};
                  if (PHM & 16) run_gemm<pg8::EpiRes, true>(lds, A, Bt, nM, 4, K, 256, E, tid); } break;
        case 5: { pg8::EpiFfnIn E{(bf16*)(ws + WS_ACT), (const float*)(ws + WS_PA), ap->in[29] + slab * 3 * FFN, ap->in[30] + slab * FFN, edge};
                  if (PHM & 32) run_gemm<pg8::EpiFfnIn, true>(lds, HB, (const bf16*)(dob + (slab ? DO_WF1I : DO_WF0I)), 131, 22, 1024, 254, E, tid); } break;
        case 7: if (PHM & 64) rwkv_mix(HB, (const float*)(ws + WS_PB), ap->in[3] + 1024, ap->in[10], BIG, BIG + 2 * SLABE, row0, tid); break;
        case 8: {
                  int c = (int)blockIdx.x, gd = (int)gridDim.x; asm volatile("" : "+s"(c), "+s"(gd));
                  { pg8::BalOrder S{65, 2, 130, gd, c, 0};
                    pg8::EpiLora E{(bf16*)(ws + WS_HW), (bf16*)(ws + WS_HA), (bf16*)(ws + WS_HG)};
                    if (PHM & 128) run_gemm_list<pg8::EpiLora>(lds, BIG, (const bf16*)(dob + DO_WLORA), 2048, 2048, 0u, 0u, S, E, tid); }
                  { pg8::BalOrder S{65, 12, 780, gd, c, 1};
                    pg8::EpiRkv E{BIG + 4 * SLABE};
                    if (PHM & 128) run_gemm_list<pg8::EpiRkv>(lds, BIG, (const bf16*)(dob + DO_WRW1), 1024, 2048, (unsigned)(2 * SLABE * 2), (unsigned)(2 * SLABE * 2 + 2048), S, E, tid); } } break;
        case 9: if (PHM & 256) rwkv_scan_chunk<true>(lds, BIG + 4 * SLABE, BIG + 5 * SLABE, BIG + 6 * SLABE, (const bf16*)(ws + WS_HW), (const bf16*)(ws + WS_HA), BIG + 2 * SLABE, BIG + 3 * SLABE, (float*)(ws + WS_BETA), (float*)BIG, (bf16*)((unsigned char*)BIG + 8388608), ap, slab, tid); break;
        case 10: if (PHM & 256) rwkv_scan_chunk<false>(lds, BIG + 4 * SLABE, BIG + 5 * SLABE, BIG + 6 * SLABE, (const bf16*)(ws + WS_HW), (const bf16*)(ws + WS_HA), BIG + 2 * SLABE, BIG + 3 * SLABE, (float*)(ws + WS_BETA), (float*)BIG, (bf16*)((unsigned char*)BIG + 8388608), ap, slab, tid); break;
        case 11: if (PHM & 512) rwkv_gn(BIG + 2 * SLABE, BIG + 3 * SLABE, BIG + 6 * SLABE, (const float*)(ws + WS_BETA), ap->in[26], ap->in[27], tid); break;
        case 12: { pg8::EpiGate E{BIG + 2 * SLABE, BIG};
                  if (PHM & 1024) run_gemm<pg8::EpiGate, true>(lds, (const bf16*)(ws + WS_HG), (const bf16*)(dob + DO_WG2), 65, 4, 256, 256, E, tid); } break;
        default: if (PHM & 2048) final_norm((const bf16*)(ws + WS_HBNEW), (const float*)(ws + WS_PB), ap->in[5], ap->out, tid); break;
        }
        if (phc < 29) { unsigned z2 = 0u; asm volatile("" : "+v"(z2)); const int t2 = wave_s * 64 + (int)__builtin_amdgcn_mbcnt_hi(~0u, __builtin_amdgcn_mbcnt_lo(~0u, z2)); xcd_barrier(xbar, t2); }
    }
}

extern "C" void kernel_launch(void* const* d_in, const int* in_sizes, int n_in, void* d_out, int out_size, void* d_ws, size_t ws_size, hipStream_t stream) {
    static int grid = 0;
    if (grid == 0) {
        if (n_in != 32 || ws_size < WS_NEED || out_size != 32768 * 1024) { fprintf(stderr, "kernel_launch: unexpected shapes (n_in %d, ws %zu, out %d)\n", n_in, ws_size, out_size); grid = -1; return; }
        int dev = 0, cus = 0, per_cu = 0;
        hipGetDevice(&dev); hipDeviceGetAttribute(&cus, hipDeviceAttributeMultiprocessorCount, dev);
        if (hipFuncSetAttribute((const void*)fwd_mega, hipFuncAttributeMaxDynamicSharedMemorySize, LDS_BYTES) != hipSuccess) { fprintf(stderr, "kernel_launch: hipFuncSetAttribute failed\n"); grid = -1; return; }
        if (hipOccupancyMaxActiveBlocksPerMultiprocessor(&per_cu, (const void*)fwd_mega, 512, LDS_BYTES) != hipSuccess || per_cu < 1) { fprintf(stderr, "kernel_launch: occupancy query says %d\n", per_cu); per_cu = 1; }
        (void)hipGetLastError();
        grid = cus;
    }
    if (grid < 0) return;
    if (hipMemsetAsync((char*)d_ws + WS_BAR, 0, 16384, stream) != hipSuccess) { fprintf(stderr, "kernel_launch: memset failed\n"); return; }
    Args a{};
    for (int i = 0; i < 32; ++i) a.in[i] = (const float*)d_in[i];
    a.out = (float*)d_out; a.ws = (unsigned char*)d_ws;
    void* args[] = {&a};
    hipError_t e = hipLaunchCooperativeKernel((const void*)fwd_mega, dim3(grid), dim3(512), args, LDS_BYTES, stream);
    if (e != hipSuccess) fprintf(stderr, "kernel_launch: cooperative launch failed: %s (grid %d)\n", hipGetErrorString(e), grid);
}
```

```cpp
#include <hip/hip_runtime.h>
#include <hip/hip_cooperative_groups.h>
#include <cstdio>
#include <cstdint>
namespace cg = cooperative_groups;

constexpr int D_ = 1024, FFN = 2816, TROWS = 33280, SLAB = 16640;
constexpr size_t SLABE = (size_t)SLAB * 1024;
constexpr float NEPS = 1e-6f;
__host__ __device__ __forceinline__ bool row_is_pad(int r) {
    int o;
    if (r < 8256) o = r; else if (r < 16512) o = r - 8256; else if (r < 16640) return true; else if (r < 33088) o = r - 16640; else return true;
    return o < 48;
}
__device__ __forceinline__ float bf2f(unsigned short v) { return __uint_as_float(((unsigned)v) << 16); }
typedef float f32x2_cv __attribute__((ext_vector_type(2)));
typedef __bf16 bf16x2_cv __attribute__((ext_vector_type(2)));
__device__ __forceinline__ unsigned pk2(float lo, float hi) { const f32x2_cv v = {lo, hi}; const bf16x2_cv b = __builtin_convertvector(v, bf16x2_cv); return __builtin_bit_cast(unsigned, b); }
__device__ __forceinline__ unsigned f2bf(float f) { return pk2(f, 0.f) & 0xffffu; }
__device__ __forceinline__ float sigmoidf_(float x) { return __builtin_amdgcn_rcpf(1.0f + __expf(-x)); }
namespace pg8 {
#define PG8_LAS __attribute__((address_space(3)))
typedef unsigned short bf16_t;
typedef short bf16x8 __attribute__((ext_vector_type(8)));
typedef float f32x4 __attribute__((ext_vector_type(4)));
typedef unsigned u32x4 __attribute__((ext_vector_type(4)));
constexpr int BM = 256, BK = 64, HALF = 128, HTB = HALF * BK * 2  , STAGE_BYTES = 8 * HTB, NXCD = 8, WGM = 8;

__host__ __device__ __forceinline__ int lds_byte(int r, int c) { const int st = (r >> 4) * 2 + (c >> 5), rr = r & 15, cc = c & 31, ob = rr * 64 + cc * 2; return st * 1024 + (ob ^ (((ob >> 9) & 1) << 5)); }
__host__ __device__ __forceinline__ void stage_rc(int b, int& R, int& C) { const int st = b / 1024, sb = b % 1024, swz = sb ^ (((sb >> 9) & 1) << 5); R = (st >> 1) * 16 + swz / 64; C = (st & 1) * 32 + (swz % 64) / 2; }
__host__ __device__ __forceinline__ int perm32(int rho) { const int n = rho >> 4, i = rho & 15; return 8 * (i >> 2) + 4 * n + (i & 3); }

struct Unit { int pm, pn; };
struct Gemm { const bf16_t* A; const bf16_t* Bt; int M, N, K, a_tile_rows, lda; unsigned a_off1, a_off2; };
__device__ __forceinline__ size_t a_unit_off(const Gemm& g, int pn) { return pn >= 8 ? (size_t)g.a_off2 : (pn >= 4 ? (size_t)g.a_off1 : (size_t)0); }

struct StaticOrder {
    int nM, nN, nwg, G, c;
    __host__ __device__ void init(int M, int N, int G_, int c_) { nM = M / BM; nN = N / BM; nwg = nM * nN; G = G_; c = c_; }
    __host__ __device__ bool next(int i, Unit& u) const {
        const long L = (long)i * G + c; if (L >= nwg) return false;
        int wgid = (int)L; { const int q = nwg / NXCD, r = nwg % NXCD, xcd = wgid % NXCD, off = wgid / NXCD; wgid = (xcd < r ? xcd * (q + 1) : r * (q + 1) + (xcd - r) * q) + off; }
        const int nig = WGM * nN, gid = wgid / nig, fm = gid * WGM, gsz = (nM - fm) < WGM ? (nM - fm) : WGM;
        u.pm = fm + ((wgid % nig) % gsz); u.pn = (wgid % nig) / gsz; return true;
    }
    __device__ __forceinline__ void a_ready(const Unit&) const {}
    __device__ __forceinline__ void done(const Unit&) const {}
};

struct BalOrder {
    int nM, nN, nwg, G, c, mode;
    __device__ bool next(int i, Unit& u) const {
        long L;
        if (G != 256) { L = (long)i * G + c; }
        else if (mode == 0) { if (i > 0 || c >= 130) return false; L = c; }
        else { if (i < 2) L = 256 * i + c; else { if (c < 130) return false; const int h = c - 130; if (i == 2) L = 512 + h; else if (i == 3) L = 638 + h; else if (i == 4 && h < 16) L = 764 + h; else return false; } }
        if (L >= nwg) return false;
        int wgid = (int)L; { const int q = nwg / NXCD, r = nwg % NXCD, xcd = wgid % NXCD, off = wgid / NXCD; wgid = (xcd < r ? xcd * (q + 1) : r * (q + 1) + (xcd - r) * q) + off; }
        const int nig = WGM * nN, gid = wgid / nig, fm = gid * WGM, gsz = (nM - fm) < WGM ? (nM - fm) : WGM;
        u.pm = fm + ((wgid % nig) % gsz); u.pn = (wgid % nig) / gsz; return true;
    }
    __device__ __forceinline__ void a_ready(const Unit&) const {}
    __device__ __forceinline__ void done(const Unit&) const {}
};

__device__ __forceinline__ unsigned cvt_pk_bf16(float lo, float hi) { return pk2(lo, hi); }
typedef float f32x2 __attribute__((ext_vector_type(2)));
__device__ __forceinline__ f32x2 gelu_pk(f32x2 v) {
    const f32x2 av = __builtin_elementwise_abs(v), d = av * 0.2316418882f + 1.0f;
    f32x2 t; t.x = __builtin_amdgcn_rcpf(d.x); t.y = __builtin_amdgcn_rcpf(d.y);
    f32x2 q = t * 0.5307027145f + (-0.7265760135f); q = q * t + 0.7107068705f; q = q * t + (-0.142248368f); q = q * t + 0.127414796f; q = q * t;
    const f32x2 s = (v * v) * (-0.72134752044f);
    f32x2 e; e.x = __builtin_amdgcn_exp2f(s.x); e.y = __builtin_amdgcn_exp2f(s.y);
    const f32x2 m = v * (q * e), r = v - m;
    f32x2 o; o.x = v.x < 0.f ? m.x : r.x; o.y = v.y < 0.f ? m.y : r.y; return o;
}


typedef unsigned u32x2 __attribute__((ext_vector_type(2)));
__device__ __forceinline__ u32x4 pack8(const f32x4 a, const f32x4 b) { u32x4 w; w.x = cvt_pk_bf16(a[0], a[1]); w.y = cvt_pk_bf16(a[2], a[3]); w.z = cvt_pk_bf16(b[0], b[1]); w.w = cvt_pk_bf16(b[2], b[3]); return w; }
__device__ __forceinline__ float silu_(float v) { return v * __builtin_amdgcn_rcpf(1.0f + __expf(-v)); }
__device__ __forceinline__ float gelu_tanh_(float x) { const float y = 1.5957691216f * (x + 0.044715f * x * x * x); return x * __builtin_amdgcn_rcpf(1.0f + __expf(-y)); }

__device__ __forceinline__ float row_ssq16(const float* part, int row) { const f32x4* p = (const f32x4*)(part + (size_t)row * 16); const f32x4 a = p[0], b = p[1], c = p[2], d = p[3];
    return (((a[0] + a[1]) + (a[2] + a[3])) + ((b[0] + b[1]) + (b[2] + b[3]))) + (((c[0] + c[1]) + (c[2] + c[3])) + ((d[0] + d[1]) + (d[2] + d[3]))); }

struct EpiHgIn {
    static constexpr bool PERM = true, AFTER_DRAIN = false;
    bf16_t* base; const float* ssq;
    __device__ __forceinline__ void operator()(const f32x4 (&acc)[2][2][4][2], const Unit& u, int wr, int wc, int fr, int fq) const {
        const int which = u.pn >> 2; const int colt = (u.pn & 3) * 256 + wc * 32 + 8 * fq;
        bf16_t* dst = base + (size_t)which * SLABE; const bool act = (which == 0) || (which == 4);
#pragma unroll
        for (int ai = 0; ai < 2; ++ai)
#pragma unroll
            for (int m = 0; m < 4; ++m) { const int row = u.pm * 256 + ai * 128 + wr * 64 + m * 16 + fr; const float rs = rsqrtf(ssq[row] * (1.0f / 1024.0f) + NEPS);
#pragma unroll
                for (int bj = 0; bj < 2; ++bj) { f32x4 v0 = acc[ai][bj][m][0] * rs, v1 = acc[ai][bj][m][1] * rs;
                    if (act) {
#pragma unroll
                        for (int e = 0; e < 4; ++e) { v0[e] = silu_(v0[e]); v1[e] = silu_(v1[e]); } }
                    *(u32x4*)(dst + (size_t)row * 1024 + colt + bj * 128) = pack8(v0, v1); } }
    }
};

struct EpiRes {
    static constexpr bool PERM = true, AFTER_DRAIN = false;
    const bf16_t* hin; bf16_t* hout; float* ssq; int row0;
    __device__ __forceinline__ void operator()(const f32x4 (&acc)[2][2][4][2], const Unit& u, int wr, int wc, int fr, int fq) const {
        const int col0 = u.pn * 256 + wc * 32 + 8 * fq;
#pragma unroll
        for (int ai = 0; ai < 2; ++ai)
#pragma unroll
            for (int m = 0; m < 4; ++m) { const int row = row0 + u.pm * 256 + ai * 128 + wr * 64 + m * 16 + fr; const bool pad = row_is_pad(row); float s = 0.f;
#pragma unroll
                for (int bj = 0; bj < 2; ++bj) { const size_t off = (size_t)row * 1024 + col0 + bj * 128; const u32x4 hv = *(const u32x4*)(hin + off);
                    f32x4 v0 = acc[ai][bj][m][0], v1 = acc[ai][bj][m][1];
                    v0[0] += __uint_as_float(hv.x << 16); v0[1] += __uint_as_float(hv.x & 0xffff0000u); v0[2] += __uint_as_float(hv.y << 16); v0[3] += __uint_as_float(hv.y & 0xffff0000u);
                    v1[0] += __uint_as_float(hv.z << 16); v1[1] += __uint_as_float(hv.z & 0xffff0000u); v1[2] += __uint_as_float(hv.w << 16); v1[3] += __uint_as_float(hv.w & 0xffff0000u);
#pragma unroll
                    for (int e = 0; e < 4; ++e) s += v0[e] * v0[e] + v1[e] * v1[e];
                    if (!pad) *(u32x4*)(hout + off) = pack8(v0, v1); }
                s += __shfl_xor(s, 16); s += __shfl_xor(s, 32);
                if (fq == 0) ssq[(size_t)row * 16 + u.pn * 4 + wc] = pad ? 0.f : s;
                if (m & 1) asm volatile("" ::: "memory"); }
    }
};

struct EpiFfnIn {
    static constexpr bool PERM = true, AFTER_DRAIN = false;
    bf16_t* act; const float* ssq; const float* cw; const float* cb; PG8_LAS float* edge;
    __device__ __forceinline__ void operator()(f32x4 (&acc)[2][2][4][2], const Unit& u, int wr, int wc, int fr, int fq) const {
        const int lane = fq * 16 + fr;
        const int rowt = u.pm * 254;
#pragma unroll
        for (int ai = 0; ai < 2; ++ai)
#pragma unroll
            for (int m = 0; m < 4; ++m) { const int row = rowt + ai * 128 + wr * 64 + m * 16 + fr; const f32x4 pv = *(const f32x4*)(ssq + (size_t)row * 16 + 4 * fq); float sq = (pv[0] + pv[1]) + (pv[2] + pv[3]); sq += __shfl_xor(sq, 16); sq += __shfl_xor(sq, 32);
                const float rs = rsqrtf(sq * (1.0f / 1024.0f) + NEPS);
#pragma unroll
                for (int bj = 0; bj < 2; ++bj)
#pragma unroll
                    for (int n = 0; n < 2; ++n) acc[ai][bj][m][n] = acc[ai][bj][m][n] * rs;
                asm volatile("" ::: "memory"); }
        const int colw = wc * 32 + 8 * fq;
        PG8_LAS float* edgeF = edge; PG8_LAS float* edgeL = edge + 512;
#pragma unroll
        for (int ai = 0; ai < 2; ++ai) { const int blk = 2 * ai + wr;
            if (fr == 0) {
#pragma unroll
                for (int n = 0; n < 2; ++n)
#pragma unroll
                    for (int e = 0; e < 4; ++e) edgeF[blk * 128 + colw + 4 * n + e] = acc[ai][0][0][n][e]; }
            if (fr == 15) {
#pragma unroll
                for (int n = 0; n < 2; ++n)
#pragma unroll
                    for (int e = 0; e < 4; ++e) edgeL[blk * 128 + colw + 4 * n + e] = acc[ai][0][3][n][e]; } }
        asm volatile("s_waitcnt lgkmcnt(0)" ::: "memory"); __builtin_amdgcn_s_barrier(); asm volatile("" ::: "memory");
        const int lprev = (lane & 48) | ((fr + 15) & 15), lnext = (lane & 48) | ((fr + 1) & 15);
        const int colg = u.pn * 128 + colw;
        const bool f0 = (fr == 0), f15 = (fr == 15);
#pragma unroll
        for (int ai = 0; ai < 2; ++ai) { const int blk = 2 * ai + wr;
#pragma unroll
            for (int n = 0; n < 2; ++n) {
                const f32x4 w0v = *(const f32x4*)(cw + colg + 4 * n), w1v = *(const f32x4*)(cw + FFN + colg + 4 * n), w2v = *(const f32x4*)(cw + 2 * FFN + colg + 4 * n), cbv = *(const f32x4*)(cb + colg + 4 * n);
                f32x4 res[4];
#pragma unroll
                for (int p = 0; p < 2; ++p) {
                    const f32x2 w0 = {w0v[2 * p], w0v[2 * p + 1]}, w1 = {w1v[2 * p], w1v[2 * p + 1]}, w2 = {w2v[2 * p], w2v[2 * p + 1]}, bb = {cbv[2 * p], cbv[2 * p + 1]};
                    f32x2 c[4], ps[4], ns[4];
#pragma unroll
                    for (int m = 0; m < 4; ++m) { c[m] = (f32x2){acc[ai][0][m][n][2 * p], acc[ai][0][m][n][2 * p + 1]};
                        ps[m] = (f32x2){__shfl(c[m].x, lprev), __shfl(c[m].y, lprev)}; ns[m] = (f32x2){__shfl(c[m].x, lnext), __shfl(c[m].y, lnext)}; }
                    f32x2 pe = {0.f, 0.f}, ne = {0.f, 0.f};
                    if (blk > 0) pe = (f32x2){edgeL[(blk - 1) * 128 + colw + 4 * n + 2 * p], edgeL[(blk - 1) * 128 + colw + 4 * n + 2 * p + 1]};
                    if (blk < 3) ne = (f32x2){edgeF[(blk + 1) * 128 + colw + 4 * n + 2 * p], edgeF[(blk + 1) * 128 + colw + 4 * n + 2 * p + 1]};
#pragma unroll
                    for (int m = 0; m < 4; ++m) {
                        const f32x2 pvm = f0 ? (m == 0 ? pe : ps[m == 0 ? 0 : m - 1]) : ps[m];
                        const f32x2 nvm = f15 ? (m == 3 ? ne : ns[m == 3 ? 3 : m + 1]) : ns[m];
                        f32x2 cu = w1 * c[m] + bb; cu = w0 * pvm + cu; cu = w2 * nvm + cu;
                        f32x2 tq = (cu * cu) * cu; tq = tq * 0.044715f + cu;
                        const f32x2 ea = tq * (-2.3022082f);
                        f32x2 dn; dn.x = __builtin_amdgcn_exp2f(ea.x); dn.y = __builtin_amdgcn_exp2f(ea.y); dn = dn + 1.0f;
                        f32x2 rc; rc.x = __builtin_amdgcn_rcpf(dn.x); rc.y = __builtin_amdgcn_rcpf(dn.y);
                        const f32x2 vv = {acc[ai][1][m][n][2 * p], acc[ai][1][m][n][2 * p + 1]};
                        const f32x2 o = (cu * rc) * vv;
                        res[m][2 * p] = o.x; res[m][2 * p + 1] = o.y; }
                }
#pragma unroll
                for (int m = 0; m < 4; ++m) { const int j = ai * 128 + wr * 64 + m * 16 + fr;
                    u32x2 w; w.x = cvt_pk_bf16(res[m][0], res[m][1]); w.y = cvt_pk_bf16(res[m][2], res[m][3]);
                    if (j >= 1 && j <= 254) *(u32x2*)(act + (size_t)(rowt + j) * FFN + colg + 4 * n) = w; }
                asm volatile("" ::: "memory");
            }
        }
        asm volatile("s_waitcnt lgkmcnt(0)" ::: "memory"); __builtin_amdgcn_s_barrier(); asm volatile("" ::: "memory");
    }
};

struct EpiRkv {
    static constexpr bool PERM = true, AFTER_DRAIN = false;
    bf16_t* base;
    __device__ __forceinline__ void operator()(const f32x4 (&acc)[2][2][4][2], const Unit& u, int wr, int wc, int fr, int fq) const {
        const int colw = wc * 32 + 8 * fq;
        bf16_t* dst0 = base + (size_t)(u.pn >> 2) * SLABE + (u.pn & 3) * 256 + colw;
#pragma unroll
        for (int ai = 0; ai < 2; ++ai)
#pragma unroll
            for (int m = 0; m < 4; ++m) { const int row = u.pm * 256 + ai * 128 + wr * 64 + m * 16 + fr; bf16_t* dst = dst0 + (size_t)row * 1024;
#pragma unroll
                for (int bj = 0; bj < 2; ++bj) *(u32x4*)(dst + bj * 128) = pack8(acc[ai][bj][m][0], acc[ai][bj][m][1]);
                asm volatile("" ::: "memory"); }
    }
};
struct EpiLora {
    static constexpr bool PERM = true, AFTER_DRAIN = false;
    bf16_t* hw; bf16_t* ha; bf16_t* hg;
    __device__ __forceinline__ void operator()(const f32x4 (&acc)[2][2][4][2], const Unit& u, int wr, int wc, int fr, int fq) const {
        const int colw = wc * 32 + 8 * fq;
#pragma unroll
        for (int ai = 0; ai < 2; ++ai)
#pragma unroll
            for (int m = 0; m < 4; ++m) { const int row = u.pm * 256 + ai * 128 + wr * 64 + m * 16 + fr;
                if (u.pn == 0) { f32x4 v0 = acc[ai][0][m][0], v1 = acc[ai][0][m][1];
#pragma unroll
                    for (int e = 0; e < 4; ++e) { v0[e] = 2.0f * __builtin_amdgcn_rcpf(1.0f + __expf(-2.0f * v0[e])) - 1.0f; v1[e] = 2.0f * __builtin_amdgcn_rcpf(1.0f + __expf(-2.0f * v1[e])) - 1.0f; }
                    *(u32x4*)(hw + (size_t)row * 128 + colw) = pack8(v0, v1);
                    *(u32x4*)(ha + (size_t)row * 128 + colw) = pack8(acc[ai][1][m][0], acc[ai][1][m][1]);
                } else {
#pragma unroll
                    for (int bj = 0; bj < 2; ++bj) { f32x4 v0 = acc[ai][bj][m][0], v1 = acc[ai][bj][m][1];
#pragma unroll
                        for (int e = 0; e < 4; ++e) { v0[e] = __builtin_amdgcn_rcpf(1.0f + __expf(-v0[e])); v1[e] = __builtin_amdgcn_rcpf(1.0f + __expf(-v1[e])); }
                        *(u32x4*)(hg + (size_t)row * 256 + bj * 128 + colw) = pack8(v0, v1); } }
                asm volatile("" ::: "memory"); }
    }
};

struct EpiGate {
    static constexpr bool PERM = true, AFTER_DRAIN = false;
    const bf16_t* yb; bf16_t* outb;
    __device__ __forceinline__ void operator()(const f32x4 (&acc)[2][2][4][2], const Unit& u, int wr, int wc, int fr, int fq) const {
        const int col0 = u.pn * 256 + wc * 32 + 8 * fq;
#pragma unroll
        for (int ai = 0; ai < 2; ++ai)
#pragma unroll
            for (int m = 0; m < 4; ++m) { const int row = u.pm * 256 + ai * 128 + wr * 64 + m * 16 + fr;
#pragma unroll
                for (int bj = 0; bj < 2; ++bj) { const size_t off = (size_t)row * 1024 + col0 + bj * 128; const u32x4 hv = *(const u32x4*)(yb + off);
                    f32x4 v0 = acc[ai][bj][m][0], v1 = acc[ai][bj][m][1];
                    v0[0] *= __uint_as_float(hv.x << 16); v0[1] *= __uint_as_float(hv.x & 0xffff0000u); v0[2] *= __uint_as_float(hv.y << 16); v0[3] *= __uint_as_float(hv.y & 0xffff0000u);
                    v1[0] *= __uint_as_float(hv.z << 16); v1[1] *= __uint_as_float(hv.z & 0xffff0000u); v1[2] *= __uint_as_float(hv.w << 16); v1[3] *= __uint_as_float(hv.w & 0xffff0000u);
                    *(u32x4*)(outb + off) = pack8(v0, v1); }
                asm volatile("" ::: "memory"); }
    }
};
template <class Epi, class Sched, bool ALIGN_EPI = false, bool SP2 = false>
__device__ __forceinline__ void gemm_phase(PG8_LAS unsigned char* lds, const Gemm g, const Sched& S, const Epi& E, int tid_in) {
    int tid_l = tid_in;
    const int tid = tid_l, wid = __builtin_amdgcn_readfirstlane(tid >> 6), lane = tid & 63, wr = wid >> 2, wc = wid & 3, fr = lane & 15, fq = lane >> 4;
    const int K = g.K, nt = K / BK;
    unsigned voffA[2], voffB[2];
#pragma unroll
    for (int i = 0; i < 2; ++i) { int R, C; stage_rc(tid * 16 + i * 8192, R, C); const int Rb = Epi::PERM ? ((R & ~31) + perm32(R & 31)) : R;
        voffA[i] = (unsigned)(R * g.lda + C) * 2u; voffB[i] = (unsigned)(Rb * K + C) * 2u; }
    const size_t kstep = (size_t)(BK * 2);
    const size_t hstep = (size_t)HALF * K * 2;
    const size_t hstepA = (size_t)HALF * g.lda * 2;
    const size_t tstepA = (size_t)g.a_tile_rows * g.lda * 2, tstepB = 2 * hstep;
    const unsigned ldsw = (unsigned)wid * 1024u;
    const int aoff = lds_byte(wr * 64 + fr, fq * 8), boff = lds_byte(wc * 32 + fr, fq * 8);
#define PG8_SA(b, h) (((b) * 2 + (h)) * HTB)
#define PG8_SB(b, h) ((4 + (b) * 2 + (h)) * HTB)
#define PG8_STAGE(bufoff, gbase, voff) do { _Pragma("unroll") for (int _i = 0; _i < 2; ++_i) \
        __builtin_amdgcn_global_load_lds((const unsigned*)((const char*)(gbase) + (voff)[_i]), (PG8_LAS unsigned*)(lds + (bufoff) + ldsw + _i * 8192), 16, 0, 0); } while (0)
#define PG8_LDA(dst, b, h) do { _Pragma("unroll") for (int m = 0; m < 4; ++m) _Pragma("unroll") for (int k = 0; k < 2; ++k) dst[m][k] = *(const PG8_LAS bf16x8*)(lds + PG8_SA(b, h) + aoff + m * 2048 + k * 1024); } while (0)
#define PG8_LDB(dst, b, h) do { _Pragma("unroll") for (int n = 0; n < 2; ++n) _Pragma("unroll") for (int k = 0; k < 2; ++k) dst[n][k] = *(const PG8_LAS bf16x8*)(lds + PG8_SB(b, h) + boff + n * 2048 + k * 1024); } while (0)
#define PG8_MMA(ai, bj, At, Bt) do { __builtin_amdgcn_s_setprio(1); _Pragma("unroll") for (int m = 0; m < 4; ++m) _Pragma("unroll") for (int n = 0; n < 2; ++n) _Pragma("unroll") for (int k = 0; k < 2; ++k) \
        acc[ai][bj][m][n] = __builtin_amdgcn_mfma_f32_16x16x32_bf16(Bt[n][k], At[m][k], acc[ai][bj][m][n], 0, 0, 0); __builtin_amdgcn_s_setprio(0); } while (0)
#define PG8_WAIT_V(n) asm volatile("s_waitcnt vmcnt(" #n ")" ::: "memory")
#define PG8_WAIT_L(n) asm volatile("s_waitcnt lgkmcnt(" #n ")" ::: "memory")
#define PG8_BAR __builtin_amdgcn_s_barrier()
#define PG8_SCHED __builtin_amdgcn_sched_barrier(0)
    Unit cur, nxt; int ui = 0;
    if (!S.next(0, cur)) return;
    f32x4 acc[2][2][4][2];
#pragma unroll
    for (int a = 0; a < 2; ++a)
#pragma unroll
        for (int b = 0; b < 2; ++b)
#pragma unroll
            for (int m = 0; m < 4; ++m)
#pragma unroll
                for (int n = 0; n < 2; ++n) acc[a][b][m][n] = (f32x4){0.f, 0.f, 0.f, 0.f};
    bf16x8 At[4][2], B0[2][2], B1[2][2];
    const char* cA = (const char*)g.A + (size_t)cur.pm * tstepA + a_unit_off(g, cur.pn); const char* cB = (const char*)g.Bt + (size_t)cur.pn * tstepB;
    S.a_ready(cur);
    if constexpr (SP2) {
        PG8_STAGE(PG8_SB(0, 0), cB, voffB); PG8_STAGE(PG8_SB(0, 1), cB + hstep, voffB); PG8_STAGE(PG8_SA(0, 0), cA, voffA); PG8_STAGE(PG8_SA(0, 1), cA + hstepA, voffA);
        if (wr == 1) PG8_BAR;
        PG8_WAIT_V(2); PG8_BAR;
        PG8_STAGE(PG8_SB(1, 0), cB + kstep, voffB); PG8_STAGE(PG8_SA(1, 0), cA + kstep, voffA); PG8_STAGE(PG8_SB(1, 1), cB + hstep + kstep, voffB);
        PG8_WAIT_V(6); PG8_BAR;
    } else {
        PG8_STAGE(PG8_SB(0, 0), cB, voffB); PG8_STAGE(PG8_SA(0, 0), cA, voffA); PG8_STAGE(PG8_SB(0, 1), cB + hstep, voffB); PG8_STAGE(PG8_SA(0, 1), cA + hstepA, voffA);
        if (wr == 1) PG8_BAR;
        PG8_WAIT_V(4); PG8_BAR;
        PG8_STAGE(PG8_SB(1, 0), cB + kstep, voffB); PG8_STAGE(PG8_SA(1, 0), cA + kstep, voffA); PG8_STAGE(PG8_SB(1, 1), cB + hstep + kstep, voffB);
        PG8_WAIT_V(6); PG8_BAR;
    }
    for (;;) {
        const bool has_next = S.next(ui + 1, nxt);
        const char* nA = has_next ? (const char*)g.A + (size_t)nxt.pm * tstepA + a_unit_off(g, nxt.pn) : cA; const char* nB = has_next ? (const char*)g.Bt + (size_t)nxt.pn * tstepB : cB;
#pragma unroll 1
        for (int t = 0; t < nt; t += 2) {
            const bool last = (t == nt - 2);
            const char* a1 = cA + (size_t)(t + 1) * kstep;
            const char* a2 = last ? nA : cA + (size_t)(t + 2) * kstep; const char* b2 = last ? nB : cB + (size_t)(t + 2) * kstep;
            const char* a3 = a2 + kstep; const char* b3 = b2 + kstep;
            if (last && has_next) S.a_ready(nxt);
            if constexpr (SP2) {
            PG8_LDB(B0, 0, 0); PG8_LDB(B1, 0, 1); PG8_SCHED; PG8_LDA(At, 0, 0); PG8_STAGE(PG8_SA(1, 1), a1 + hstepA, voffA);
            PG8_WAIT_V(8); PG8_WAIT_L(0); PG8_BAR; PG8_MMA(0, 0, At, B0); PG8_MMA(0, 1, At, B1); PG8_BAR; PG8_SCHED;
            PG8_LDA(At, 0, 1); PG8_STAGE(PG8_SB(0, 0), b2, voffB); PG8_STAGE(PG8_SB(0, 1), b2 + hstep, voffB); PG8_STAGE(PG8_SA(0, 0), a2, voffA);
            PG8_WAIT_V(8); PG8_WAIT_L(0); PG8_BAR; PG8_MMA(1, 0, At, B0); PG8_MMA(1, 1, At, B1); PG8_BAR; PG8_SCHED;
            PG8_LDB(B0, 1, 0); PG8_LDB(B1, 1, 1); PG8_SCHED; PG8_LDA(At, 1, 0); PG8_STAGE(PG8_SA(0, 1), a2 + hstepA, voffA);
            PG8_WAIT_V(8); PG8_WAIT_L(0); PG8_BAR; PG8_MMA(0, 0, At, B0); PG8_MMA(0, 1, At, B1); PG8_BAR; PG8_SCHED;
            PG8_LDA(At, 1, 1); PG8_STAGE(PG8_SB(1, 0), b3, voffB); PG8_STAGE(PG8_SB(1, 1), b3 + hstep, voffB); PG8_STAGE(PG8_SA(1, 0), a3, voffA);
            PG8_WAIT_V(8); PG8_WAIT_L(0); PG8_BAR; PG8_MMA(1, 0, At, B0); PG8_MMA(1, 1, At, B1); PG8_BAR; PG8_SCHED;
            } else {
            PG8_LDB(B0, 0, 0); PG8_SCHED; PG8_LDA(At, 0, 0); PG8_STAGE(PG8_SA(1, 1), a1 + hstepA, voffA);
            PG8_WAIT_L(8); PG8_BAR; PG8_WAIT_L(0); PG8_MMA(0, 0, At, B0); PG8_BAR; PG8_SCHED;
            PG8_LDB(B1, 0, 1); PG8_STAGE(PG8_SB(0, 0), b2, voffB);
            PG8_BAR; PG8_WAIT_L(0); PG8_MMA(0, 1, At, B1); PG8_BAR;
            PG8_LDA(At, 0, 1); PG8_STAGE(PG8_SA(0, 0), a2, voffA);
            PG8_BAR; PG8_WAIT_L(0); PG8_MMA(1, 0, At, B0); PG8_BAR; PG8_SCHED;
            PG8_STAGE(PG8_SB(0, 1), b2 + hstep, voffB);
            PG8_WAIT_V(6); PG8_BAR; PG8_MMA(1, 1, At, B1); PG8_BAR;
            PG8_LDB(B0, 1, 0); PG8_SCHED; PG8_LDA(At, 1, 0); PG8_STAGE(PG8_SA(0, 1), a2 + hstepA, voffA);
            PG8_WAIT_L(8); PG8_BAR; PG8_WAIT_L(0); PG8_MMA(0, 0, At, B0); PG8_BAR; PG8_SCHED;
            PG8_LDB(B1, 1, 1); PG8_STAGE(PG8_SB(1, 0), b3, voffB);
            PG8_BAR; PG8_WAIT_L(0); PG8_MMA(0, 1, At, B1); PG8_BAR;
            PG8_LDA(At, 1, 1); PG8_STAGE(PG8_SA(1, 0), a3, voffA);
            PG8_BAR; PG8_WAIT_L(0); PG8_MMA(1, 0, At, B0); PG8_BAR; PG8_SCHED;
            PG8_STAGE(PG8_SB(1, 1), b3 + hstep, voffB);
            PG8_WAIT_V(6); PG8_BAR; PG8_MMA(1, 1, At, B1); PG8_BAR;
            }
        }
        if constexpr (ALIGN_EPI) { if (wr == 0) PG8_BAR; }
        if constexpr (!Epi::AFTER_DRAIN) { E(acc, cur, wr, wc, fr, fq); S.done(cur); }
        if (!has_next) break;
#pragma unroll
        for (int a = 0; a < 2; ++a)
#pragma unroll
            for (int b = 0; b < 2; ++b)
#pragma unroll
                for (int m = 0; m < 4; ++m)
#pragma unroll
                    for (int n = 0; n < 2; ++n) acc[a][b][m][n] = (f32x4){0.f, 0.f, 0.f, 0.f};
        cur = nxt; cA = nA; cB = nB; ++ui;
        if constexpr (ALIGN_EPI) { if (wr == 1) PG8_BAR; }
    }
    PG8_WAIT_V(0);
    if constexpr (!ALIGN_EPI) { if (wr == 0) PG8_BAR; }
    PG8_BAR;
    if constexpr (Epi::AFTER_DRAIN) { E.fused(acc, cur, wr, wc, fr, fq, lds, wid, lane); S.done(cur); }
#undef PG8_SA
#undef PG8_SB
#undef PG8_STAGE
#undef PG8_LDA
#undef PG8_LDB
#undef PG8_MMA
#undef PG8_WAIT_V
#undef PG8_WAIT_L
#undef PG8_BAR
#undef PG8_SCHED
}
}

#define LAS __attribute__((address_space(3)))
typedef unsigned short bf16;
typedef short bf16x8_t __attribute__((ext_vector_type(8)));
typedef float f32x4_t __attribute__((ext_vector_type(4)));
typedef unsigned u32x4_t __attribute__((ext_vector_type(4)));
typedef unsigned u32x2_t __attribute__((ext_vector_type(2)));
constexpr int LDS_BYTES = 147456, RING_BYTES = 131072;

constexpr size_t DO_WLORA = 98041856 + 6291456, DO_HB = 0, DO_WHG = 68157440, DO_WHGO = 78643200, DO_WF0I = 80740352, DO_WF0O = 92274688, DO_WRW1 = 98041856, DO_WRWO = 113770496,
                 DO_WG2 = 115867648, DO_WF1I = 116391936, DO_WF1O = 127926272, DO_END = 133693440;
constexpr size_t WS_BAR = 720896, WS_SSQ = 0, WS_BETA = 1048576, WS_PA = 3211264, WS_PB = 5373952, WS_HW = 7536640, WS_HA = 11796480, WS_HG = 16056320, WS_BIG = 25165824, WS_SLOTB = 34078720,
                 WS_NEED = 268435456, WS_ACT = WS_NEED - (size_t)TROWS * FFN * 2, WS_HBNEW = 8388608;
static_assert(WS_BETA + 2 * (size_t)SLAB * 64 <= WS_PA && WS_PA + (size_t)TROWS * 64 <= WS_PB && WS_PB + (size_t)TROWS * 64 <= WS_HW && WS_HW + (size_t)SLAB * 256 <= WS_HA && WS_HA + (size_t)SLAB * 256 <= WS_HG && WS_HG + (size_t)SLAB * 512 <= WS_BIG, "small map");
static_assert(8388608 + (size_t)64 * 129 * 4608 <= 2 * WS_SLOTB && 8388608 + (size_t)32 * 257 * 4608 <= 2 * WS_SLOTB && WS_HW + (size_t)256 * 16512 * 4 <= WS_BIG && WS_BIG + 7 * WS_SLOTB <= WS_NEED && WS_HBNEW + (size_t)TROWS * 2048 <= WS_ACT && DO_END <= 134217728, "maps");

struct Args { const float* in[32]; float* out; unsigned char* ws; };
typedef const __attribute__((address_space(4))) Args* ArgP;
#define LAUNDER_ARGS(ap0) ({ ArgP _p = (ap0); asm volatile("" : "+s"(_p)); _p; })

__device__ __forceinline__ float wave_sum(float v) {
#pragma unroll
    for (int o = 1; o < 64; o <<= 1) v += __shfl_xor(v, o);
    return v;
}

__device__ __forceinline__ void tr_item(const float* W, int N, int Klim, int k0, int n0, bf16* WT, int ldk, int drow, int dcol, const float* sc, float* scr, int lane, const float* sc2 = nullptr) {
    if (k0 + 64 <= Klim) {
#pragma unroll 8
        for (int i = 0; i < 32; ++i) { const int kk = 2 * i + (lane >> 5); scr[kk * 33 + (lane & 31)] = W[(size_t)(k0 + kk) * N + n0 + (lane & 31)]; }
    } else {
#pragma unroll 8
        for (int i = 0; i < 32; ++i) { const int kk = 2 * i + (lane >> 5); const int k = k0 + kk; float v = 0.f; if (k < Klim) v = W[(size_t)k * N + n0 + (lane & 31)]; scr[kk * 33 + (lane & 31)] = v; }
    }
    asm volatile("s_waitcnt lgkmcnt(0)" ::: "memory");
    const int c = lane & 7;
    f32x4_t sa = (f32x4_t){1.f, 1.f, 1.f, 1.f}, sb = sa;
    if (sc) { sa = *(const f32x4_t*)(sc + k0 + 8 * c); sb = *(const f32x4_t*)(sc + k0 + 8 * c + 4);
        if (sc2) { sa = sa - *(const f32x4_t*)(sc2 + k0 + 8 * c); sb = sb - *(const f32x4_t*)(sc2 + k0 + 8 * c + 4); } }
#pragma unroll
    for (int j = 0; j < 4; ++j) { const int n = (lane >> 3) + 8 * j; const float* s = scr + (8 * c) * 33 + n;
        u32x4_t o; o.x = pk2(s[0 * 33] * sa[0], s[1 * 33] * sa[1]); o.y = pk2(s[2 * 33] * sa[2], s[3 * 33] * sa[3]); o.z = pk2(s[4 * 33] * sb[0], s[5 * 33] * sb[1]); o.w = pk2(s[6 * 33] * sb[2], s[7 * 33] * sb[3]);
        *(u32x4_t*)(WT + (size_t)(drow + n) * ldk + dcol + k0 + 8 * c) = o; }
    asm volatile("s_waitcnt lgkmcnt(0)" ::: "memory");
}

__device__ __forceinline__ void p0_prologue(ArgP ap, unsigned char* lds, int tid) {
    const int lane = tid & 63, wave = tid >> 6;
    float* scr = (float*)(lds + wave * 16384);
    int gdim = gridDim.x; asm volatile("" : "+s"(gdim));
    const int gw = blockIdx.x * 8 + wave, NGW = gdim * 8;
    unsigned char* dob = (unsigned char*)ap->out;
    bf16* WHG = (bf16*)(dob + DO_WHG); bf16* WHGO = (bf16*)(dob + DO_WHGO); bf16* WF0I = (bf16*)(dob + DO_WF0I); bf16* WF0O = (bf16*)(dob + DO_WF0O);
    bf16* WRW1 = (bf16*)(dob + DO_WRW1); bf16* WLORA = (bf16*)(dob + DO_WLORA); bf16* WRWO = (bf16*)(dob + DO_WRWO); bf16* WG2 = (bf16*)(dob + DO_WG2); bf16* WF1I = (bf16*)(dob + DO_WF1I); bf16* WF1O = (bf16*)(dob + DO_WF1O);
    const float* mu = ap->in[10];
    constexpr int I_HG = 16 * 160, I_SQ = 16 * 32, I_FI = 16 * 176, I_FO = 44 * 32, I_L64 = 16 * 2, I_G1 = 16 * 5, I_G2 = 4 * 32;
    constexpr int NITEMS = I_HG + I_SQ + 2 * I_FI + 2 * I_FO + 3 * I_SQ + 4 * I_L64 + 4 * I_L64 + 2 * I_G1 + I_SQ + I_G2;
    for (int it = gw; it < NITEMS; it += NGW) {
        int r = it;
        if (r < I_HG) { const int kb = r / 160, nb = r % 160; tr_item(ap->in[6], 5120, 1024, 64 * kb, 32 * nb, WHG, 1024, 32 * nb, 0, ap->in[3], scr, lane); continue; } r -= I_HG;
        if (r < I_SQ) { const int kb = r / 32, nb = r % 32; tr_item(ap->in[7], 1024, 1024, 64 * kb, 32 * nb, WHGO, 1024, 32 * nb, 0, nullptr, scr, lane); continue; } r -= I_SQ;
        if (r < 2 * I_FI) { const int l = r / I_FI; r -= l * I_FI; const int kb = r / 176, nb = r % 176; const int n0 = 32 * nb; const int half = n0 / FFN, c = n0 % FFN;
            const int drow = 256 * (c / 128) + 128 * half + (c % 128);
            tr_item(ap->in[28] + (size_t)l * 1024 * 5632, 5632, 1024, 64 * kb, n0, l ? WF1I : WF0I, 1024, drow, 0, ap->in[4] + l * 1024, scr, lane); continue; } r -= 2 * I_FI;
        if (r < 2 * I_FO) { const int l = r / I_FO; r -= l * I_FO; const int kb = r / 32, nb = r % 32;
            tr_item(ap->in[31] + (size_t)l * 2816 * 1024, 1024, 2816, 64 * kb, 32 * nb, l ? WF1O : WF0O, 2816, 32 * nb, 0, nullptr, scr, lane); continue; } r -= 2 * I_FO;
        if (r < 3 * I_SQ) { const int m3 = r / I_SQ; r -= m3 * I_SQ; const int kb = r / 32, nb = r % 32;
            tr_item(ap->in[11 + m3], 1024, 1024, 64 * kb, 32 * nb, WRW1, 1024, m3 * 1024 + 32 * nb, 0, nullptr, scr, lane); continue; } r -= 3 * I_SQ;
        if (r < 4 * I_L64) { const int d = r / (2 * I_L64); r -= d * 2 * I_L64; const int half = r / I_L64; r -= half * I_L64; const int kb = r / 2, nb = r % 2;
            tr_item(ap->in[16] + (size_t)d * 1024 * 64, 64, 1024, 64 * kb, 32 * nb, WLORA, 2048, d * 64 + 32 * nb, half * 1024, half ? mu + 1 * 1024 : nullptr, scr, lane, mu); continue; } r -= 4 * I_L64;
        if (r < 4 * I_L64) { const int d = r / (2 * I_L64); r -= d * 2 * I_L64; const int half = r / I_L64; r -= half * I_L64; const int kb = r / 2, nb = r % 2;
            tr_item(ap->in[19] + (size_t)d * 1024 * 64, 64, 1024, 64 * kb, 32 * nb, WLORA, 2048, 128 + d * 64 + 32 * nb, half * 1024, half ? mu + 4 * 1024 : nullptr, scr, lane, mu); continue; } r -= 4 * I_L64;
        if (r < 2 * I_G1) { const int half = r / I_G1; r -= half * I_G1; const int kb = r / 5, nb = r % 5;
            tr_item(ap->in[21], 160, 1024, 64 * kb, 32 * nb, WLORA, 2048, 256 + 32 * nb, half * 1024, half ? mu + 5 * 1024 : nullptr, scr, lane, mu); continue; } r -= 2 * I_G1;
        if (r < I_SQ) { const int kb = r / 32, nb = r % 32; tr_item(ap->in[14], 1024, 1024, 64 * kb, 32 * nb, WRWO, 1024, 32 * nb, 0, nullptr, scr, lane); continue; } r -= I_SQ;
        { const int kb = r / 32, nb = r % 32; tr_item(ap->in[22], 1024, 160, 64 * kb, 32 * nb, WG2, 256, 32 * nb, 0, nullptr, scr, lane); }
    }
    {
        const int gt = blockIdx.x * 512 + tid, NGT = gdim * 512;
        for (int i = gt; i < 96 * 256; i += NGT) { const int rr = i >> 8, cc = i & 255;
            unsigned zz = 0u; asm volatile("" : "+v"(zz)); *(u32x4_t*)(WLORA + (size_t)(416 + rr) * 2048 + cc * 8) = (u32x4_t){zz, zz, zz, zz}; }
    }
    bf16* HB = (bf16*)(dob + DO_HB); float* ssq0 = (float*)(ap->ws + WS_SSQ);
    for (int r = gw; r < TROWS; r += NGW) {
        int o, tokbase; bool pad = false;
        if (r < 8256) { o = r; tokbase = 16384; } else if (r < 16512) { o = r - 8256; tokbase = 24576; } else if (r < 16640) { pad = true; o = 0; tokbase = 0; }
        else if (r < 33088) { o = r - 16640; tokbase = 0; } else { pad = true; o = 0; tokbase = 0; }
        if (o < 48) pad = true;
        const float* src = nullptr;
        if (!pad) { if (o < 64) src = ap->in[2] + (size_t)(o - 48) * 1024; else { const int g = tokbase + o - 64; src = (g < 16384) ? ap->in[0] + (size_t)g * 1024 : ap->in[1] + (size_t)(g - 16384) * 1024; } }
        float s = 0.f;
#pragma unroll
        for (int j = 0; j < 4; ++j) { f32x4_t v = (f32x4_t){0.f, 0.f, 0.f, 0.f}; if (src) v = *(const f32x4_t*)(src + 4 * lane + 256 * j);
            s += v[0] * v[0] + v[1] * v[1] + v[2] * v[2] + v[3] * v[3];
            u32x2_t w; w.x = pk2(v[0], v[1]); w.y = pk2(v[2], v[3]); *(u32x2_t*)(HB + (size_t)r * 1024 + 4 * lane + 256 * j) = w; }
        s = wave_sum(s); if (lane == 0) ssq0[r] = s;
    }
}

#define XB_TMO      128
#define XB_XCNT(j)  (256  + 64 * (j))
#define XB_XSUB(j)  (1280 + 64 * (j))
#define XB_XGEN(j)  (2304 + 64 * (j))
#define XB_TOP      3328
#define XB_TOPGEN   3392
#define XCD_BAR_WORDS 3456
#define XB_SPIN_CAP (1u << 18)

__device__ __forceinline__ unsigned xb_ld(unsigned* p)              { return __hip_atomic_load(p, __ATOMIC_RELAXED, __HIP_MEMORY_SCOPE_AGENT); }
__device__ __forceinline__ unsigned xb_add(unsigned* p, unsigned v) { return __hip_atomic_fetch_add(p, v, __ATOMIC_RELAXED, __HIP_MEMORY_SCOPE_AGENT); }
__device__ __forceinline__ unsigned xb_xcc_id() { return (unsigned)__builtin_amdgcn_s_getreg((3 << 11) | 20) & 0xFu; }
#define XB_SPIN(cond, bar) do { unsigned _sp = 0; while (cond) { __builtin_amdgcn_s_sleep(1); \
    if ((++_sp & 255u) == 0u) { if (xb_ld(&(bar)[XB_TMO])) break; if (_sp > XB_SPIN_CAP) { atomicAdd(&(bar)[XB_TMO], 1u); break; } } } } while (0)

struct XcdBarrier {
    unsigned* bar; unsigned x;
    volatile LAS unsigned* st;
};

__device__ __forceinline__ XcdBarrier xcd_barrier_post(unsigned* bar, volatile LAS unsigned* st) {
    XcdBarrier b; b.bar = bar; b.x = xb_xcc_id(); b.st = st;
    if (threadIdx.x == 0) (void)xb_add(&bar[XB_XCNT(b.x)], 1u);
    return b;
}
__device__ __forceinline__ void xcd_barrier_complete(unsigned* bar, unsigned x, unsigned& nloc, unsigned& nx) {
    const unsigned G = gridDim.x * gridDim.y * gridDim.z;
    unsigned sum, cnt, mine, sp = 0u;
    for (;;) {
        sum = 0u; cnt = 0u; mine = 0u;
#pragma unroll
        for (unsigned j = 0; j < 16; ++j) { const unsigned c = xb_ld(&bar[XB_XCNT(j)]); sum += c; cnt += (c > 0u) ? 1u : 0u; mine = (j == x) ? c : mine; }
        if (sum == G) break;
        __builtin_amdgcn_s_sleep(1);
        if ((++sp & 255u) == 0u) { if (xb_ld(&bar[XB_TMO])) break; if (sp > XB_SPIN_CAP) { atomicAdd(&bar[XB_TMO], 1u); break; } }
    }
    nloc = mine > 0u ? mine : 1u; nx = cnt > 0u ? cnt : 1u;
}

__device__ __forceinline__ void xcd_barrier(const XcdBarrier& b, int tid_) {
    asm volatile("s_waitcnt vmcnt(0)" ::: "memory");
    __syncthreads();
    if (tid_ == 0) {
        unsigned* bar = b.bar;
        __builtin_amdgcn_s_waitcnt(0);
        unsigned nloc = b.st[0], nx = b.st[1];
        if (nloc == 0u) { xcd_barrier_complete(bar, b.x, nloc, nx); b.st[0] = nloc; b.st[1] = nx; }
        const unsigned old = xb_add(&bar[XB_XSUB(b.x)], 1u);
        const unsigned gen = old / nloc;
        if (old + 1u == (gen + 1u) * nloc) {
            __builtin_amdgcn_fence(__ATOMIC_RELEASE, "agent");
            asm volatile("s_waitcnt vmcnt(0)" ::: "memory");
            const unsigned og = xb_add(&bar[XB_TOP], 1u);
            const unsigned tg = og / nx;
            if (og + 1u == (tg + 1u) * nx) xb_add(&bar[XB_TOPGEN], 1u);
            else XB_SPIN(xb_ld(&bar[XB_TOPGEN]) == tg, bar);
            __builtin_amdgcn_fence(__ATOMIC_ACQUIRE, "agent");
            xb_add(&bar[XB_XGEN(b.x)], 1u);
            asm volatile("s_waitcnt vmcnt(0)" ::: "memory");
        } else {
            XB_SPIN(xb_ld(&bar[XB_XGEN(b.x)]) == gen, bar);
            __builtin_amdgcn_fence(__ATOMIC_ACQUIRE, "agent");
            asm volatile("s_waitcnt vmcnt(0)" ::: "memory");
        }
    }
    __syncthreads();
}

template <class Epi, bool ALIGN>
__device__ __forceinline__ void run_gemm(unsigned char* lds, const bf16* A, const bf16* Bt, int nM, int nN, int K, int a_tile_rows, const Epi& E, int tid) {
    asm volatile("" : "+s"(K));
    pg8::Gemm g{A, Bt, nM * 256, nN * 256, K, a_tile_rows, K, 0u, 0u}; pg8::StaticOrder S; S.init(nM * 256, nN * 256, (int)gridDim.x, (int)blockIdx.x);
    pg8::gemm_phase<Epi, pg8::StaticOrder, ALIGN, true>((PG8_LAS unsigned char*)lds, g, S, E, tid);
}
template <class Epi>
__device__ __forceinline__ void run_gemm_list(unsigned char* lds, const bf16* A, const bf16* Bt, int K, int lda, unsigned a_off1, unsigned a_off2, const pg8::BalOrder& S, const Epi& E, int tid) {
    asm volatile("" : "+s"(K));
    pg8::Gemm g{A, Bt, 0, 0, K, 256, lda, a_off1, a_off2};
    pg8::gemm_phase<Epi, pg8::BalOrder, true, true>((PG8_LAS unsigned char*)lds, g, S, E, tid);
}

template <bool PA>
__device__ __forceinline__ void hgrn_scan(unsigned char* lds, const bf16* Q, const bf16* FFb, const bf16* FBb, const bf16* Ib, bf16* OFb, bf16* OBb, const float* lbp, float* segm, int slab, int tid) {
    const int lane = tid & 63, wave = tid >> 6, r16 = lane & 15, kq = lane >> 4;
    bf16* qin = (bf16*)lds;
    bf16* kin = qin + 64 * 136;
    bf16* kinT = kin + 64 * 136;
    bf16* Pm = kinT + 128 * 72;
    bf16* iT = Pm + 64 * 72;
    bf16* SbT = iT + 128 * 72;
    float* tot = (float*)(SbT + 128 * 136);
    float* c1 = tot + 512; float* c2 = c1 + 128; float* gtv = c2 + 128;
    const int G = slab == 0 ? 8 : 16, nch = slab == 0 ? 129 : 257;
    const int c = tid & 127, seg = tid >> 7;
    const int jr = tid >> 3, part = tid & 7;
    for (int item = blockIdx.x; item < 256; item += gridDim.x) {
        const int g = item % G, strm = item / G; const int p0 = g == 0 ? 0 : 1 + 16 * g, p1 = 17 + 16 * g;
        if (PA && g == G - 1) continue;
        const int dir = strm & 1, head = (strm >> 1) & 7, sq = strm >> 4;
        const int seqbase = sq * 8256;
        const bf16* Fp = dir ? FBb : FFb; bf16* Op = dir ? OBb : OFb;
        const int hc = head * 128 + c;
        const float l0 = lbp[hc], l1 = lbp[1024 + hc]; const float lb = 1.0f / (1.0f + __expf(l1 - l0));
        f32x4_t S[8];
#pragma unroll
        for (int vt = 0; vt < 8; ++vt) S[vt] = (f32x4_t){0.f, 0.f, 0.f, 0.f};
        float gprod = 1.f;
        float* myPsi = segm + (size_t)item * 16512; float* myG = myPsi + 16384;
        if (!PA) {
            for (int gg = 0; gg < g; ++gg) { const float* Psi = segm + (size_t)(strm * G + gg) * 16512; const float* Gv = Psi + 16384;
#pragma unroll
                for (int e = 0; e < 4; ++e) { const int kr = 16 * wave + 4 * kq + e; const float gk = Gv[kr];
#pragma unroll
                    for (int vt = 0; vt < 8; ++vt) S[vt][e] = gk * S[vt][e] + Psi[kr * 128 + 16 * vt + r16]; } }
        }
        unsigned short qraw[16], fraw[16];
        { const int cbase = seqbase + (dir ? nch - 1 - p0 : p0) * 64;
#pragma unroll
          for (int jj = 0; jj < 16; ++jj) { const int j = 16 * seg + jj; const unsigned bo = ((unsigned)(cbase + (dir ? 63 - j : j)) * 1024u + (unsigned)hc) * 2u; qraw[jj] = PA ? (unsigned short)0 : *(const unsigned short*)((const char*)Q + bo); fraw[jj] = *(const unsigned short*)((const char*)Fp + bo); } }
        __syncthreads();
        for (int p = p0; p < p1; ++p) {
            const int cidx = dir ? nch - 1 - p : p; const int cbase = seqbase + cidx * 64;
            float bl[16], kvv[16], qv[16]; float run = 1.f;
#pragma unroll
            for (int jj = 0; jj < 16; ++jj) { const float f = bf2f(fraw[jj]); const float fg = lb + (1.0f - lb) * sigmoidf_(f); run *= fg; bl[jj] = run; kvv[jj] = 1.0f - fg; qv[jj] = bf2f(qraw[jj]); }
            tot[seg * 128 + c] = run;
            { const size_t row = cbase + (dir ? 63 - jr : jr);
              const u32x4_t w0 = *(const u32x4_t*)(Ib + row * 1024 + head * 128 + part * 16), w1 = *(const u32x4_t*)(Ib + row * 1024 + head * 128 + part * 16 + 8);
              const unsigned wa[8] = {w0.x, w0.y, w0.z, w0.w, w1.x, w1.y, w1.z, w1.w};
#pragma unroll
              for (int q = 0; q < 8; ++q) { iT[(part * 16 + 2 * q) * 72 + jr] = (bf16)(wa[q] & 0xffff); iT[(part * 16 + 2 * q + 1) * 72 + jr] = (bf16)(wa[q] >> 16); } }
            if (p + 1 < p1) { const int nb = seqbase + (dir ? nch - 2 - p : p + 1) * 64;
#pragma unroll
                for (int jj = 0; jj < 16; ++jj) { const int j = 16 * seg + jj; const unsigned bo = ((unsigned)(nb + (dir ? 63 - j : j)) * 1024u + (unsigned)hc) * 2u; qraw[jj] = PA ? (unsigned short)0 : *(const unsigned short*)((const char*)Q + bo); fraw[jj] = *(const unsigned short*)((const char*)Fp + bo); } }
            __syncthreads();
            const float t0 = tot[c], t1 = tot[128 + c], t2 = tot[256 + c], t3 = tot[384 + c];
            const float off = seg == 0 ? 1.f : (seg == 1 ? t0 : (seg == 2 ? t0 * t1 : t0 * t1 * t2));
            const float aref = t0 * t1, alast = (t0 * t1) * (t2 * t3); const float iaref = __builtin_amdgcn_rcpf(aref);
#pragma unroll
            for (int jj = 0; jj < 16; ++jj) { const int j = 16 * seg + jj; const float at = off * bl[jj];
                const float ke = kvv[jj] * (aref * __builtin_amdgcn_rcpf(at)); const bf16 kb = (bf16)f2bf(ke); kinT[c * 72 + j] = kb;
                if (!PA) { const float qe = qv[jj] * (at * iaref); qin[j * 136 + c] = (bf16)f2bf(qe); kin[j * 136 + c] = kb; } }
            if (seg == 0) { c1[c] = aref; c2[c] = alast * iaref; gtv[c] = alast; gprod *= alast; }
            __syncthreads();
            if (!PA) {
                { const int cc = 16 * wave + 4 * kq; const float s0 = c1[cc], s1 = c1[cc + 1], s2 = c1[cc + 2], s3 = c1[cc + 3];
#pragma unroll
                  for (int vt = 0; vt < 8; ++vt) { u32x2_t w; w.x = pk2(s0 * S[vt][0], s1 * S[vt][1]); w.y = pk2(s2 * S[vt][2], s3 * S[vt][3]); *(u32x2_t*)(SbT + (16 * vt + r16) * 136 + cc) = w; } }
                { const int tt = wave >> 1;
#pragma unroll
                  for (int si = 0; si < 2; ++si) { const int ss = 2 * (wave & 1) + si; f32x4_t ac = (f32x4_t){0.f, 0.f, 0.f, 0.f};
#pragma unroll
                      for (int kk = 0; kk < 4; ++kk) { const bf16x8_t av = *(const bf16x8_t*)(qin + (16 * tt + r16) * 136 + 32 * kk + 8 * kq); const bf16x8_t bv = *(const bf16x8_t*)(kin + (16 * ss + r16) * 136 + 32 * kk + 8 * kq);
                          ac = __builtin_amdgcn_mfma_f32_16x16x32_bf16(av, bv, ac, 0, 0, 0); }
#pragma unroll
                      for (int e = 0; e < 4; ++e) { const int t = 16 * tt + 4 * kq + e, s = 16 * ss + r16; Pm[t * 72 + s] = (bf16)f2bf(s <= t ? ac[e] : 0.f); } } }
                __syncthreads();
            }
            f32x4_t kv[8];
            { const bf16x8_t a0 = *(const bf16x8_t*)(kinT + (16 * wave + r16) * 72 + 8 * kq), a1 = *(const bf16x8_t*)(kinT + (16 * wave + r16) * 72 + 32 + 8 * kq);
#pragma unroll
              for (int vt = 0; vt < 8; ++vt) { kv[vt] = (f32x4_t){0.f, 0.f, 0.f, 0.f};
                  kv[vt] = __builtin_amdgcn_mfma_f32_16x16x32_bf16(a0, *(const bf16x8_t*)(iT + (16 * vt + r16) * 72 + 8 * kq), kv[vt], 0, 0, 0);
                  kv[vt] = __builtin_amdgcn_mfma_f32_16x16x32_bf16(a1, *(const bf16x8_t*)(iT + (16 * vt + r16) * 72 + 32 + 8 * kq), kv[vt], 0, 0, 0); } }
            if (!PA) { const int tt = wave & 3;
#pragma unroll
                for (int vi = 0; vi < 4; ++vi) { const int vt = 4 * (wave >> 2) + vi; f32x4_t o = (f32x4_t){0.f, 0.f, 0.f, 0.f};
#pragma unroll
                    for (int kk = 0; kk < 2; ++kk) o = __builtin_amdgcn_mfma_f32_16x16x32_bf16(*(const bf16x8_t*)(Pm + (16 * tt + r16) * 72 + 32 * kk + 8 * kq), *(const bf16x8_t*)(iT + (16 * vt + r16) * 72 + 32 * kk + 8 * kq), o, 0, 0, 0);
#pragma unroll
                    for (int kk = 0; kk < 4; ++kk) o = __builtin_amdgcn_mfma_f32_16x16x32_bf16(*(const bf16x8_t*)(qin + (16 * tt + r16) * 136 + 32 * kk + 8 * kq), *(const bf16x8_t*)(SbT + (16 * vt + r16) * 136 + 32 * kk + 8 * kq), o, 0, 0, 0);
#pragma unroll
                    for (int e = 0; e < 4; ++e) kin[(16 * tt + 4 * kq + e) * 136 + 16 * vt + r16] = (bf16)f2bf(o[e]); } }
            { const int cc = 16 * wave + 4 * kq;
#pragma unroll
              for (int e = 0; e < 4; ++e) { const float ge = gtv[cc + e], ce = c2[cc + e];
#pragma unroll
                  for (int vt = 0; vt < 8; ++vt) S[vt][e] = ge * S[vt][e] + ce * kv[vt][e]; } }
            __syncthreads();
            if (!PA) { const size_t row = cbase + (dir ? 63 - jr : jr);
                *(u32x4_t*)(Op + row * 1024 + head * 128 + part * 16) = *(const u32x4_t*)(kin + jr * 136 + part * 16);
                *(u32x4_t*)(Op + row * 1024 + head * 128 + part * 16 + 8) = *(const u32x4_t*)(kin + jr * 136 + part * 16 + 8); }
        }
        if (PA) {
#pragma unroll
            for (int e = 0; e < 4; ++e) { const int kr = 16 * wave + 4 * kq + e;
#pragma unroll
                for (int vt = 0; vt < 8; ++vt) myPsi[kr * 128 + 16 * vt + r16] = S[vt][e]; }
            if (seg == 0) myG[c] = gprod;
        }
    }
}

__device__ __forceinline__ void hgrn_gate(const bf16* OFb, const bf16* OBb, bf16* G, const float* onorm, int tid) {
    const int lane = tid & 63, wave = tid >> 6; const int gw = blockIdx.x * 8 + wave, NGW = gridDim.x * 8;
    for (int r = gw; r < SLAB; r += NGW) {
        const size_t off = (size_t)r * 1024 + 16 * lane;
        float o[16], g[16]; float ss = 0.f;
#pragma unroll
        for (int h = 0; h < 2; ++h) { const u32x4_t a = *(const u32x4_t*)(OFb + off + 8 * h), b = *(const u32x4_t*)(OBb + off + 8 * h), gg = *(const u32x4_t*)(G + off + 8 * h);
            const unsigned aw[4] = {a.x, a.y, a.z, a.w}, bw[4] = {b.x, b.y, b.z, b.w}, gw4[4] = {gg.x, gg.y, gg.z, gg.w};
#pragma unroll
            for (int q = 0; q < 4; ++q) { o[8 * h + 2 * q] = __uint_as_float(aw[q] << 16) + __uint_as_float(bw[q] << 16); o[8 * h + 2 * q + 1] = __uint_as_float(aw[q] & 0xffff0000u) + __uint_as_float(bw[q] & 0xffff0000u);
                g[8 * h + 2 * q] = __uint_as_float(gw4[q] << 16); g[8 * h + 2 * q + 1] = __uint_as_float(gw4[q] & 0xffff0000u); } }
#pragma unroll
        for (int i = 0; i < 16; ++i) ss += o[i] * o[i];
        ss += __shfl_xor(ss, 1); ss += __shfl_xor(ss, 2); ss += __shfl_xor(ss, 4);
        const float rs = rsqrtf(ss * (1.0f / 128.0f) + NEPS);
        float res[16];
#pragma unroll
        for (int i = 0; i < 16; ++i) res[i] = o[i] * rs * onorm[16 * lane + i] * g[i];
#pragma unroll
        for (int h = 0; h < 2; ++h) { u32x4_t w; w.x = pk2(res[8 * h], res[8 * h + 1]); w.y = pk2(res[8 * h + 2], res[8 * h + 3]); w.z = pk2(res[8 * h + 4], res[8 * h + 5]); w.w = pk2(res[8 * h + 6], res[8 * h + 7]);
            *(u32x4_t*)(G + off + 8 * h) = w; }
    }
}

__device__ __forceinline__ void rwkv_mix(const bf16* HB, const float* ssq, const float* gain, const float* mu, bf16* P0, bf16* P1, int row0, int tid) {
    const int lane = tid & 63, wave = tid >> 6; const int gw = blockIdx.x * 8 + wave, NGW = gridDim.x * 8;
    for (int lr = gw; lr < SLAB; lr += NGW) {
        const int r = row0 + lr; const bool pad = row_is_pad(r);
        const float rs = rsqrtf(pg8::row_ssq16(ssq, r) * (1.0f / 1024.0f) + NEPS);
        const float rsm = (r > 0) ? rsqrtf(pg8::row_ssq16(ssq, r - 1) * (1.0f / 1024.0f) + NEPS) : 0.f;
        const float rsp = (r < TROWS - 1) ? rsqrtf(pg8::row_ssq16(ssq, r + 1) * (1.0f / 1024.0f) + NEPS) : 0.f;
#pragma unroll
        for (int h = 0; h < 2; ++h) { const int col = 16 * lane + 8 * h; const size_t off = (size_t)r * 1024 + col;
            u32x4_t a = *(const u32x4_t*)(HB + off), am = (u32x4_t){0u, 0u, 0u, 0u}, ap = (u32x4_t){0u, 0u, 0u, 0u};
            if (r > 0) am = *(const u32x4_t*)(HB + off - 1024);
            if (r < TROWS - 1) ap = *(const u32x4_t*)(HB + off + 1024);
            const unsigned aw[4] = {a.x, a.y, a.z, a.w}, mw[4] = {am.x, am.y, am.z, am.w}, pw[4] = {ap.x, ap.y, ap.z, ap.w};
            float xr[8], xk[8], xv[8], xx[8];
            const f32x4_t ga = *(const f32x4_t*)(gain + col), gb = *(const f32x4_t*)(gain + col + 4);
            const f32x4_t ra = *(const f32x4_t*)(mu + col), rb = *(const f32x4_t*)(mu + col + 4), ka = *(const f32x4_t*)(mu + 2048 + col), kb = *(const f32x4_t*)(mu + 2048 + col + 4), va = *(const f32x4_t*)(mu + 3072 + col), vb = *(const f32x4_t*)(mu + 3072 + col + 4);
            const float keep = pad ? 0.f : 1.f;
#pragma unroll
            for (int q = 0; q < 4; ++q) {
#pragma unroll
                for (int hh = 0; hh < 2; ++hh) { const int i8 = 2 * q + hh; const float g0 = (i8 < 4 ? ga[i8 & 3] : gb[i8 & 3]) * keep;
                    const float mr = i8 < 4 ? ra[i8 & 3] : rb[i8 & 3], mk = i8 < 4 ? ka[i8 & 3] : kb[i8 & 3], mv = i8 < 4 ? va[i8 & 3] : vb[i8 & 3];
                    const float x0 = (hh ? __uint_as_float(aw[q] & 0xffff0000u) : __uint_as_float(aw[q] << 16)) * rs * g0;
                    const float m0 = (hh ? __uint_as_float(mw[q] & 0xffff0000u) : __uint_as_float(mw[q] << 16)) * rsm * g0;
                    const float p0 = (hh ? __uint_as_float(pw[q] & 0xffff0000u) : __uint_as_float(pw[q] << 16)) * rsp * g0;
                    const float d0 = 0.5f * (m0 + p0) - x0;
                    xx[i8] = d0; xr[i8] = x0 + d0 * mr; xk[i8] = x0 + d0 * mk; xv[i8] = x0 + d0 * mv; } }
            u32x4_t w; w.x = pk2(xr[0], xr[1]); w.y = pk2(xr[2], xr[3]); w.z = pk2(xr[4], xr[5]); w.w = pk2(xr[6], xr[7]);
            *(u32x4_t*)(P0 + (size_t)lr * 2048 + col) = w;
            w.x = pk2(xx[0], xx[1]); w.y = pk2(xx[2], xx[3]); w.z = pk2(xx[4], xx[5]); w.w = pk2(xx[6], xx[7]);
            *(u32x4_t*)(P0 + (size_t)lr * 2048 + 1024 + col) = w;
            w.x = pk2(xk[0], xk[1]); w.y = pk2(xk[2], xk[3]); w.z = pk2(xk[4], xk[5]); w.w = pk2(xk[6], xk[7]);
            *(u32x4_t*)(P1 + (size_t)lr * 2048 + col) = w;
            w.x = pk2(xv[0], xv[1]); w.y = pk2(xv[2], xv[3]); w.z = pk2(xv[4], xv[5]); w.w = pk2(xv[6], xv[7]);
            *(u32x4_t*)(P1 + (size_t)lr * 2048 + 1024 + col) = w; }
    }
}

__device__ __forceinline__ void rwkv_scan_seq(unsigned char* lds, const bf16* Rb, const bf16* Kb, const bf16* Vb, const bf16* HWb, const bf16* HAb, bf16* OFb, bf16* OBb, float* beta,
                                              ArgP a, int slab, int tid) {
    float* w2s = (float*)lds; float* a2s = w2s + 4096; float* rS = a2s + 4096; float* kdS = rS + 4096; float* vS = kdS + 4096; float* wS = vS + 4096; float* kkS = wS + 4096; float* kkaS = kkS + 4096;
    const int nitems = (slab == 0 ? 2 : 1) * 32, nch = slab == 0 ? 129 : 257;
    const int j = tid >> 3, part = tid & 7, c8 = part * 8;
    for (int item = blockIdx.x; item < nitems; item += gridDim.x) {
        const int d = item & 1, head = (item >> 1) & 15, sq = item >> 5; const int seqbase = sq * 8256; const int hc8 = head * 64 + c8;
        bf16* Op = d ? OBb : OFb;
        const float* w0 = a->in[15] + d * 1024; const float* w2 = a->in[17] + (size_t)d * 64 * 1024; const float* a0 = a->in[18] + d * 1024; const float* a2 = a->in[20] + (size_t)d * 64 * 1024;
        const float* pkk = a->in[23]; const float* pka = a->in[24]; const float* prk = a->in[25];
        __syncthreads();
        for (int i = tid; i < 4096; i += 512) { const int l = i >> 6, cc = i & 63; w2s[i] = w2[(size_t)l * 1024 + head * 64 + cc]; a2s[i] = a2[(size_t)l * 1024 + head * 64 + cc]; }
        float s[8];
#pragma unroll
        for (int e = 0; e < 8; ++e) s[e] = 0.f;
        __syncthreads();
        for (int p = 0; p < nch; ++p) {
            const int cidx = d ? nch - 1 - p : p; const int cbase = seqbase + cidx * 64;
            const size_t row = cbase + (d ? 63 - j : j);
            asm volatile("" ::: "memory");
            float w0c[8], a0c[8];
#pragma unroll
            for (int e = 0; e < 8; ++e) { w0c[e] = w0[hc8 + e]; a0c[e] = a0[hc8 + e]; }
            const u32x4_t rw = *(const u32x4_t*)(Rb + row * 1024 + hc8), kw = *(const u32x4_t*)(Kb + row * 1024 + hc8), vw = *(const u32x4_t*)(Vb + row * 1024 + hc8);
            const unsigned rwa[4] = {rw.x, rw.y, rw.z, rw.w}, kwa[4] = {kw.x, kw.y, kw.z, kw.w}, vwa[4] = {vw.x, vw.y, vw.z, vw.w};
            float rv[8], kv[8], vv[8], z[8], aa[8];
#pragma unroll
            for (int q = 0; q < 4; ++q) { rv[2 * q] = __uint_as_float(rwa[q] << 16); rv[2 * q + 1] = __uint_as_float(rwa[q] & 0xffff0000u); kv[2 * q] = __uint_as_float(kwa[q] << 16); kv[2 * q + 1] = __uint_as_float(kwa[q] & 0xffff0000u);
                vv[2 * q] = __uint_as_float(vwa[q] << 16); vv[2 * q + 1] = __uint_as_float(vwa[q] & 0xffff0000u); }
#pragma unroll
            for (int e = 0; e < 8; ++e) { z[e] = w0c[e]; aa[e] = a0c[e]; }
#pragma unroll 1
            for (int l8 = 0; l8 < 8; ++l8) { const u32x4_t hw = *(const u32x4_t*)(HWb + row * 128 + d * 64 + 8 * l8), ha = *(const u32x4_t*)(HAb + row * 128 + d * 64 + 8 * l8);
                const unsigned hwa[4] = {hw.x, hw.y, hw.z, hw.w}, haa[4] = {ha.x, ha.y, ha.z, ha.w};
#pragma unroll
                for (int q = 0; q < 4; ++q) {
#pragma unroll
                    for (int hh = 0; hh < 2; ++hh) { const int l = 8 * l8 + 2 * q + hh; const float hwv = hh ? __uint_as_float(hwa[q] & 0xffff0000u) : __uint_as_float(hwa[q] << 16); const float hav = hh ? __uint_as_float(haa[q] & 0xffff0000u) : __uint_as_float(haa[q] << 16);
                        const f32x4_t wa = *(const f32x4_t*)(w2s + l * 64 + c8), wb = *(const f32x4_t*)(w2s + l * 64 + c8 + 4), xa = *(const f32x4_t*)(a2s + l * 64 + c8), xb = *(const f32x4_t*)(a2s + l * 64 + c8 + 4);
#pragma unroll
                        for (int e = 0; e < 4; ++e) { z[e] += hwv * wa[e]; z[4 + e] += hwv * wb[e]; aa[e] += hav * xa[e]; aa[4 + e] += hav * xb[e]; }
                        if (hh) asm volatile("" ::: "memory"); } } }
            asm volatile("" ::: "memory");
            float kkc[8], kac[8], rkc[8];
#pragma unroll
            for (int e = 0; e < 8; ++e) { kkc[e] = pkk[hc8 + e]; kac[e] = pka[hc8 + e]; rkc[e] = prk[hc8 + e]; }
            float kk[8], ss = 0.f, bsum = 0.f;
#pragma unroll
            for (int e = 0; e < 8; ++e) { kk[e] = kv[e] * kkc[e]; ss += kk[e] * kk[e]; }
            ss += __shfl_xor(ss, 1); ss += __shfl_xor(ss, 2); ss += __shfl_xor(ss, 4);
            const float inv = rsqrtf(fmaxf(ss, 1e-24f));
#pragma unroll
            for (int e = 0; e < 8; ++e) { const float av = sigmoidf_(aa[e]); const float wv = __expf(-0.6065306597f * sigmoidf_(z[e])); const float kd = kv[e] * (1.0f + (av - 1.0f) * kac[e]); const float kkn = kk[e] * inv;
                bsum += rv[e] * kd * rkc[e];
                rS[j * 64 + c8 + e] = rv[e]; kdS[j * 64 + c8 + e] = kd; vS[j * 64 + c8 + e] = vv[e]; wS[j * 64 + c8 + e] = wv; kkS[j * 64 + c8 + e] = kkn; kkaS[j * 64 + c8 + e] = kkn * av; }
            bsum += __shfl_xor(bsum, 1); bsum += __shfl_xor(bsum, 2); bsum += __shfl_xor(bsum, 4);
            if (part == 0) beta[((size_t)d * SLAB + row) * 16 + head] = bsum;
            __syncthreads();
#pragma unroll 1
            for (int st = 0; st < 64; ++st) {
                const f32x4_t k0 = *(const f32x4_t*)(kkS + st * 64 + c8), k1 = *(const f32x4_t*)(kkS + st * 64 + c8 + 4);
                const f32x4_t wv0 = *(const f32x4_t*)(wS + st * 64 + c8), wv1 = *(const f32x4_t*)(wS + st * 64 + c8 + 4);
                const f32x4_t ka0 = *(const f32x4_t*)(kkaS + st * 64 + c8), ka1 = *(const f32x4_t*)(kkaS + st * 64 + c8 + 4);
                const f32x4_t kd0 = *(const f32x4_t*)(kdS + st * 64 + c8), kd1 = *(const f32x4_t*)(kdS + st * 64 + c8 + 4);
                const f32x4_t r0 = *(const f32x4_t*)(rS + st * 64 + c8), r1 = *(const f32x4_t*)(rS + st * 64 + c8 + 4);
                const float vi = vS[st * 64 + j];
                float sa = 0.f;
#pragma unroll
                for (int e = 0; e < 4; ++e) sa += s[e] * k0[e] + s[4 + e] * k1[e];
                sa += __shfl_xor(sa, 1); sa += __shfl_xor(sa, 2); sa += __shfl_xor(sa, 4);
                float y = 0.f;
#pragma unroll
                for (int e = 0; e < 4; ++e) { s[e] = s[e] * wv0[e] - sa * ka0[e] + vi * kd0[e]; s[4 + e] = s[4 + e] * wv1[e] - sa * ka1[e] + vi * kd1[e]; y += s[e] * r0[e] + s[4 + e] * r1[e]; }
                y += __shfl_xor(y, 1); y += __shfl_xor(y, 2); y += __shfl_xor(y, 4);
                if (part == 0) { const size_t orow = cbase + (d ? 63 - st : st); Op[orow * 1024 + head * 64 + j] = (bf16)f2bf(y); }
            }
            __syncthreads();
        }
    }
}

__device__ __forceinline__ void mm2(f32x4_t (&acc)[2], const bf16* A, const bf16* Bt, int mt, int ntb, int r16, int kq) {
#pragma unroll
    for (int kk = 0; kk < 2; ++kk) { const bf16x8_t av = *(const bf16x8_t*)(A + (16 * mt + r16) * 72 + 32 * kk + 8 * kq);
#pragma unroll
        for (int i = 0; i < 2; ++i) { const bf16x8_t bv = *(const bf16x8_t*)(Bt + (16 * (ntb + i) + r16) * 72 + 32 * kk + 8 * kq); acc[i] = __builtin_amdgcn_mfma_f32_16x16x32_bf16(av, bv, acc[i], 0, 0, 0); } }
}
__device__ __forceinline__ void st_rm(bf16* dst, const f32x4_t (&acc)[2], int mt, int ntb, int r16, int kq) {
#pragma unroll
    for (int i = 0; i < 2; ++i) { const unsigned w0 = pk2(acc[i][0], acc[i][1]), w1 = pk2(acc[i][2], acc[i][3]); bf16* d = dst + (16 * mt + 4 * kq) * 72 + 16 * (ntb + i) + r16;
        d[0] = (bf16)(w0 & 0xffffu); d[72] = (bf16)(w0 >> 16); d[144] = (bf16)(w1 & 0xffffu); d[216] = (bf16)(w1 >> 16); }
}
__device__ __forceinline__ void st_tr(bf16* dst, const f32x4_t (&acc)[2], int mt, int ntb, int r16, int kq) {
#pragma unroll
    for (int i = 0; i < 2; ++i) { u32x2_t w; w.x = pk2(acc[i][0], acc[i][1]); w.y = pk2(acc[i][2], acc[i][3]); *(u32x2_t*)(dst + (16 * (ntb + i) + r16) * 72 + 16 * mt + 4 * kq) = w; }
}
template <bool PA>
__device__ __forceinline__ void rwkv_scan_chunk(unsigned char* lds, const bf16* Rb, const bf16* Kb, const bf16* Vb, const bf16* HWb, const bf16* HAb, bf16* OFb, bf16* OBb, float* beta, float* segm, bf16* tbuf,
                                                ArgP a, int slab, int tid) {
    bf16* M = (bf16*)lds;
#define MAT(i) (M + (i) * 4608)
    bf16* w2T = MAT(13); bf16* a2T = MAT(14); float* wc = (float*)MAT(15); float* cst = wc + 64;
    float* zbuf = (float*)MAT(0); float* abuf = zbuf + 4096;
    float* cumb = (float*)MAT(10); float* segtot = cumb + 4096;
    const int nch = slab == 0 ? 129 : 257, G = slab == 0 ? 4 : 8, nitems = 256, NCHA = nch;
    const int lane = tid & 63, wave = tid >> 6, r16 = lane & 15, kq = lane >> 4, mt = wave >> 1, ntb = 2 * (wave & 1);
    const int j = tid >> 3, part = tid & 7, c8 = part * 8;
    const int tunit = ((j >> 3) + 1) * (4 * (j >> 3) + (j & 7)) + part; const bool tlow = part <= (j >> 3);
    for (int item = blockIdx.x; item < nitems; item += gridDim.x) {
        const int g = item % G, strm = item / G; const int p0 = g == 0 ? 0 : 1 + 32 * g, p1 = 33 + 32 * g;
        const bool haveT = !PA;
        const int d = strm & 1, head = (strm >> 1) & 15, sq = strm >> 5; const int seqbase = sq * 8256; const int hc8 = head * 64 + c8;
        bf16* Op = d ? OBb : OFb;
        const float* w0 = a->in[15] + d * 1024; const float* w2 = a->in[17] + (size_t)d * 64 * 1024; const float* a0 = a->in[18] + d * 1024; const float* a2 = a->in[20] + (size_t)d * 64 * 1024;
        __syncthreads();
        if (tid < 320) { const int wch = tid >> 6, cc = tid & 63; const float* src = wch == 0 ? w0 : (wch == 1 ? a0 : (wch == 2 ? a->in[23] : (wch == 3 ? a->in[24] : a->in[25]))); cst[tid] = src[head * 64 + cc]; }
        for (int i = tid; i < 4096; i += 512) { const int l = i >> 6, cc = i & 63; w2T[cc * 72 + l] = (bf16)f2bf(w2[(size_t)l * 1024 + head * 64 + cc]); a2T[cc * 72 + l] = (bf16)f2bf(a2[(size_t)l * 1024 + head * 64 + cc]); }
        f32x4_t Sacc[2], S2acc[2]; Sacc[0] = (f32x4_t){0.f, 0.f, 0.f, 0.f}; Sacc[1] = Sacc[0];
#pragma unroll
        for (int i = 0; i < 2; ++i)
#pragma unroll
            for (int e = 0; e < 4; ++e) S2acc[i][e] = (16 * mt + 4 * kq + e == 16 * (ntb + i) + r16) ? 1.f : 0.f;
        __syncthreads();
        if (!PA) {
            for (int gg = 0; gg < g; ++gg) {
                const float* Psi = segm + (size_t)(strm * G + gg) * 8192; const float* Phi = Psi + 4096;
                { const f32x4_t q0 = *(const f32x4_t*)(Phi + j * 64 + c8), q1 = *(const f32x4_t*)(Phi + j * 64 + c8 + 4);
#pragma unroll
                  for (int e = 0; e < 4; ++e) { MAT(1)[(c8 + e) * 72 + j] = (bf16)f2bf(q0[e]); MAT(1)[(c8 + 4 + e) * 72 + j] = (bf16)f2bf(q1[e]); } }
                st_rm(MAT(0), Sacc, mt, ntb, r16, kq);
                __syncthreads();
#pragma unroll
                for (int i = 0; i < 2; ++i)
#pragma unroll
                    for (int e = 0; e < 4; ++e) Sacc[i][e] = Psi[(16 * mt + 4 * kq + e) * 64 + 16 * (ntb + i) + r16];
                mm2(Sacc, MAT(0), MAT(1), mt, ntb, r16, kq);
                __syncthreads();
            }
        }
        for (int p = p0; p < p1; ++p) {
            const int cidx = d ? nch - 1 - p : p; const int cbase = seqbase + cidx * 64;
            float rv[8], kk[8], av[8], kd[8], lw[8]; u32x4_t tld = (u32x4_t){0u, 0u, 0u, 0u}, vraw = (u32x4_t){0u, 0u, 0u, 0u};
            {
                const size_t row = cbase + (d ? 63 - j : j);
                asm volatile("" ::: "memory");
                if (haveT && tlow) tld = *(const u32x4_t*)(tbuf + ((size_t)strm * NCHA + p) * 2304 + tunit * 8);
                *(u32x4_t*)(MAT(4) + j * 72 + c8) = *(const u32x4_t*)(HWb + row * 128 + d * 64 + c8);
                *(u32x4_t*)(MAT(5) + j * 72 + c8) = *(const u32x4_t*)(HAb + row * 128 + d * 64 + c8);
                const u32x4_t rw = *(const u32x4_t*)(Rb + row * 1024 + hc8), kw = *(const u32x4_t*)(Kb + row * 1024 + hc8), vw = *(const u32x4_t*)(Vb + row * 1024 + hc8);
                __syncthreads();
                { f32x4_t za[2], xa[2]; za[0] = (f32x4_t){0.f, 0.f, 0.f, 0.f}; za[1] = za[0]; xa[0] = za[0]; xa[1] = za[0];
                  mm2(za, MAT(4), w2T, mt, ntb, r16, kq); mm2(xa, MAT(5), a2T, mt, ntb, r16, kq);
#pragma unroll
                  for (int i = 0; i < 2; ++i)
#pragma unroll
                      for (int e = 0; e < 4; ++e) { zbuf[(16 * mt + 4 * kq + e) * 64 + 16 * (ntb + i) + r16] = za[i][e]; abuf[(16 * mt + 4 * kq + e) * 64 + 16 * (ntb + i) + r16] = xa[i][e]; } }
                __syncthreads();
                const unsigned rwa[4] = {rw.x, rw.y, rw.z, rw.w}, kwa[4] = {kw.x, kw.y, kw.z, kw.w};
                float kv[8], z[8], aa[8];
#pragma unroll
                for (int q = 0; q < 4; ++q) { rv[2 * q] = __uint_as_float(rwa[q] << 16); rv[2 * q + 1] = __uint_as_float(rwa[q] & 0xffff0000u); kv[2 * q] = __uint_as_float(kwa[q] << 16); kv[2 * q + 1] = __uint_as_float(kwa[q] & 0xffff0000u);
                }
                vraw = vw;
                { const f32x4_t z0 = *(const f32x4_t*)(zbuf + j * 64 + c8), z1 = *(const f32x4_t*)(zbuf + j * 64 + c8 + 4), x0 = *(const f32x4_t*)(abuf + j * 64 + c8), x1 = *(const f32x4_t*)(abuf + j * 64 + c8 + 4);
#pragma unroll
                  for (int e = 0; e < 4; ++e) { z[e] = cst[c8 + e] + z0[e]; z[4 + e] = cst[c8 + 4 + e] + z1[e]; aa[e] = cst[64 + c8 + e] + x0[e]; aa[4 + e] = cst[64 + c8 + 4 + e] + x1[e]; } }
                asm volatile("" ::: "memory");
                float ss = 0.f, bsum = 0.f;
#pragma unroll
                for (int e = 0; e < 8; ++e) { kk[e] = kv[e] * cst[128 + c8 + e]; ss += kk[e] * kk[e]; }
                ss += __shfl_xor(ss, 1); ss += __shfl_xor(ss, 2); ss += __shfl_xor(ss, 4);
                const float inv = rsqrtf(fmaxf(ss, 1e-24f));
#pragma unroll
                for (int e = 0; e < 8; ++e) { av[e] = sigmoidf_(aa[e]); lw[e] = -0.6065306597f * sigmoidf_(z[e]); kd[e] = kv[e] * (1.0f + (av[e] - 1.0f) * cst[192 + c8 + e]); kk[e] *= inv; bsum += rv[e] * kd[e] * cst[256 + c8 + e]; }
                bsum += __shfl_xor(bsum, 1); bsum += __shfl_xor(bsum, 2); bsum += __shfl_xor(bsum, 4);
                if (!PA && part == 0) beta[((size_t)d * SLAB + row) * 16 + head] = bsum;
                *(f32x4_t*)(cumb + j * 64 + c8) = (f32x4_t){lw[0], lw[1], lw[2], lw[3]}; *(f32x4_t*)(cumb + j * 64 + c8 + 4) = (f32x4_t){lw[4], lw[5], lw[6], lw[7]};
            }
            __syncthreads();
            { const int c = tid & 63, sg = tid >> 6; float run = 0.f;
#pragma unroll
              for (int i = 0; i < 8; ++i) { run += cumb[(8 * sg + i) * 64 + c]; cumb[(8 * sg + i) * 64 + c] = run; }
              segtot[sg * 64 + c] = run; }
            __syncthreads();
            { const int c = tid & 63, sg = tid >> 6; float off = 0.f;
#pragma unroll
              for (int s = 0; s < 7; ++s) off += (s < sg) ? segtot[s * 64 + c] : 0.f;
#pragma unroll
              for (int i = 0; i < 8; ++i) cumb[(8 * sg + i) * 64 + c] += off; }
            __syncthreads();
            {
                const f32x4_t c0 = *(const f32x4_t*)(cumb + j * 64 + c8), c1 = *(const f32x4_t*)(cumb + j * 64 + c8 + 4);
                float ah[8], bh[8], kh[8], rh[8];
#pragma unroll
                for (int e = 0; e < 8; ++e) { const float cu = e < 4 ? c0[e & 3] : c1[e & 3]; const float Wt = __expf(cu), iW = __expf(-cu), Wm1 = __expf(cu - lw[e]);
                    ah[e] = kk[e] * Wm1; bh[e] = -(kk[e] * av[e]) * iW; kh[e] = kd[e] * iW; rh[e] = rv[e] * Wt;
                    if (j == 63) wc[c8 + e] = Wt; }
                u32x4_t w;
                w.x = pk2(ah[0], ah[1]); w.y = pk2(ah[2], ah[3]); w.z = pk2(ah[4], ah[5]); w.w = pk2(ah[6], ah[7]); *(u32x4_t*)(MAT(0) + j * 72 + c8) = w;
                u32x4_t wb, wk;
                wb.x = pk2(bh[0], bh[1]); wb.y = pk2(bh[2], bh[3]); wb.z = pk2(bh[4], bh[5]); wb.w = pk2(bh[6], bh[7]); *(u32x4_t*)(MAT(1) + j * 72 + c8) = wb;
                wk.x = pk2(kh[0], kh[1]); wk.y = pk2(kh[2], kh[3]); wk.z = pk2(kh[4], kh[5]); wk.w = pk2(kh[6], kh[7]); *(u32x4_t*)(MAT(2) + j * 72 + c8) = wk;
                w.x = pk2(rh[0], rh[1]); w.y = pk2(rh[2], rh[3]); w.z = pk2(rh[4], rh[5]); w.w = pk2(rh[6], rh[7]); *(u32x4_t*)(MAT(3) + j * 72 + c8) = w;
                { const unsigned wba[4] = {wb.x, wb.y, wb.z, wb.w}, wka[4] = {wk.x, wk.y, wk.z, wk.w}, wva[4] = {vraw.x, vraw.y, vraw.z, vraw.w};
#pragma unroll
                  for (int q = 0; q < 4; ++q) { bf16* d4 = MAT(4) + (c8 + 2 * q) * 72 + j; bf16* d5 = MAT(5) + (c8 + 2 * q) * 72 + j; bf16* d6 = MAT(6) + (c8 + 2 * q) * 72 + j;
                      d4[0] = (bf16)(wba[q] & 0xffffu); d4[72] = (bf16)(wba[q] >> 16); d5[0] = (bf16)(wka[q] & 0xffffu); d5[72] = (bf16)(wka[q] >> 16); d6[0] = (bf16)(wva[q] & 0xffffu); d6[72] = (bf16)(wva[q] >> 16); } }
                if (haveT) *(u32x4_t*)(MAT(9) + j * 72 + c8) = tld;
                st_rm(MAT(7), Sacc, mt, ntb, r16, kq);
                if (PA) st_rm(MAT(12), S2acc, mt, ntb, r16, kq);
            }
            __syncthreads();
            f32x4_t Pacc[2], Tacc[2], Xacc[2], Yacc[2], tmp[2];
            const f32x4_t z4 = (f32x4_t){0.f, 0.f, 0.f, 0.f};
            Tacc[0] = z4; Tacc[1] = z4;
            if (!haveT) {
            Pacc[0] = z4; Pacc[1] = z4; mm2(Pacc, MAT(0), MAT(1), mt, ntb, r16, kq);
#pragma unroll
            for (int i = 0; i < 2; ++i)
#pragma unroll
                for (int e = 0; e < 4; ++e) { const int t = 16 * mt + 4 * kq + e, s = 16 * (ntb + i) + r16; Pacc[i][e] = (s < t) ? Pacc[i][e] : 0.f; Tacc[i][e] = Pacc[i][e] + ((s == t) ? 1.f : 0.f); }
            st_rm(MAT(8), Pacc, mt, ntb, r16, kq); st_tr(MAT(9), Pacc, mt, ntb, r16, kq);
            }
            tmp[0] = z4; tmp[1] = z4; mm2(tmp, MAT(0), MAT(2), mt, ntb, r16, kq);
#pragma unroll
            for (int i = 0; i < 2; ++i)
#pragma unroll
                for (int e = 0; e < 4; ++e) { const int t = 16 * mt + 4 * kq + e, s = 16 * (ntb + i) + r16; tmp[i][e] = (s < t) ? tmp[i][e] : 0.f; }
            st_rm(MAT(10), tmp, mt, ntb, r16, kq);
            f32x4_t X2acc[2]; X2acc[0] = z4; X2acc[1] = z4;
            if (PA) mm2(X2acc, MAT(0), MAT(12), mt, ntb, r16, kq);
            if (!PA) {
            tmp[0] = z4; tmp[1] = z4; mm2(tmp, MAT(3), MAT(1), mt, ntb, r16, kq);
#pragma unroll
            for (int i = 0; i < 2; ++i)
#pragma unroll
                for (int e = 0; e < 4; ++e) { const int t = 16 * mt + 4 * kq + e, s = 16 * (ntb + i) + r16; tmp[i][e] = (s <= t) ? tmp[i][e] : 0.f; }
            st_rm(MAT(11), tmp, mt, ntb, r16, kq);
            tmp[0] = z4; tmp[1] = z4; mm2(tmp, MAT(3), MAT(2), mt, ntb, r16, kq);
#pragma unroll
            for (int i = 0; i < 2; ++i)
#pragma unroll
                for (int e = 0; e < 4; ++e) { const int t = 16 * mt + 4 * kq + e, s = 16 * (ntb + i) + r16; tmp[i][e] = (s <= t) ? tmp[i][e] : 0.f; }
            st_rm(MAT(12), tmp, mt, ntb, r16, kq);
            }
            Xacc[0] = z4; Xacc[1] = z4; mm2(Xacc, MAT(0), MAT(7), mt, ntb, r16, kq);
            Yacc[0] = z4; Yacc[1] = z4; if (!PA) mm2(Yacc, MAT(3), MAT(7), mt, ntb, r16, kq);
            __syncthreads();
            if (!haveT) {
            tmp[0] = z4; tmp[1] = z4; mm2(tmp, MAT(8), MAT(9), mt, ntb, r16, kq);
            st_rm(MAT(0), tmp, mt, ntb, r16, kq); st_tr(MAT(1), tmp, mt, ntb, r16, kq); st_rm(MAT(2), Tacc, mt, ntb, r16, kq);
            __syncthreads();
#pragma unroll
            for (int i = 1; i <= 5; ++i) {
                bf16* Pc = (i & 1) ? MAT(0) : MAT(8); bf16* PcT = (i & 1) ? MAT(1) : MAT(9); bf16* Pn = (i & 1) ? MAT(8) : MAT(0); bf16* PnT = (i & 1) ? MAT(9) : MAT(1);
                bf16* Tc = (i & 1) ? MAT(2) : MAT(3); bf16* Tn = (i & 1) ? MAT(3) : MAT(2);
                mm2(Tacc, Tc, PcT, mt, ntb, r16, kq);
                if (i < 5) { tmp[0] = z4; tmp[1] = z4; mm2(tmp, Pc, PcT, mt, ntb, r16, kq); st_rm(Pn, tmp, mt, ntb, r16, kq); st_tr(PnT, tmp, mt, ntb, r16, kq); }
                st_rm(Tn, Tacc, mt, ntb, r16, kq);
                __syncthreads();
            }
            }
            if (PA && tlow) *(u32x4_t*)(tbuf + ((size_t)strm * NCHA + p) * 2304 + tunit * 8) = *(const u32x4_t*)(MAT(3) + j * 72 + c8);
            const bf16* Tm = haveT ? MAT(9) : MAT(3);
            mm2(Xacc, MAT(10), MAT(6), mt, ntb, r16, kq);
            st_tr(MAT(7), Xacc, mt, ntb, r16, kq);
            if (PA) st_tr(MAT(11), X2acc, mt, ntb, r16, kq);
            __syncthreads();
            tmp[0] = z4; tmp[1] = z4; mm2(tmp, Tm, MAT(7), mt, ntb, r16, kq);
            st_tr(MAT(8), tmp, mt, ntb, r16, kq);
            if (PA) { tmp[0] = z4; tmp[1] = z4; mm2(tmp, MAT(3), MAT(11), mt, ntb, r16, kq); st_tr(MAT(12), tmp, mt, ntb, r16, kq); }
            __syncthreads();
            if (!PA) { mm2(Yacc, MAT(11), MAT(8), mt, ntb, r16, kq); mm2(Yacc, MAT(12), MAT(6), mt, ntb, r16, kq);
            st_rm(MAT(7), Yacc, mt, ntb, r16, kq); }
            if (PA) mm2(S2acc, MAT(12), MAT(4), mt, ntb, r16, kq);
            mm2(Sacc, MAT(8), MAT(4), mt, ntb, r16, kq); mm2(Sacc, MAT(6), MAT(5), mt, ntb, r16, kq);
#pragma unroll
            for (int i = 0; i < 2; ++i) { const float wk = wc[16 * (ntb + i) + r16];
#pragma unroll
                for (int e = 0; e < 4; ++e) { Sacc[i][e] *= wk; S2acc[i][e] *= wk; } }
            __syncthreads();
            if (!PA) { const size_t orow = cbase + (d ? 63 - j : j); *(u32x4_t*)(Op + orow * 1024 + hc8) = *(const u32x4_t*)(MAT(7) + j * 72 + c8); }
        }
        if (PA) { float* Psi = segm + (size_t)item * 8192; float* Phi = Psi + 4096;
#pragma unroll
            for (int i = 0; i < 2; ++i)
#pragma unroll
                for (int e = 0; e < 4; ++e) { Psi[(16 * mt + 4 * kq + e) * 64 + 16 * (ntb + i) + r16] = Sacc[i][e]; Phi[(16 * mt + 4 * kq + e) * 64 + 16 * (ntb + i) + r16] = S2acc[i][e]; } }
    }
#undef MAT
}

__device__ __forceinline__ void rwkv_gn(bf16* OFb, const bf16* OBb, const bf16* Vb, const float* beta, const float* gnw, const float* gnb, int tid) {
    const int lane = tid & 63, wave = tid >> 6; const int gw = blockIdx.x * 8 + wave, NGW = gridDim.x * 8;
    for (int r = gw; r < SLAB; r += NGW) {
        const size_t off = (size_t)r * 1024 + 16 * lane; const int head = lane >> 2;
        float y[16], v[16]; float sm = 0.f;
#pragma unroll
        for (int h = 0; h < 2; ++h) { const u32x4_t a = *(const u32x4_t*)(OFb + off + 8 * h), b = *(const u32x4_t*)(OBb + off + 8 * h), vv = *(const u32x4_t*)(Vb + off + 8 * h);
            const unsigned aw[4] = {a.x, a.y, a.z, a.w}, bw[4] = {b.x, b.y, b.z, b.w}, vw[4] = {vv.x, vv.y, vv.z, vv.w};
#pragma unroll
            for (int q = 0; q < 4; ++q) { y[8 * h + 2 * q] = __uint_as_float(aw[q] << 16) + __uint_as_float(bw[q] << 16); y[8 * h + 2 * q + 1] = __uint_as_float(aw[q] & 0xffff0000u) + __uint_as_float(bw[q] & 0xffff0000u);
                v[8 * h + 2 * q] = __uint_as_float(vw[q] << 16); v[8 * h + 2 * q + 1] = __uint_as_float(vw[q] & 0xffff0000u); } }
#pragma unroll
        for (int i = 0; i < 16; ++i) sm += y[i];
        sm += __shfl_xor(sm, 1); sm += __shfl_xor(sm, 2);
        const float mean = sm * (1.0f / 64.0f); float sv = 0.f;
#pragma unroll
        for (int i = 0; i < 16; ++i) { const float dd = y[i] - mean; sv += dd * dd; }
        sv += __shfl_xor(sv, 1); sv += __shfl_xor(sv, 2);
        const float rs = rsqrtf(sv * (1.0f / 64.0f) + 64e-5f);
        const float bt = beta[(size_t)r * 16 + head] + beta[((size_t)SLAB + r) * 16 + head];
        float res[16];
#pragma unroll
        for (int i = 0; i < 16; ++i) res[i] = (y[i] - mean) * rs * gnw[16 * lane + i] + gnb[16 * lane + i] + bt * v[i];
#pragma unroll
        for (int h = 0; h < 2; ++h) { u32x4_t w; w.x = pk2(res[8 * h], res[8 * h + 1]); w.y = pk2(res[8 * h + 2], res[8 * h + 3]); w.z = pk2(res[8 * h + 4], res[8 * h + 5]); w.w = pk2(res[8 * h + 6], res[8 * h + 7]);
            *(u32x4_t*)(OFb + off + 8 * h) = w; }
    }
}

__device__ __forceinline__ void final_norm(const bf16* HBN, const float* ssq, const float* gain, float* out, int tid) {
    const int lane = tid & 63, wave = tid >> 6; const int gw = blockIdx.x * 8 + wave, NGW = gridDim.x * 8;
    for (int g = gw; g < 32768; g += NGW) {
        const int row = (g < 16384) ? 16640 + 64 + g : (g < 24576 ? 64 + (g - 16384) : 8256 + 64 + (g - 24576));
        const float rs = rsqrtf(pg8::row_ssq16(ssq, row) * (1.0f / 1024.0f) + NEPS);
#pragma unroll
        for (int jx = 0; jx < 4; ++jx) { const int col = 4 * lane + 256 * jx; const u32x2_t w = *(const u32x2_t*)(HBN + (size_t)row * 1024 + col); const f32x4_t gg = *(const f32x4_t*)(gain + col);
            f32x4_t o; o[0] = __uint_as_float(w.x << 16) * rs * gg[0]; o[1] = __uint_as_float(w.x & 0xffff0000u) * rs * gg[1]; o[2] = __uint_as_float(w.y << 16) * rs * gg[2]; o[3] = __uint_as_float(w.y & 0xffff0000u) * rs * gg[3];
            *(f32x4_t*)(out + (size_t)g * 1024 + col) = o; }
    }
}

#ifndef PHM
#define PHM 4095
#endif
__global__ void __launch_bounds__(512, 2) fwd_mega(Args a_) {
    ArgP ap0 = (ArgP)__builtin_amdgcn_kernarg_segment_ptr();
    extern __shared__ __attribute__((aligned(16))) unsigned char lds[];
    cg::grid_group grid = cg::this_grid();
    PG8_LAS float* edge = (PG8_LAS float*)((PG8_LAS unsigned char*)lds + RING_BYTES);
    volatile LAS unsigned* bst = (volatile LAS unsigned*)((LAS unsigned char*)lds + LDS_BYTES - 16);
    const int wave_s = __builtin_amdgcn_readfirstlane(threadIdx.x >> 6);
    if (threadIdx.x < 4) bst[threadIdx.x] = 0u;
    __syncthreads();
    XcdBarrier xbar = xcd_barrier_post((unsigned*)(ap0->ws + WS_BAR), bst);
    grid.sync();
#pragma unroll 1
    for (int phc = 0; phc < 30; ++phc) {
        int ph = phc; asm volatile("" : "+s"(ph));
        int kind = 15, slab = 0;
        if (ph == 0) kind = 0;
        else if (ph <= 10) { const int q = (ph - 1) % 5; slab = (ph - 1) / 5; kind = q == 0 ? 1 : (q == 1 ? 14 : (q == 2 ? 2 : (q == 3 ? 3 : 4))); }
        else if (ph == 11) kind = 5; else if (ph == 12) kind = 6;
        else if (ph <= 26) { kind = 7 + (ph - 13) % 7; slab = (ph - 13) / 7; }
        else if (ph == 27) { kind = 5; slab = 1; } else if (ph == 28) { kind = 6; slab = 1; }
        ArgP ap = LAUNDER_ARGS(ap0);
        unsigned char* dob = (unsigned char*)ap->out; unsigned char* ws = ap->ws;
        bf16* HB = (bf16*)(dob + DO_HB); float* ssq = (float*)(ws + WS_SSQ); bf16* BIG = (bf16*)(ws + WS_BIG);
        unsigned zl = 0u; asm volatile("" : "+v"(zl));
        const int tid = wave_s * 64 + (int)__builtin_amdgcn_mbcnt_hi(~0u, __builtin_amdgcn_mbcnt_lo(~0u, zl));
        const int row0 = slab * SLAB;
        switch (kind) {
        case 0: if (PHM & 1) p0_prologue(ap, lds, tid); break;
        case 1: { pg8::EpiHgIn E{BIG, ssq + row0};
                  if (PHM & 2) run_gemm<pg8::EpiHgIn, true>(lds, HB + (size_t)row0 * 1024, (const bf16*)(dob + DO_WHG), 65, 20, 1024, 256, E, tid); } break;
        case 2: if (PHM & 4) hgrn_scan<false>(lds, BIG, BIG + SLABE, BIG + 2 * SLABE, BIG + 3 * SLABE, BIG + 5 * SLABE, BIG + 6 * SLABE, ap->in[8], (float*)(ws + WS_HW), slab, tid); break;
        case 14: if (PHM & 4) hgrn_scan<true>(lds, BIG, BIG + SLABE, BIG + 2 * SLABE, BIG + 3 * SLABE, BIG + 5 * SLABE, BIG + 6 * SLABE, ap->in[8], (float*)(ws + WS_HW), slab, tid); break;
        case 3: if (PHM & 8) hgrn_gate(BIG + 5 * SLABE, BIG + 6 * SLABE, BIG + 4 * SLABE, ap->in[9], tid); break;
        case 4: case 6: case 13: {
                  const bf16* A; const bf16* Bt; int nM, K, r0; float* sq; bf16* hout = HB;
                  if (kind == 4) { A = BIG + 4 * SLABE; Bt = (const bf16*)(dob + DO_WHGO); nM = 65; K = 1024; r0 = row0; sq = (float*)(ws + WS_PA); }
                  else if (kind == 13) { A = BIG; Bt = (const bf16*)(dob + DO_WRWO); nM = 65; K = 1024; r0 = row0; sq = (float*)(ws + WS_PA); }
                  else { A = (const bf16*)(ws + WS_ACT); Bt = (const bf16*)(dob + (slab ? DO_WF1O : DO_WF0O)); nM = 130; K = 2816; r0 = 0; sq = (float*)(ws + WS_PB); if (slab) hout = (bf16*)(ws + WS_HBNEW); }
                  pg8::EpiRes E{HB, hout, sq, r0};
                  if (PHM & 16) run_gemm<pg8::EpiRes, true>(lds, A, Bt, nM, 4, K, 256, E, tid); } break;
        case 5: { pg8::EpiFfnIn E{(bf16*)(ws + WS_ACT), (const float*)(ws + WS_PA), ap->in[29] + slab * 3 * FFN, ap->in[30] + slab * FFN, edge};
                  if (PHM & 32) run_gemm<pg8::EpiFfnIn, true>(lds, HB, (const bf16*)(dob + (slab ? DO_WF1I : DO_WF0I)), 131, 22, 1024, 254, E, tid); } break;
        case 7: if (PHM & 64) rwkv_mix(HB, (const float*)(ws + WS_PB), ap->in[3] + 1024, ap->in[10], BIG, BIG + 2 * SLABE, row0, tid); break;
        case 8: {
                  int c = (int)blockIdx.x, gd = (int)gridDim.x; asm volatile("" : "+s"(c), "+s"(gd));
                  { pg8::BalOrder S{65, 2, 130, gd, c, 0};
                    pg8::EpiLora E{(bf16*)(ws + WS_HW), (bf16*)(ws + WS_HA), (bf16*)(ws + WS_HG)};
                    if (PHM & 128) run_gemm_list<pg8::EpiLora>(lds, BIG, (const bf16*)(dob + DO_WLORA), 2048, 2048, 0u, 0u, S, E, tid); }
                  { pg8::BalOrder S{65, 12, 780, gd, c, 1};
                    pg8::EpiRkv E{BIG + 4 * SLABE};
                    if (PHM & 128) run_gemm_list<pg8::EpiRkv>(lds, BIG, (const bf16*)(dob + DO_WRW1), 1024, 2048, (unsigned)(2 * SLABE * 2), (unsigned)(2 * SLABE * 2 + 2048), S, E, tid); } } break;
        case 9: if (PHM & 256) rwkv_scan_chunk<true>(lds, BIG + 4 * SLABE, BIG + 5 * SLABE, BIG + 6 * SLABE, (const bf16*)(ws + WS_HW), (const bf16*)(ws + WS_HA), BIG + 2 * SLABE, BIG + 3 * SLABE, (float*)(ws + WS_BETA), (float*)BIG, (bf16*)((unsigned char*)BIG + 8388608), ap, slab, tid); break;
        case 10: if (PHM & 256) rwkv_scan_chunk<false>(lds, BIG + 4 * SLABE, BIG + 5 * SLABE, BIG + 6 * SLABE, (const bf16*)(ws + WS_HW), (const bf16*)(ws + WS_HA), BIG + 2 * SLABE, BIG + 3 * SLABE, (float*)(ws + WS_BETA), (float*)BIG, (bf16*)((unsigned char*)BIG + 8388608), ap, slab, tid); break;
        case 11: if (PHM & 512) rwkv_gn(BIG + 2 * SLABE, BIG + 3 * SLABE, BIG + 6 * SLABE, (const float*)(ws + WS_BETA), ap->in[26], ap->in[27], tid); break;
        case 12: { pg8::EpiGate E{BIG + 2 * SLABE, BIG};
                  if (PHM & 1024) run_gemm<pg8::EpiGate, true>(lds, (const bf16*)(ws + WS_HG), (const bf16*)(dob + DO_WG2), 65, 4, 256, 256, E, tid); } break;
        default: if (PHM & 2048) final_norm((const bf16*)(ws + WS_HBNEW), (const float*)(ws + WS_PB), ap->in[5], ap->out, tid); break;
        }
        if (phc < 29) { unsigned z2 = 0u; asm volatile("" : "+v"(z2)); const int t2 = wave_s * 64 + (int)__builtin_amdgcn_mbcnt_hi(~0u, __builtin_amdgcn_mbcnt_lo(~0u, z2)); xcd_barrier(xbar, t2); }
    }
}

extern "C" void kernel_launch(void* const* d_in, const int* in_sizes, int n_in, void* d_out, int out_size, void* d_ws, size_t ws_size, hipStream_t stream) {
    static int grid = 0;
    if (grid == 0) {
        if (n_in != 32 || ws_size < WS_NEED || out_size != 32768 * 1024) { fprintf(stderr, "kernel_launch: unexpected shapes (n_in %d, ws %zu, out %d)\n", n_in, ws_size, out_size); grid = -1; return; }
        int dev = 0, cus = 0, per_cu = 0;
        hipGetDevice(&dev); hipDeviceGetAttribute(&cus, hipDeviceAttributeMultiprocessorCount, dev);
        if (hipFuncSetAttribute((const void*)fwd_mega, hipFuncAttributeMaxDynamicSharedMemorySize, LDS_BYTES) != hipSuccess) { fprintf(stderr, "kernel_launch: hipFuncSetAttribute failed\n"); grid = -1; return; }
        if (hipOccupancyMaxActiveBlocksPerMultiprocessor(&per_cu, (const void*)fwd_mega, 512, LDS_BYTES) != hipSuccess || per_cu < 1) { fprintf(stderr, "kernel_launch: occupancy query says %d\n", per_cu); per_cu = 1; }
        (void)hipGetLastError();
        grid = cus;
    }
    if (grid < 0) return;
    if (hipMemsetAsync((char*)d_ws + WS_BAR, 0, 16384, stream) != hipSuccess) { fprintf(stderr, "kernel_launch: memset failed\n"); return; }
    Args a{};
    for (int i = 0; i < 32; ++i) a.in[i] = (const float*)d_in[i];
    a.out = (float*)d_out; a.ws = (unsigned char*)d_ws;
    void* args[] = {&a};
    hipError_t e = hipLaunchCooperativeKernel((const void*)fwd_mega, dim3(grid), dim3(512), args, LDS_BYTES, stream);
    if (e != hipSuccess) fprintf(stderr, "kernel_launch: cooperative launch failed: %s (grid %d)\n", hipGetErrorString(e), grid);
}
```

```cpp
#include <hip/hip_runtime.h>
#include <hip/hip_cooperative_groups.h>
#include <cstdio>
#include <cstdint>
namespace cg = cooperative_groups;

constexpr int D_ = 1024, FFN = 2816, TROWS = 33280, SLAB = 16640;
constexpr size_t SLABE = (size_t)SLAB * 1024;
constexpr float NEPS = 1e-6f;
__host__ __device__ __forceinline__ bool row_is_pad(int r) {
    int o;
    if (r < 8256) o = r; else if (r < 16512) o = r - 8256; else if (r < 16640) return true; else if (r < 33088) o = r - 16640; else return true;
    return o < 48;
}
__device__ __forceinline__ float bf2f(unsigned short v) { return __uint_as_float(((unsigned)v) << 16); }
typedef float f32x2_cv __attribute__((ext_vector_type(2)));
typedef __bf16 bf16x2_cv __attribute__((ext_vector_type(2)));
__device__ __forceinline__ unsigned pk2(float lo, float hi) { const f32x2_cv v = {lo, hi}; const bf16x2_cv b = __builtin_convertvector(v, bf16x2_cv); return __builtin_bit_cast(unsigned, b); }
__device__ __forceinline__ unsigned f2bf(float f) { return pk2(f, 0.f) & 0xffffu; }
__device__ __forceinline__ float sigmoidf_(float x) { return __builtin_amdgcn_rcpf(1.0f + __expf(-x)); }
namespace pg8 {
#define PG8_LAS __attribute__((address_space(3)))
typedef unsigned short bf16_t;
typedef short bf16x8 __attribute__((ext_vector_type(8)));
typedef float f32x4 __attribute__((ext_vector_type(4)));
typedef unsigned u32x4 __attribute__((ext_vector_type(4)));
constexpr int BM = 256, BK = 64, HALF = 128, HTB = HALF * BK * 2  , STAGE_BYTES = 8 * HTB, NXCD = 8, WGM = 8;

__host__ __device__ __forceinline__ int lds_byte(int r, int c) { const int st = (r >> 4) * 2 + (c >> 5), rr = r & 15, cc = c & 31, ob = rr * 64 + cc * 2; return st * 1024 + (ob ^ (((ob >> 9) & 1) << 5)); }
__host__ __device__ __forceinline__ void stage_rc(int b, int& R, int& C) { const int st = b / 1024, sb = b % 1024, swz = sb ^ (((sb >> 9) & 1) << 5); R = (st >> 1) * 16 + swz / 64; C = (st & 1) * 32 + (swz % 64) / 2; }
__host__ __device__ __forceinline__ int perm32(int rho) { const int n = rho >> 4, i = rho & 15; return 8 * (i >> 2) + 4 * n + (i & 3); }

struct Unit { int pm, pn; };
struct Gemm { const bf16_t* A; const bf16_t* Bt; int M, N, K, a_tile_rows, lda; unsigned a_off1, a_off2; };
__device__ __forceinline__ size_t a_unit_off(const Gemm& g, int pn) { return pn >= 8 ? (size_t)g.a_off2 : (pn >= 4 ? (size_t)g.a_off1 : (size_t)0); }

struct StaticOrder {
    int nM, nN, nwg, G, c;
    __host__ __device__ void init(int M, int N, int G_, int c_) { nM = M / BM; nN = N / BM; nwg = nM * nN; G = G_; c = c_; }
    __host__ __device__ bool next(int i, Unit& u) const {
        const long L = (long)i * G + c; if (L >= nwg) return false;
        int wgid = (int)L; { const int q = nwg / NXCD, r = nwg % NXCD, xcd = wgid % NXCD, off = wgid / NXCD; wgid = (xcd < r ? xcd * (q + 1) : r * (q + 1) + (xcd - r) * q) + off; }
        const int nig = WGM * nN, gid = wgid / nig, fm = gid * WGM, gsz = (nM - fm) < WGM ? (nM - fm) : WGM;
        u.pm = fm + ((wgid % nig) % gsz); u.pn = (wgid % nig) / gsz; return true;
    }
    __device__ __forceinline__ void a_ready(const Unit&) const {}
    __device__ __forceinline__ void done(const Unit&) const {}
};

struct BalOrder {
    int nM, nN, nwg, G, c, mode;
    __device__ bool next(int i, Unit& u) const {
        long L;
        if (G != 256) { L = (long)i * G + c; }
        else if (mode == 0) { if (i > 0 || c >= 130) return false; L = c; }
        else { if (i < 2) L = 256 * i + c; else { if (c < 130) return false; const int h = c - 130; if (i == 2) L = 512 + h; else if (i == 3) L = 638 + h; else if (i == 4 && h < 16) L = 764 + h; else return false; } }
        if (L >= nwg) return false;
        int wgid = (int)L; { const int q = nwg / NXCD, r = nwg % NXCD, xcd = wgid % NXCD, off = wgid / NXCD; wgid = (xcd < r ? xcd * (q + 1) : r * (q + 1) + (xcd - r) * q) + off; }
        const int nig = WGM * nN, gid = wgid / nig, fm = gid * WGM, gsz = (nM - fm) < WGM ? (nM - fm) : WGM;
        u.pm = fm + ((wgid % nig) % gsz); u.pn = (wgid % nig) / gsz; return true;
    }
    __device__ __forceinline__ void a_ready(const Unit&) const {}
    __device__ __forceinline__ void done(const Unit&) const {}
};

__device__ __forceinline__ unsigned cvt_pk_bf16(float lo, float hi) { return pk2(lo, hi); }
typedef float f32x2 __attribute__((ext_vector_type(2)));
__device__ __forceinline__ f32x2 gelu_pk(f32x2 v) {
    const f32x2 av = __builtin_elementwise_abs(v), d = av * 0.2316418882f + 1.0f;
    f32x2 t; t.x = __builtin_amdgcn_rcpf(d.x); t.y = __builtin_amdgcn_rcpf(d.y);
    f32x2 q = t * 0.5307027145f + (-0.7265760135f); q = q * t + 0.7107068705f; q = q * t + (-0.142248368f); q = q * t + 0.127414796f; q = q * t;
    const f32x2 s = (v * v) * (-0.72134752044f);
    f32x2 e; e.x = __builtin_amdgcn_exp2f(s.x); e.y = __builtin_amdgcn_exp2f(s.y);
    const f32x2 m = v * (q * e), r = v - m;
    f32x2 o; o.x = v.x < 0.f ? m.x : r.x; o.y = v.y < 0.f ? m.y : r.y; return o;
}


typedef unsigned u32x2 __attribute__((ext_vector_type(2)));
__device__ __forceinline__ u32x4 pack8(const f32x4 a, const f32x4 b) { u32x4 w; w.x = cvt_pk_bf16(a[0], a[1]); w.y = cvt_pk_bf16(a[2], a[3]); w.z = cvt_pk_bf16(b[0], b[1]); w.w = cvt_pk_bf16(b[2], b[3]); return w; }
__device__ __forceinline__ float silu_(float v) { return v * __builtin_amdgcn_rcpf(1.0f + __expf(-v)); }
__device__ __forceinline__ float gelu_tanh_(float x) { const float y = 1.5957691216f * (x + 0.044715f * x * x * x); return x * __builtin_amdgcn_rcpf(1.0f + __expf(-y)); }

__device__ __forceinline__ float row_ssq16(const float* part, int row) { const f32x4* p = (const f32x4*)(part + (size_t)row * 16); const f32x4 a = p[0], b = p[1], c = p[2], d = p[3];
    return (((a[0] + a[1]) + (a[2] + a[3])) + ((b[0] + b[1]) + (b[2] + b[3]))) + (((c[0] + c[1]) + (c[2] + c[3])) + ((d[0] + d[1]) + (d[2] + d[3]))); }

struct EpiHgIn {
    static constexpr bool PERM = true, AFTER_DRAIN = false;
    bf16_t* base; const float* ssq;
    __device__ __forceinline__ void operator()(const f32x4 (&acc)[2][2][4][2], const Unit& u, int wr, int wc, int fr, int fq) const {
        const int which = u.pn >> 2; const int colt = (u.pn & 3) * 256 + wc * 32 + 8 * fq;
        bf16_t* dst = base + (size_t)which * SLABE; const bool act = (which == 0) || (which == 4);
#pragma unroll
        for (int ai = 0; ai < 2; ++ai)
#pragma unroll
            for (int m = 0; m < 4; ++m) { const int row = u.pm * 256 + ai * 128 + wr * 64 + m * 16 + fr; const float rs = rsqrtf(ssq[row] * (1.0f / 1024.0f) + NEPS);
#pragma unroll
                for (int bj = 0; bj < 2; ++bj) { f32x4 v0 = acc[ai][bj][m][0] * rs, v1 = acc[ai][bj][m][1] * rs;
                    if (act) {
#pragma unroll
                        for (int e = 0; e < 4; ++e) { v0[e] = silu_(v0[e]); v1[e] = silu_(v1[e]); } }
                    *(u32x4*)(dst + (size_t)row * 1024 + colt + bj * 128) = pack8(v0, v1); } }
    }
};

struct EpiRes {
    static constexpr bool PERM = true, AFTER_DRAIN = false;
    const bf16_t* hin; bf16_t* hout; float* ssq; int row0;
    __device__ __forceinline__ void operator()(const f32x4 (&acc)[2][2][4][2], const Unit& u, int wr, int wc, int fr, int fq) const {
        const int col0 = u.pn * 256 + wc * 32 + 8 * fq;
#pragma unroll
        for (int ai = 0; ai < 2; ++ai)
#pragma unroll
            for (int m = 0; m < 4; ++m) { const int row = row0 + u.pm * 256 + ai * 128 + wr * 64 + m * 16 + fr; const bool pad = row_is_pad(row); float s = 0.f;
#pragma unroll
                for (int bj = 0; bj < 2; ++bj) { const size_t off = (size_t)row * 1024 + col0 + bj * 128; const u32x4 hv = *(const u32x4*)(hin + off);
                    f32x4 v0 = acc[ai][bj][m][0], v1 = acc[ai][bj][m][1];
                    v0[0] += __uint_as_float(hv.x << 16); v0[1] += __uint_as_float(hv.x & 0xffff0000u); v0[2] += __uint_as_float(hv.y << 16); v0[3] += __uint_as_float(hv.y & 0xffff0000u);
                    v1[0] += __uint_as_float(hv.z << 16); v1[1] += __uint_as_float(hv.z & 0xffff0000u); v1[2] += __uint_as_float(hv.w << 16); v1[3] += __uint_as_float(hv.w & 0xffff0000u);
#pragma unroll
                    for (int e = 0; e < 4; ++e) s += v0[e] * v0[e] + v1[e] * v1[e];
                    if (!pad) *(u32x4*)(hout + off) = pack8(v0, v1); }
                s += __shfl_xor(s, 16); s += __shfl_xor(s, 32);
                if (fq == 0) ssq[(size_t)row * 16 + u.pn * 4 + wc] = pad ? 0.f : s;
                if (m & 1) asm volatile("" ::: "memory"); }
    }
};

struct EpiFfnIn {
    static constexpr bool PERM = true, AFTER_DRAIN = false;
    bf16_t* act; const float* ssq; const float* cw; const float* cb; PG8_LAS float* edge;
    __device__ __forceinline__ void operator()(f32x4 (&acc)[2][2][4][2], const Unit& u, int wr, int wc, int fr, int fq) const {
        const int lane = fq * 16 + fr;
        const int rowt = u.pm * 254;
#pragma unroll
        for (int ai = 0; ai < 2; ++ai)
#pragma unroll
            for (int m = 0; m < 4; ++m) { const int row = rowt + ai * 128 + wr * 64 + m * 16 + fr; const f32x4 pv = *(const f32x4*)(ssq + (size_t)row * 16 + 4 * fq); float sq = (pv[0] + pv[1]) + (pv[2] + pv[3]); sq += __shfl_xor(sq, 16); sq += __shfl_xor(sq, 32);
                const float rs = rsqrtf(sq * (1.0f / 1024.0f) + NEPS);
#pragma unroll
                for (int bj = 0; bj < 2; ++bj)
#pragma unroll
                    for (int n = 0; n < 2; ++n) acc[ai][bj][m][n] = acc[ai][bj][m][n] * rs;
                asm volatile("" ::: "memory"); }
        const int colw = wc * 32 + 8 * fq;
        PG8_LAS float* edgeF = edge; PG8_LAS float* edgeL = edge + 512;
#pragma unroll
        for (int ai = 0; ai < 2; ++ai) { const int blk = 2 * ai + wr;
            if (fr == 0) {
#pragma unroll
                for (int n = 0; n < 2; ++n)
#pragma unroll
                    for (int e = 0; e < 4; ++e) edgeF[blk * 128 + colw + 4 * n + e] = acc[ai][0][0][n][e]; }
            if (fr == 15) {
#pragma unroll
                for (int n = 0; n < 2; ++n)
#pragma unroll
                    for (int e = 0; e < 4; ++e) edgeL[blk * 128 + colw + 4 * n + e] = acc[ai][0][3][n][e]; } }
        asm volatile("s_waitcnt lgkmcnt(0)" ::: "memory"); __builtin_amdgcn_s_barrier(); asm volatile("" ::: "memory");
        const int lprev = (lane & 48) | ((fr + 15) & 15), lnext = (lane & 48) | ((fr + 1) & 15);
        const int colg = u.pn * 128 + colw;
        const bool f0 = (fr == 0), f15 = (fr == 15);
#pragma unroll
        for (int ai = 0; ai < 2; ++ai) { const int blk = 2 * ai + wr;
#pragma unroll
            for (int n = 0; n < 2; ++n) {
                const f32x4 w0v = *(const f32x4*)(cw + colg + 4 * n), w1v = *(const f32x4*)(cw + FFN + colg + 4 * n), w2v = *(const f32x4*)(cw + 2 * FFN + colg + 4 * n), cbv = *(const f32x4*)(cb + colg + 4 * n);
                f32x4 res[4];
#pragma unroll
                for (int p = 0; p < 2; ++p) {
                    const f32x2 w0 = {w0v[2 * p], w0v[2 * p + 1]}, w1 = {w1v[2 * p], w1v[2 * p + 1]}, w2 = {w2v[2 * p], w2v[2 * p + 1]}, bb = {cbv[2 * p], cbv[2 * p + 1]};
                    f32x2 c[4], ps[4], ns[4];
#pragma unroll
                    for (int m = 0; m < 4; ++m) { c[m] = (f32x2){acc[ai][0][m][n][2 * p], acc[ai][0][m][n][2 * p + 1]};
                        ps[m] = (f32x2){__shfl(c[m].x, lprev), __shfl(c[m].y, lprev)}; ns[m] = (f32x2){__shfl(c[m].x, lnext), __shfl(c[m].y, lnext)}; }
                    f32x2 pe = {0.f, 0.f}, ne = {0.f, 0.f};
                    if (blk > 0) pe = (f32x2){edgeL[(blk - 1) * 128 + colw + 4 * n + 2 * p], edgeL[(blk - 1) * 128 + colw + 4 * n + 2 * p + 1]};
                    if (blk < 3) ne = (f32x2){edgeF[(blk + 1) * 128 + colw + 4 * n + 2 * p], edgeF[(blk + 1) * 128 + colw + 4 * n + 2 * p + 1]};
#pragma unroll
                    for (int m = 0; m < 4; ++m) {
                        const f32x2 pvm = f0 ? (m == 0 ? pe : ps[m == 0 ? 0 : m - 1]) : ps[m];
                        const f32x2 nvm = f15 ? (m == 3 ? ne : ns[m == 3 ? 3 : m + 1]) : ns[m];
                        f32x2 cu = w1 * c[m] + bb; cu = w0 * pvm + cu; cu = w2 * nvm + cu;
                        f32x2 tq = (cu * cu) * cu; tq = tq * 0.044715f + cu;
                        const f32x2 ea = tq * (-2.3022082f);
                        f32x2 dn; dn.x = __builtin_amdgcn_exp2f(ea.x); dn.y = __builtin_amdgcn_exp2f(ea.y); dn = dn + 1.0f;
                        f32x2 rc; rc.x = __builtin_amdgcn_rcpf(dn.x); rc.y = __builtin_amdgcn_rcpf(dn.y);
                        const f32x2 vv = {acc[ai][1][m][n][2 * p], acc[ai][1][m][n][2 * p + 1]};
                        const f32x2 o = (cu * rc) * vv;
                        res[m][2 * p] = o.x; res[m][2 * p + 1] = o.y; }
                }
#pragma unroll
                for (int m = 0; m < 4; ++m) { const int j = ai * 128 + wr * 64 + m * 16 + fr;
                    u32x2 w; w.x = cvt_pk_bf16(res[m][0], res[m][1]); w.y = cvt_pk_bf16(res[m][2], res[m][3]);
                    if (j >= 1 && j <= 254) *(u32x2*)(act + (size_t)(rowt + j) * FFN + colg + 4 * n) = w; }
                asm volatile("" ::: "memory");
            }
        }
        asm volatile("" ::: "memory");
    }
};

struct EpiRkv {
    static constexpr bool PERM = true, AFTER_DRAIN = false;
    bf16_t* base;
    __device__ __forceinline__ void operator()(const f32x4 (&acc)[2][2][4][2], const Unit& u, int wr, int wc, int fr, int fq) const {
        const int colw = wc * 32 + 8 * fq;
        bf16_t* dst0 = base + (size_t)(u.pn >> 2) * SLABE + (u.pn & 3) * 256 + colw;
#pragma unroll
        for (int ai = 0; ai < 2; ++ai)
#pragma unroll
            for (int m = 0; m < 4; ++m) { const int row = u.pm * 256 + ai * 128 + wr * 64 + m * 16 + fr; bf16_t* dst = dst0 + (size_t)row * 1024;
#pragma unroll
                for (int bj = 0; bj < 2; ++bj) *(u32x4*)(dst + bj * 128) = pack8(acc[ai][bj][m][0], acc[ai][bj][m][1]);
                asm volatile("" ::: "memory"); }
    }
};
struct EpiLora {
    static constexpr bool PERM = true, AFTER_DRAIN = false;
    bf16_t* hw; bf16_t* ha; bf16_t* hg;
    __device__ __forceinline__ void operator()(const f32x4 (&acc)[2][2][4][2], const Unit& u, int wr, int wc, int fr, int fq) const {
        const int colw = wc * 32 + 8 * fq;
#pragma unroll
        for (int ai = 0; ai < 2; ++ai)
#pragma unroll
            for (int m = 0; m < 4; ++m) { const int row = u.pm * 256 + ai * 128 + wr * 64 + m * 16 + fr;
                if (u.pn == 0) { f32x4 v0 = acc[ai][0][m][0], v1 = acc[ai][0][m][1];
#pragma unroll
                    for (int e = 0; e < 4; ++e) { v0[e] = 2.0f * __builtin_amdgcn_rcpf(1.0f + __expf(-2.0f * v0[e])) - 1.0f; v1[e] = 2.0f * __builtin_amdgcn_rcpf(1.0f + __expf(-2.0f * v1[e])) - 1.0f; }
                    *(u32x4*)(hw + (size_t)row * 128 + colw) = pack8(v0, v1);
                    *(u32x4*)(ha + (size_t)row * 128 + colw) = pack8(acc[ai][1][m][0], acc[ai][1][m][1]);
                } else {
#pragma unroll
                    for (int bj = 0; bj < 2; ++bj) { f32x4 v0 = acc[ai][bj][m][0], v1 = acc[ai][bj][m][1];
#pragma unroll
                        for (int e = 0; e < 4; ++e) { v0[e] = __builtin_amdgcn_rcpf(1.0f + __expf(-v0[e])); v1[e] = __builtin_amdgcn_rcpf(1.0f + __expf(-v1[e])); }
                        *(u32x4*)(hg + (size_t)row * 256 + bj * 128 + colw) = pack8(v0, v1); } }
                asm volatile("" ::: "memory"); }
    }
};

struct EpiGate {
    static constexpr bool PERM = true, AFTER_DRAIN = false;
    const bf16_t* yb; bf16_t* outb;
    __device__ __forceinline__ void operator()(const f32x4 (&acc)[2][2][4][2], const Unit& u, int wr, int wc, int fr, int fq) const {
        const int col0 = u.pn * 256 + wc * 32 + 8 * fq;
#pragma unroll
        for (int ai = 0; ai < 2; ++ai)
#pragma unroll
            for (int m = 0; m < 4; ++m) { const int row = u.pm * 256 + ai * 128 + wr * 64 + m * 16 + fr;
#pragma unroll
                for (int bj = 0; bj < 2; ++bj) { const size_t off = (size_t)row * 1024 + col0 + bj * 128; const u32x4 hv = *(const u32x4*)(yb + off);
                    f32x4 v0 = acc[ai][bj][m][0], v1 = acc[ai][bj][m][1];
                    v0[0] *= __uint_as_float(hv.x << 16); v0[1] *= __uint_as_float(hv.x & 0xffff0000u); v0[2] *= __uint_as_float(hv.y << 16); v0[3] *= __uint_as_float(hv.y & 0xffff0000u);
                    v1[0] *= __uint_as_float(hv.z << 16); v1[1] *= __uint_as_float(hv.z & 0xffff0000u); v1[2] *= __uint_as_float(hv.w << 16); v1[3] *= __uint_as_float(hv.w & 0xffff0000u);
                    *(u32x4*)(outb + off) = pack8(v0, v1); }
                asm volatile("" ::: "memory"); }
    }
};
template <class Epi, class Sched, bool ALIGN_EPI = false, bool SP2 = false>
__device__ __forceinline__ void gemm_phase(PG8_LAS unsigned char* lds, const Gemm g, const Sched& S, const Epi& E, int tid_in) {
    int tid_l = tid_in;
    const int tid = tid_l, wid = __builtin_amdgcn_readfirstlane(tid >> 6), lane = tid & 63, wr = wid >> 2, wc = wid & 3, fr = lane & 15, fq = lane >> 4;
    const int K = g.K, nt = K / BK;
    unsigned voffA[2], voffB[2];
#pragma unroll
    for (int i = 0; i < 2; ++i) { int R, C; stage_rc(tid * 16 + i * 8192, R, C); const int Rb = Epi::PERM ? ((R & ~31) + perm32(R & 31)) : R;
        voffA[i] = (unsigned)(R * g.lda + C) * 2u; voffB[i] = (unsigned)(Rb * K + C) * 2u; }
    const size_t kstep = (size_t)(BK * 2);
    const size_t hstep = (size_t)HALF * K * 2;
    const size_t hstepA = (size_t)HALF * g.lda * 2;
    const size_t tstepA = (size_t)g.a_tile_rows * g.lda * 2, tstepB = 2 * hstep;
    const unsigned ldsw = (unsigned)wid * 1024u;
    const int aoff = lds_byte(wr * 64 + fr, fq * 8), boff = lds_byte(wc * 32 + fr, fq * 8);
#define PG8_SA(b, h) (((b) * 2 + (h)) * HTB)
#define PG8_SB(b, h) ((4 + (b) * 2 + (h)) * HTB)
#define PG8_STAGE(bufoff, gbase, voff) do { _Pragma("unroll") for (int _i = 0; _i < 2; ++_i) \
        __builtin_amdgcn_global_load_lds((const unsigned*)((const char*)(gbase) + (voff)[_i]), (PG8_LAS unsigned*)(lds + (bufoff) + ldsw + _i * 8192), 16, 0, 0); } while (0)
#define PG8_LDA(dst, b, h) do { _Pragma("unroll") for (int m = 0; m < 4; ++m) _Pragma("unroll") for (int k = 0; k < 2; ++k) dst[m][k] = *(const PG8_LAS bf16x8*)(lds + PG8_SA(b, h) + aoff + m * 2048 + k * 1024); } while (0)
#define PG8_LDB(dst, b, h) do { _Pragma("unroll") for (int n = 0; n < 2; ++n) _Pragma("unroll") for (int k = 0; k < 2; ++k) dst[n][k] = *(const PG8_LAS bf16x8*)(lds + PG8_SB(b, h) + boff + n * 2048 + k * 1024); } while (0)
#define PG8_MMA(ai, bj, At, Bt) do { __builtin_amdgcn_s_setprio(1); _Pragma("unroll") for (int m = 0; m < 4; ++m) _Pragma("unroll") for (int n = 0; n < 2; ++n) _Pragma("unroll") for (int k = 0; k < 2; ++k) \
        acc[ai][bj][m][n] = __builtin_amdgcn_mfma_f32_16x16x32_bf16(Bt[n][k], At[m][k], acc[ai][bj][m][n], 0, 0, 0); __builtin_amdgcn_s_setprio(0); } while (0)
#define PG8_WAIT_V(n) asm volatile("s_waitcnt vmcnt(" #n ")" ::: "memory")
#define PG8_WAIT_L(n) asm volatile("s_waitcnt lgkmcnt(" #n ")" ::: "memory")
#define PG8_BAR __builtin_amdgcn_s_barrier()
#define PG8_SCHED __builtin_amdgcn_sched_barrier(0)
    Unit cur, nxt; int ui = 0;
    if (!S.next(0, cur)) return;
    f32x4 acc[2][2][4][2];
#pragma unroll
    for (int a = 0; a < 2; ++a)
#pragma unroll
        for (int b = 0; b < 2; ++b)
#pragma unroll
            for (int m = 0; m < 4; ++m)
#pragma unroll
                for (int n = 0; n < 2; ++n) acc[a][b][m][n] = (f32x4){0.f, 0.f, 0.f, 0.f};
    bf16x8 At[4][2], B0[2][2], B1[2][2];
    const char* cA = (const char*)g.A + (size_t)cur.pm * tstepA + a_unit_off(g, cur.pn); const char* cB = (const char*)g.Bt + (size_t)cur.pn * tstepB;
    S.a_ready(cur);
    if constexpr (SP2) {
        PG8_STAGE(PG8_SB(0, 0), cB, voffB); PG8_STAGE(PG8_SB(0, 1), cB + hstep, voffB); PG8_STAGE(PG8_SA(0, 0), cA, voffA); PG8_STAGE(PG8_SA(0, 1), cA + hstepA, voffA);
        if (wr == 1) PG8_BAR;
        PG8_WAIT_V(2); PG8_BAR;
        PG8_STAGE(PG8_SB(1, 0), cB + kstep, voffB); PG8_STAGE(PG8_SA(1, 0), cA + kstep, voffA); PG8_STAGE(PG8_SB(1, 1), cB + hstep + kstep, voffB);
        PG8_WAIT_V(6); PG8_BAR;
    } else {
        PG8_STAGE(PG8_SB(0, 0), cB, voffB); PG8_STAGE(PG8_SA(0, 0), cA, voffA); PG8_STAGE(PG8_SB(0, 1), cB + hstep, voffB); PG8_STAGE(PG8_SA(0, 1), cA + hstepA, voffA);
        if (wr == 1) PG8_BAR;
        PG8_WAIT_V(4); PG8_BAR;
        PG8_STAGE(PG8_SB(1, 0), cB + kstep, voffB); PG8_STAGE(PG8_SA(1, 0), cA + kstep, voffA); PG8_STAGE(PG8_SB(1, 1), cB + hstep + kstep, voffB);
        PG8_WAIT_V(6); PG8_BAR;
    }
    for (;;) {
        const bool has_next = S.next(ui + 1, nxt);
        const char* nA = has_next ? (const char*)g.A + (size_t)nxt.pm * tstepA + a_unit_off(g, nxt.pn) : cA; const char* nB = has_next ? (const char*)g.Bt + (size_t)nxt.pn * tstepB : cB;
#pragma unroll 1
        for (int t = 0; t < nt; t += 2) {
            const bool last = (t == nt - 2);
            const char* a1 = cA + (size_t)(t + 1) * kstep;
            const char* a2 = last ? nA : cA + (size_t)(t + 2) * kstep; const char* b2 = last ? nB : cB + (size_t)(t + 2) * kstep;
            const char* a3 = a2 + kstep; const char* b3 = b2 + kstep;
            if (last && has_next) S.a_ready(nxt);
            if constexpr (SP2) {
            PG8_LDB(B0, 0, 0); PG8_LDB(B1, 0, 1); PG8_SCHED; PG8_LDA(At, 0, 0); PG8_STAGE(PG8_SA(1, 1), a1 + hstepA, voffA);
            PG8_WAIT_V(8); PG8_WAIT_L(0); PG8_BAR; PG8_MMA(0, 0, At, B0); PG8_MMA(0, 1, At, B1); PG8_BAR; PG8_SCHED;
            PG8_LDA(At, 0, 1); PG8_STAGE(PG8_SB(0, 0), b2, voffB); PG8_STAGE(PG8_SB(0, 1), b2 + hstep, voffB); PG8_STAGE(PG8_SA(0, 0), a2, voffA);
            PG8_WAIT_V(8); PG8_WAIT_L(0); PG8_BAR; PG8_MMA(1, 0, At, B0); PG8_MMA(1, 1, At, B1); PG8_BAR; PG8_SCHED;
            PG8_LDB(B0, 1, 0); PG8_LDB(B1, 1, 1); PG8_SCHED; PG8_LDA(At, 1, 0); PG8_STAGE(PG8_SA(0, 1), a2 + hstepA, voffA);
            PG8_WAIT_V(8); PG8_WAIT_L(0); PG8_BAR; PG8_MMA(0, 0, At, B0); PG8_MMA(0, 1, At, B1); PG8_BAR; PG8_SCHED;
            PG8_LDA(At, 1, 1); PG8_STAGE(PG8_SB(1, 0), b3, voffB); PG8_STAGE(PG8_SB(1, 1), b3 + hstep, voffB); PG8_STAGE(PG8_SA(1, 0), a3, voffA);
            PG8_WAIT_V(8); PG8_WAIT_L(0); PG8_BAR; PG8_MMA(1, 0, At, B0); PG8_MMA(1, 1, At, B1); PG8_BAR; PG8_SCHED;
            } else {
            PG8_LDB(B0, 0, 0); PG8_SCHED; PG8_LDA(At, 0, 0); PG8_STAGE(PG8_SA(1, 1), a1 + hstepA, voffA);
            PG8_WAIT_L(8); PG8_BAR; PG8_WAIT_L(0); PG8_MMA(0, 0, At, B0); PG8_BAR; PG8_SCHED;
            PG8_LDB(B1, 0, 1); PG8_STAGE(PG8_SB(0, 0), b2, voffB);
            PG8_BAR; PG8_WAIT_L(0); PG8_MMA(0, 1, At, B1); PG8_BAR;
            PG8_LDA(At, 0, 1); PG8_STAGE(PG8_SA(0, 0), a2, voffA);
            PG8_BAR; PG8_WAIT_L(0); PG8_MMA(1, 0, At, B0); PG8_BAR; PG8_SCHED;
            PG8_STAGE(PG8_SB(0, 1), b2 + hstep, voffB);
            PG8_WAIT_V(6); PG8_BAR; PG8_MMA(1, 1, At, B1); PG8_BAR;
            PG8_LDB(B0, 1, 0); PG8_SCHED; PG8_LDA(At, 1, 0); PG8_STAGE(PG8_SA(0, 1), a2 + hstepA, voffA);
            PG8_WAIT_L(8); PG8_BAR; PG8_WAIT_L(0); PG8_MMA(0, 0, At, B0); PG8_BAR; PG8_SCHED;
            PG8_LDB(B1, 1, 1); PG8_STAGE(PG8_SB(1, 0), b3, voffB);
            PG8_BAR; PG8_WAIT_L(0); PG8_MMA(0, 1, At, B1); PG8_BAR;
            PG8_LDA(At, 1, 1); PG8_STAGE(PG8_SA(1, 0), a3, voffA);
            PG8_BAR; PG8_WAIT_L(0); PG8_MMA(1, 0, At, B0); PG8_BAR; PG8_SCHED;
            PG8_STAGE(PG8_SB(1, 1), b3 + hstep, voffB);
            PG8_WAIT_V(6); PG8_BAR; PG8_MMA(1, 1, At, B1); PG8_BAR;
            }
        }
        if constexpr (ALIGN_EPI) { if (wr == 0) PG8_BAR; }
        if constexpr (!Epi::AFTER_DRAIN) { E(acc, cur, wr, wc, fr, fq); S.done(cur); }
        if (!has_next) break;
#pragma unroll
        for (int a = 0; a < 2; ++a)
#pragma unroll
            for (int b = 0; b < 2; ++b)
#pragma unroll
                for (int m = 0; m < 4; ++m)
#pragma unroll
                    for (int n = 0; n < 2; ++n) acc[a][b][m][n] = (f32x4){0.f, 0.f, 0.f, 0.f};
        cur = nxt; cA = nA; cB = nB; ++ui;
        if constexpr (ALIGN_EPI) { if (wr == 1) PG8_BAR; }
    }
    PG8_WAIT_V(0);
    if constexpr (!ALIGN_EPI) { if (wr == 0) PG8_BAR; }
    PG8_BAR;
    if constexpr (Epi::AFTER_DRAIN) { E.fused(acc, cur, wr, wc, fr, fq, lds, wid, lane); S.done(cur); }
#undef PG8_SA
#undef PG8_SB
#undef PG8_STAGE
#undef PG8_LDA
#undef PG8_LDB
#undef PG8_MMA
#undef PG8_WAIT_V
#undef PG8_WAIT_L
#undef PG8_BAR
#undef PG8_SCHED
}
}

#define LAS __attribute__((address_space(3)))
typedef unsigned short bf16;
typedef short bf16x8_t __attribute__((ext_vector_type(8)));
typedef float f32x4_t __attribute__((ext_vector_type(4)));
typedef unsigned u32x4_t __attribute__((ext_vector_type(4)));
typedef unsigned u32x2_t __attribute__((ext_vector_type(2)));
constexpr int LDS_BYTES = 147456, RING_BYTES = 131072;

constexpr size_t DO_WLORA = 98041856 + 6291456, DO_HB = 0, DO_WHG = 68157440, DO_WHGO = 78643200, DO_WF0I = 80740352, DO_WF0O = 92274688, DO_WRW1 = 98041856, DO_WRWO = 113770496,
                 DO_WG2 = 115867648, DO_WF1I = 116391936, DO_WF1O = 127926272, DO_END = 133693440;
constexpr size_t WS_BAR = 720896, WS_SSQ = 0, WS_BETA = 1048576, WS_PA = 3211264, WS_PB = 5373952, WS_HW = 7536640, WS_HA = 11796480, WS_HG = 16056320, WS_BIG = 25165824, WS_SLOTB = 34078720,
                 WS_NEED = 268435456, WS_ACT = WS_NEED - (size_t)TROWS * FFN * 2, WS_HBNEW = 8388608;
static_assert(WS_BETA + 2 * (size_t)SLAB * 64 <= WS_PA && WS_PA + (size_t)TROWS * 64 <= WS_PB && WS_PB + (size_t)TROWS * 64 <= WS_HW && WS_HW + (size_t)SLAB * 256 <= WS_HA && WS_HA + (size_t)SLAB * 256 <= WS_HG && WS_HG + (size_t)SLAB * 512 <= WS_BIG, "small map");
static_assert(8388608 + (size_t)64 * 129 * 4608 <= 2 * WS_SLOTB && 8388608 + (size_t)32 * 257 * 4608 <= 2 * WS_SLOTB && WS_HW + (size_t)256 * 16512 * 4 <= WS_BIG && WS_BIG + 7 * WS_SLOTB <= WS_NEED && WS_HBNEW + (size_t)TROWS * 2048 <= WS_ACT && DO_END <= 134217728, "maps");

struct Args { const float* in[32]; float* out; unsigned char* ws; };
typedef const __attribute__((address_space(4))) Args* ArgP;
#define LAUNDER_ARGS(ap0) ({ ArgP _p = (ap0); asm volatile("" : "+s"(_p)); _p; })

__device__ __forceinline__ float wave_sum(float v) {
#pragma unroll
    for (int o = 1; o < 64; o <<= 1) v += __shfl_xor(v, o);
    return v;
}

__device__ __forceinline__ void tr_item(const float* W, int N, int Klim, int k0, int n0, bf16* WT, int ldk, int drow, int dcol, const float* sc, float* scr, int lane, const float* sc2 = nullptr) {
    if (k0 + 64 <= Klim) {
#pragma unroll 8
        for (int i = 0; i < 32; ++i) { const int kk = 2 * i + (lane >> 5); scr[kk * 33 + (lane & 31)] = __builtin_nontemporal_load(W + (size_t)(k0 + kk) * N + n0 + (lane & 31)); }
    } else {
#pragma unroll 8
        for (int i = 0; i < 32; ++i) { const int kk = 2 * i + (lane >> 5); const int k = k0 + kk; float v = 0.f; if (k < Klim) v = W[(size_t)k * N + n0 + (lane & 31)]; scr[kk * 33 + (lane & 31)] = v; }
    }
    asm volatile("s_waitcnt lgkmcnt(0)" ::: "memory");
    const int c = lane & 7;
    f32x4_t sa = (f32x4_t){1.f, 1.f, 1.f, 1.f}, sb = sa;
    if (sc) { sa = *(const f32x4_t*)(sc + k0 + 8 * c); sb = *(const f32x4_t*)(sc + k0 + 8 * c + 4);
        if (sc2) { sa = sa - *(const f32x4_t*)(sc2 + k0 + 8 * c); sb = sb - *(const f32x4_t*)(sc2 + k0 + 8 * c + 4); } }
#pragma unroll
    for (int j = 0; j < 4; ++j) { const int n = (lane >> 3) + 8 * j; const float* s = scr + (8 * c) * 33 + n;
        u32x4_t o; o.x = pk2(s[0 * 33] * sa[0], s[1 * 33] * sa[1]); o.y = pk2(s[2 * 33] * sa[2], s[3 * 33] * sa[3]); o.z = pk2(s[4 * 33] * sb[0], s[5 * 33] * sb[1]); o.w = pk2(s[6 * 33] * sb[2], s[7 * 33] * sb[3]);
        *(u32x4_t*)(WT + (size_t)(drow + n) * ldk + dcol + k0 + 8 * c) = o; }
    asm volatile("s_waitcnt lgkmcnt(0)" ::: "memory");
}

__device__ __forceinline__ void p0_prologue(ArgP ap, unsigned char* lds, int tid) {
    const int lane = tid & 63, wave = tid >> 6;
    float* scr = (float*)(lds + wave * 16384);
    int gdim = gridDim.x; asm volatile("" : "+s"(gdim));
    const int gw = blockIdx.x * 8 + wave, NGW = gdim * 8;
    unsigned char* dob = (unsigned char*)ap->out;
    bf16* WHG = (bf16*)(dob + DO_WHG); bf16* WHGO = (bf16*)(dob + DO_WHGO); bf16* WF0I = (bf16*)(dob + DO_WF0I); bf16* WF0O = (bf16*)(dob + DO_WF0O);
    bf16* WRW1 = (bf16*)(dob + DO_WRW1); bf16* WLORA = (bf16*)(dob + DO_WLORA); bf16* WRWO = (bf16*)(dob + DO_WRWO); bf16* WG2 = (bf16*)(dob + DO_WG2); bf16* WF1I = (bf16*)(dob + DO_WF1I); bf16* WF1O = (bf16*)(dob + DO_WF1O);
    const float* mu = ap->in[10];
    constexpr int I_HG = 16 * 160, I_SQ = 16 * 32, I_FI = 16 * 176, I_FO = 44 * 32, I_L64 = 16 * 2, I_G1 = 16 * 5, I_G2 = 4 * 32;
    constexpr int NITEMS = I_HG + I_SQ + 2 * I_FI + 2 * I_FO + 3 * I_SQ + 4 * I_L64 + 4 * I_L64 + 2 * I_G1 + I_SQ + I_G2;
    for (int it = gw; it < NITEMS; it += NGW) {
        int r = it;
        if (r < I_HG) { const int kb = r / 160, nb = r % 160; tr_item(ap->in[6], 5120, 1024, 64 * kb, 32 * nb, WHG, 1024, 32 * nb, 0, ap->in[3], scr, lane); continue; } r -= I_HG;
        if (r < I_SQ) { const int kb = r / 32, nb = r % 32; tr_item(ap->in[7], 1024, 1024, 64 * kb, 32 * nb, WHGO, 1024, 32 * nb, 0, nullptr, scr, lane); continue; } r -= I_SQ;
        if (r < 2 * I_FI) { const int l = r / I_FI; r -= l * I_FI; const int kb = r / 176, nb = r % 176; const int n0 = 32 * nb; const int half = n0 / FFN, c = n0 % FFN;
            const int drow = 256 * (c / 128) + 128 * half + (c % 128);
            tr_item(ap->in[28] + (size_t)l * 1024 * 5632, 5632, 1024, 64 * kb, n0, l ? WF1I : WF0I, 1024, drow, 0, ap->in[4] + l * 1024, scr, lane); continue; } r -= 2 * I_FI;
        if (r < 2 * I_FO) { const int l = r / I_FO; r -= l * I_FO; const int kb = r / 32, nb = r % 32;
            tr_item(ap->in[31] + (size_t)l * 2816 * 1024, 1024, 2816, 64 * kb, 32 * nb, l ? WF1O : WF0O, 2816, 32 * nb, 0, nullptr, scr, lane); continue; } r -= 2 * I_FO;
        if (r < 3 * I_SQ) { const int m3 = r / I_SQ; r -= m3 * I_SQ; const int kb = r / 32, nb = r % 32;
            tr_item(ap->in[11 + m3], 1024, 1024, 64 * kb, 32 * nb, WRW1, 1024, m3 * 1024 + 32 * nb, 0, nullptr, scr, lane); continue; } r -= 3 * I_SQ;
        if (r < 4 * I_L64) { const int d = r / (2 * I_L64); r -= d * 2 * I_L64; const int half = r / I_L64; r -= half * I_L64; const int kb = r / 2, nb = r % 2;
            tr_item(ap->in[16] + (size_t)d * 1024 * 64, 64, 1024, 64 * kb, 32 * nb, WLORA, 2048, d * 64 + 32 * nb, half * 1024, half ? mu + 1 * 1024 : nullptr, scr, lane, mu); continue; } r -= 4 * I_L64;
        if (r < 4 * I_L64) { const int d = r / (2 * I_L64); r -= d * 2 * I_L64; const int half = r / I_L64; r -= half * I_L64; const int kb = r / 2, nb = r % 2;
            tr_item(ap->in[19] + (size_t)d * 1024 * 64, 64, 1024, 64 * kb, 32 * nb, WLORA, 2048, 128 + d * 64 + 32 * nb, half * 1024, half ? mu + 4 * 1024 : nullptr, scr, lane, mu); continue; } r -= 4 * I_L64;
        if (r < 2 * I_G1) { const int half = r / I_G1; r -= half * I_G1; const int kb = r / 5, nb = r % 5;
            tr_item(ap->in[21], 160, 1024, 64 * kb, 32 * nb, WLORA, 2048, 256 + 32 * nb, half * 1024, half ? mu + 5 * 1024 : nullptr, scr, lane, mu); continue; } r -= 2 * I_G1;
        if (r < I_SQ) { const int kb = r / 32, nb = r % 32; tr_item(ap->in[14], 1024, 1024, 64 * kb, 32 * nb, WRWO, 1024, 32 * nb, 0, nullptr, scr, lane); continue; } r -= I_SQ;
        { const int kb = r / 32, nb = r % 32; tr_item(ap->in[22], 1024, 160, 64 * kb, 32 * nb, WG2, 256, 32 * nb, 0, nullptr, scr, lane); }
    }
    {
        const int gt = blockIdx.x * 512 + tid, NGT = gdim * 512;
        for (int i = gt; i < 96 * 256; i += NGT) { const int rr = i >> 8, cc = i & 255;
            unsigned zz = 0u; asm volatile("" : "+v"(zz)); *(u32x4_t*)(WLORA + (size_t)(416 + rr) * 2048 + cc * 8) = (u32x4_t){zz, zz, zz, zz}; }
    }
    bf16* HB = (bf16*)(dob + DO_HB); float* ssq0 = (float*)(ap->ws + WS_SSQ);
    for (int r = gw; r < TROWS; r += NGW) {
        int o, tokbase; bool pad = false;
        if (r < 8256) { o = r; tokbase = 16384; } else if (r < 16512) { o = r - 8256; tokbase = 24576; } else if (r < 16640) { pad = true; o = 0; tokbase = 0; }
        else if (r < 33088) { o = r - 16640; tokbase = 0; } else { pad = true; o = 0; tokbase = 0; }
        if (o < 48) pad = true;
        const float* src = nullptr;
        if (!pad) { if (o < 64) src = ap->in[2] + (size_t)(o - 48) * 1024; else { const int g = tokbase + o - 64; src = (g < 16384) ? ap->in[0] + (size_t)g * 1024 : ap->in[1] + (size_t)(g - 16384) * 1024; } }
        float s = 0.f;
#pragma unroll
        for (int j = 0; j < 4; ++j) { f32x4_t v = (f32x4_t){0.f, 0.f, 0.f, 0.f}; if (src) v = __builtin_nontemporal_load((const f32x4_t*)(src + 4 * lane + 256 * j));
            s += v[0] * v[0] + v[1] * v[1] + v[2] * v[2] + v[3] * v[3];
            u32x2_t w; w.x = pk2(v[0], v[1]); w.y = pk2(v[2], v[3]); *(u32x2_t*)(HB + (size_t)r * 1024 + 4 * lane + 256 * j) = w; }
        s = wave_sum(s); if (lane == 0) ssq0[r] = s;
    }
}

#define XB_TMO      128
#define XB_XCNT(j)  (256  + 64 * (j))
#define XB_XSUB(j)  (1280 + 64 * (j))
#define XB_XGEN(j)  (2304 + 64 * (j))
#define XB_TOP      3328
#define XB_TOPGEN   3392
#define XCD_BAR_WORDS 3456
#define XB_SPIN_CAP (1u << 18)

__device__ __forceinline__ unsigned xb_ld(unsigned* p)              { return __hip_atomic_load(p, __ATOMIC_RELAXED, __HIP_MEMORY_SCOPE_AGENT); }
__device__ __forceinline__ unsigned xb_add(unsigned* p, unsigned v) { return __hip_atomic_fetch_add(p, v, __ATOMIC_RELAXED, __HIP_MEMORY_SCOPE_AGENT); }
__device__ __forceinline__ unsigned xb_xcc_id() { return (unsigned)__builtin_amdgcn_s_getreg((3 << 11) | 20) & 0xFu; }
#define XB_SPIN(cond, bar) do { unsigned _sp = 0; while (cond) { __builtin_amdgcn_s_sleep(1); \
    if ((++_sp & 255u) == 0u) { if (xb_ld(&(bar)[XB_TMO])) break; if (_sp > XB_SPIN_CAP) { atomicAdd(&(bar)[XB_TMO], 1u); break; } } } } while (0)

struct XcdBarrier {
    unsigned* bar; unsigned x;
    volatile LAS unsigned* st;
};

__device__ __forceinline__ XcdBarrier xcd_barrier_post(unsigned* bar, volatile LAS unsigned* st) {
    XcdBarrier b; b.bar = bar; b.x = xb_xcc_id(); b.st = st;
    if (threadIdx.x == 0) (void)xb_add(&bar[XB_XCNT(b.x)], 1u);
    return b;
}
__device__ __forceinline__ void xcd_barrier_complete(unsigned* bar, unsigned x, unsigned& nloc, unsigned& nx) {
    const unsigned G = gridDim.x * gridDim.y * gridDim.z;
    unsigned sum, cnt, mine, sp = 0u;
    for (;;) {
        sum = 0u; cnt = 0u; mine = 0u;
#pragma unroll
        for (unsigned j = 0; j < 16; ++j) { const unsigned c = xb_ld(&bar[XB_XCNT(j)]); sum += c; cnt += (c > 0u) ? 1u : 0u; mine = (j == x) ? c : mine; }
        if (sum == G) break;
        __builtin_amdgcn_s_sleep(1);
        if ((++sp & 255u) == 0u) { if (xb_ld(&bar[XB_TMO])) break; if (sp > XB_SPIN_CAP) { atomicAdd(&bar[XB_TMO], 1u); break; } }
    }
    nloc = mine > 0u ? mine : 1u; nx = cnt > 0u ? cnt : 1u;
}

__device__ __forceinline__ void xcd_barrier(const XcdBarrier& b, int tid_) {
    asm volatile("s_waitcnt vmcnt(0)" ::: "memory");
    __syncthreads();
    if (tid_ == 0) {
        unsigned* bar = b.bar;
        __builtin_amdgcn_s_waitcnt(0);
        unsigned nloc = b.st[0], nx = b.st[1];
        if (nloc == 0u) { xcd_barrier_complete(bar, b.x, nloc, nx); b.st[0] = nloc; b.st[1] = nx; }
        const unsigned old = xb_add(&bar[XB_XSUB(b.x)], 1u);
        const unsigned gen = old / nloc;
        if (old + 1u == (gen + 1u) * nloc) {
            __builtin_amdgcn_fence(__ATOMIC_RELEASE, "agent");
            asm volatile("s_waitcnt vmcnt(0)" ::: "memory");
            const unsigned og = xb_add(&bar[XB_TOP], 1u);
            const unsigned tg = og / nx;
            if (og + 1u == (tg + 1u) * nx) xb_add(&bar[XB_TOPGEN], 1u);
            else XB_SPIN(xb_ld(&bar[XB_TOPGEN]) == tg, bar);
            __builtin_amdgcn_fence(__ATOMIC_ACQUIRE, "agent");
            xb_add(&bar[XB_XGEN(b.x)], 1u);
            asm volatile("s_waitcnt vmcnt(0)" ::: "memory");
        } else {
            XB_SPIN(xb_ld(&bar[XB_XGEN(b.x)]) == gen, bar);
            __builtin_amdgcn_fence(__ATOMIC_ACQUIRE, "agent");
            asm volatile("s_waitcnt vmcnt(0)" ::: "memory");
        }
    }
    __syncthreads();
}

template <class Epi, bool ALIGN>
__device__ __forceinline__ void run_gemm(unsigned char* lds, const bf16* A, const bf16* Bt, int nM, int nN, int K, int a_tile_rows, const Epi& E, int tid) {
    asm volatile("" : "+s"(K));
    pg8::Gemm g{A, Bt, nM * 256, nN * 256, K, a_tile_rows, K, 0u, 0u}; pg8::StaticOrder S; S.init(nM * 256, nN * 256, (int)gridDim.x, (int)blockIdx.x);
    pg8::gemm_phase<Epi, pg8::StaticOrder, ALIGN, true>((PG8_LAS unsigned char*)lds, g, S, E, tid);
}
template <class Epi>
__device__ __forceinline__ void run_gemm_list(unsigned char* lds, const bf16* A, const bf16* Bt, int K, int lda, unsigned a_off1, unsigned a_off2, const pg8::BalOrder& S, const Epi& E, int tid) {
    asm volatile("" : "+s"(K));
    pg8::Gemm g{A, Bt, 0, 0, K, 256, lda, a_off1, a_off2};
    pg8::gemm_phase<Epi, pg8::BalOrder, true, true>((PG8_LAS unsigned char*)lds, g, S, E, tid);
}

template <bool PA>
__device__ __forceinline__ void hgrn_scan(unsigned char* lds, const bf16* Q, const bf16* FFb, const bf16* FBb, const bf16* Ib, bf16* OFb, bf16* OBb, const float* lbp, float* segm, int slab, int tid) {
    const int lane = tid & 63, wave = tid >> 6, r16 = lane & 15, kq = lane >> 4;
    bf16* qin = (bf16*)lds;
    bf16* kin = qin + 64 * 136;
    bf16* kinT = kin + 64 * 136;
    bf16* Pm = kinT + 128 * 72;
    bf16* iT = Pm + 64 * 72;
    bf16* SbT = iT + 128 * 72;
    float* tot = (float*)(SbT + 128 * 136);
    float* c1 = tot + 512; float* c2 = c1 + 128; float* gtv = c2 + 128;
    const int G = slab == 0 ? 8 : 16, nch = slab == 0 ? 129 : 257;
    const int c = tid & 127, seg = tid >> 7;
    const int jr = tid >> 3, part = tid & 7;
    for (int item = blockIdx.x; item < 256; item += gridDim.x) {
        const int g = item % G, strm = item / G; const int p0 = g == 0 ? 0 : 1 + 16 * g, p1 = 17 + 16 * g;
        if (PA && g == G - 1) continue;
        const int dir = strm & 1, head = (strm >> 1) & 7, sq = strm >> 4;
        const int seqbase = sq * 8256;
        const bf16* Fp = dir ? FBb : FFb; bf16* Op = dir ? OBb : OFb;
        const int hc = head * 128 + c;
        const float l0 = lbp[hc], l1 = lbp[1024 + hc]; const float lb = 1.0f / (1.0f + __expf(l1 - l0));
        f32x4_t S[8];
#pragma unroll
        for (int vt = 0; vt < 8; ++vt) S[vt] = (f32x4_t){0.f, 0.f, 0.f, 0.f};
        float gprod = 1.f;
        float* myPsi = segm + (size_t)item * 16512; float* myG = myPsi + 16384;
        if (!PA) {
            for (int gg = 0; gg < g; ++gg) { const float* Psi = segm + (size_t)(strm * G + gg) * 16512; const float* Gv = Psi + 16384;
#pragma unroll
                for (int e = 0; e < 4; ++e) { const int kr = 16 * wave + 4 * kq + e; const float gk = Gv[kr];
#pragma unroll
                    for (int vt = 0; vt < 8; ++vt) S[vt][e] = gk * S[vt][e] + Psi[kr * 128 + 16 * vt + r16]; } }
        }
        unsigned short qraw[16], fraw[16];
        { const int cbase = seqbase + (dir ? nch - 1 - p0 : p0) * 64;
#pragma unroll
          for (int jj = 0; jj < 16; ++jj) { const int j = 16 * seg + jj; const unsigned bo = ((unsigned)(cbase + (dir ? 63 - j : j)) * 1024u + (unsigned)hc) * 2u; qraw[jj] = PA ? (unsigned short)0 : *(const unsigned short*)((const char*)Q + bo); fraw[jj] = *(const unsigned short*)((const char*)Fp + bo); } }
        __syncthreads();
        for (int p = p0; p < p1; ++p) {
            const int cidx = dir ? nch - 1 - p : p; const int cbase = seqbase + cidx * 64;
            float bl[16], kvv[16], qv[16]; float run = 1.f;
#pragma unroll
            for (int jj = 0; jj < 16; ++jj) { const float f = bf2f(fraw[jj]); const float fg = lb + (1.0f - lb) * sigmoidf_(f); run *= fg; bl[jj] = run; kvv[jj] = 1.0f - fg; qv[jj] = bf2f(qraw[jj]); }
            tot[seg * 128 + c] = run;
            { const size_t row = cbase + (dir ? 63 - jr : jr);
              const u32x4_t w0 = *(const u32x4_t*)(Ib + row * 1024 + head * 128 + part * 16), w1 = *(const u32x4_t*)(Ib + row * 1024 + head * 128 + part * 16 + 8);
              const unsigned wa[8] = {w0.x, w0.y, w0.z, w0.w, w1.x, w1.y, w1.z, w1.w};
#pragma unroll
              for (int q = 0; q < 8; ++q) { iT[(part * 16 + 2 * q) * 72 + jr] = (bf16)(wa[q] & 0xffff); iT[(part * 16 + 2 * q + 1) * 72 + jr] = (bf16)(wa[q] >> 16); } }
            if (p + 1 < p1) { const int nb = seqbase + (dir ? nch - 2 - p : p + 1) * 64;
#pragma unroll
                for (int jj = 0; jj < 16; ++jj) { const int j = 16 * seg + jj; const unsigned bo = ((unsigned)(nb + (dir ? 63 - j : j)) * 1024u + (unsigned)hc) * 2u; qraw[jj] = PA ? (unsigned short)0 : *(const unsigned short*)((const char*)Q + bo); fraw[jj] = *(const unsigned short*)((const char*)Fp + bo); } }
            __syncthreads();
            const float t0 = tot[c], t1 = tot[128 + c], t2 = tot[256 + c], t3 = tot[384 + c];
            const float off = seg == 0 ? 1.f : (seg == 1 ? t0 : (seg == 2 ? t0 * t1 : t0 * t1 * t2));
            const float aref = t0 * t1, alast = (t0 * t1) * (t2 * t3); const float iaref = __builtin_amdgcn_rcpf(aref);
#pragma unroll
            for (int jj = 0; jj < 16; ++jj) { const int j = 16 * seg + jj; const float at = off * bl[jj];
                const float ke = kvv[jj] * (aref * __builtin_amdgcn_rcpf(at)); const bf16 kb = (bf16)f2bf(ke); kinT[c * 72 + j] = kb;
                if (!PA) { const float qe = qv[jj] * (at * iaref); qin[j * 136 + c] = (bf16)f2bf(qe); kin[j * 136 + c] = kb; } }
            if (seg == 0) { c1[c] = aref; c2[c] = alast * iaref; gtv[c] = alast; gprod *= alast; }
            __syncthreads();
            if (!PA) {
                { const int cc = 16 * wave + 4 * kq; const float s0 = c1[cc], s1 = c1[cc + 1], s2 = c1[cc + 2], s3 = c1[cc + 3];
#pragma unroll
                  for (int vt = 0; vt < 8; ++vt) { u32x2_t w; w.x = pk2(s0 * S[vt][0], s1 * S[vt][1]); w.y = pk2(s2 * S[vt][2], s3 * S[vt][3]); *(u32x2_t*)(SbT + (16 * vt + r16) * 136 + cc) = w; } }
                { const int tt = wave >> 1;
#pragma unroll
                  for (int si = 0; si < 2; ++si) { const int ss = 2 * (wave & 1) + si; f32x4_t ac = (f32x4_t){0.f, 0.f, 0.f, 0.f};
#pragma unroll
                      for (int kk = 0; kk < 4; ++kk) { const bf16x8_t av = *(const bf16x8_t*)(qin + (16 * tt + r16) * 136 + 32 * kk + 8 * kq); const bf16x8_t bv = *(const bf16x8_t*)(kin + (16 * ss + r16) * 136 + 32 * kk + 8 * kq);
                          ac = __builtin_amdgcn_mfma_f32_16x16x32_bf16(av, bv, ac, 0, 0, 0); }
#pragma unroll
                      for (int e = 0; e < 4; ++e) { const int t = 16 * tt + 4 * kq + e, s = 16 * ss + r16; Pm[t * 72 + s] = (bf16)f2bf(s <= t ? ac[e] : 0.f); } } }
                __syncthreads();
            }
            f32x4_t kv[8];
            { const bf16x8_t a0 = *(const bf16x8_t*)(kinT + (16 * wave + r16) * 72 + 8 * kq), a1 = *(const bf16x8_t*)(kinT + (16 * wave + r16) * 72 + 32 + 8 * kq);
#pragma unroll
              for (int vt = 0; vt < 8; ++vt) { kv[vt] = (f32x4_t){0.f, 0.f, 0.f, 0.f};
                  kv[vt] = __builtin_amdgcn_mfma_f32_16x16x32_bf16(a0, *(const bf16x8_t*)(iT + (16 * vt + r16) * 72 + 8 * kq), kv[vt], 0, 0, 0);
                  kv[vt] = __builtin_amdgcn_mfma_f32_16x16x32_bf16(a1, *(const bf16x8_t*)(iT + (16 * vt + r16) * 72 + 32 + 8 * kq), kv[vt], 0, 0, 0); } }
            if (!PA) { const int tt = wave & 3;
#pragma unroll
                for (int vi = 0; vi < 4; ++vi) { const int vt = 4 * (wave >> 2) + vi; f32x4_t o = (f32x4_t){0.f, 0.f, 0.f, 0.f};
#pragma unroll
                    for (int kk = 0; kk < 2; ++kk) o = __builtin_amdgcn_mfma_f32_16x16x32_bf16(*(const bf16x8_t*)(Pm + (16 * tt + r16) * 72 + 32 * kk + 8 * kq), *(const bf16x8_t*)(iT + (16 * vt + r16) * 72 + 32 * kk + 8 * kq), o, 0, 0, 0);
#pragma unroll
                    for (int kk = 0; kk < 4; ++kk) o = __builtin_amdgcn_mfma_f32_16x16x32_bf16(*(const bf16x8_t*)(qin + (16 * tt + r16) * 136 + 32 * kk + 8 * kq), *(const bf16x8_t*)(SbT + (16 * vt + r16) * 136 + 32 * kk + 8 * kq), o, 0, 0, 0);
#pragma unroll
                    for (int e = 0; e < 4; ++e) kin[(16 * tt + 4 * kq + e) * 136 + 16 * vt + r16] = (bf16)f2bf(o[e]); } }
            { const int cc = 16 * wave + 4 * kq;
#pragma unroll
              for (int e = 0; e < 4; ++e) { const float ge = gtv[cc + e], ce = c2[cc + e];
#pragma unroll
                  for (int vt = 0; vt < 8; ++vt) S[vt][e] = ge * S[vt][e] + ce * kv[vt][e]; } }
            __syncthreads();
            if (!PA) { const size_t row = cbase + (dir ? 63 - jr : jr);
                *(u32x4_t*)(Op + row * 1024 + head * 128 + part * 16) = *(const u32x4_t*)(kin + jr * 136 + part * 16);
                *(u32x4_t*)(Op + row * 1024 + head * 128 + part * 16 + 8) = *(const u32x4_t*)(kin + jr * 136 + part * 16 + 8); }
        }
        if (PA) {
#pragma unroll
            for (int e = 0; e < 4; ++e) { const int kr = 16 * wave + 4 * kq + e;
#pragma unroll
                for (int vt = 0; vt < 8; ++vt) myPsi[kr * 128 + 16 * vt + r16] = S[vt][e]; }
            if (seg == 0) myG[c] = gprod;
        }
    }
}

__device__ __forceinline__ void hgrn_gate(const bf16* OFb, const bf16* OBb, bf16* G, const float* onorm, int tid) {
    const int lane = tid & 63, wave = tid >> 6; const int gw = blockIdx.x * 8 + wave, NGW = gridDim.x * 8;
    for (int r = gw; r < SLAB; r += NGW) {
        const size_t off = (size_t)r * 1024 + 16 * lane;
        float o[16], g[16]; float ss = 0.f;
#pragma unroll
        for (int h = 0; h < 2; ++h) { const u32x4_t a = *(const u32x4_t*)(OFb + off + 8 * h), b = *(const u32x4_t*)(OBb + off + 8 * h), gg = *(const u32x4_t*)(G + off + 8 * h);
            const unsigned aw[4] = {a.x, a.y, a.z, a.w}, bw[4] = {b.x, b.y, b.z, b.w}, gw4[4] = {gg.x, gg.y, gg.z, gg.w};
#pragma unroll
            for (int q = 0; q < 4; ++q) { o[8 * h + 2 * q] = __uint_as_float(aw[q] << 16) + __uint_as_float(bw[q] << 16); o[8 * h + 2 * q + 1] = __uint_as_float(aw[q] & 0xffff0000u) + __uint_as_float(bw[q] & 0xffff0000u);
                g[8 * h + 2 * q] = __uint_as_float(gw4[q] << 16); g[8 * h + 2 * q + 1] = __uint_as_float(gw4[q] & 0xffff0000u); } }
#pragma unroll
        for (int i = 0; i < 16; ++i) ss += o[i] * o[i];
        ss += __shfl_xor(ss, 1); ss += __shfl_xor(ss, 2); ss += __shfl_xor(ss, 4);
        const float rs = rsqrtf(ss * (1.0f / 128.0f) + NEPS);
        float res[16];
#pragma unroll
        for (int i = 0; i < 16; ++i) res[i] = o[i] * rs * onorm[16 * lane + i] * g[i];
#pragma unroll
        for (int h = 0; h < 2; ++h) { u32x4_t w; w.x = pk2(res[8 * h], res[8 * h + 1]); w.y = pk2(res[8 * h + 2], res[8 * h + 3]); w.z = pk2(res[8 * h + 4], res[8 * h + 5]); w.w = pk2(res[8 * h + 6], res[8 * h + 7]);
            *(u32x4_t*)(G + off + 8 * h) = w; }
    }
}

__device__ __forceinline__ void rwkv_mix(const bf16* HB, const float* ssq, const float* gain, const float* mu, bf16* P0, bf16* P1, int row0, int tid) {
    const int lane = tid & 63, wave = tid >> 6; const int gw = blockIdx.x * 8 + wave, NGW = gridDim.x * 8;
    for (int lr = gw; lr < SLAB; lr += NGW) {
        const int r = row0 + lr; const bool pad = row_is_pad(r);
        const float rs = rsqrtf(pg8::row_ssq16(ssq, r) * (1.0f / 1024.0f) + NEPS);
        const float rsm = (r > 0) ? rsqrtf(pg8::row_ssq16(ssq, r - 1) * (1.0f / 1024.0f) + NEPS) : 0.f;
        const float rsp = (r < TROWS - 1) ? rsqrtf(pg8::row_ssq16(ssq, r + 1) * (1.0f / 1024.0f) + NEPS) : 0.f;
#pragma unroll
        for (int h = 0; h < 2; ++h) { const int col = 16 * lane + 8 * h; const size_t off = (size_t)r * 1024 + col;
            u32x4_t a = *(const u32x4_t*)(HB + off), am = (u32x4_t){0u, 0u, 0u, 0u}, ap = (u32x4_t){0u, 0u, 0u, 0u};
            if (r > 0) am = *(const u32x4_t*)(HB + off - 1024);
            if (r < TROWS - 1) ap = *(const u32x4_t*)(HB + off + 1024);
            const unsigned aw[4] = {a.x, a.y, a.z, a.w}, mw[4] = {am.x, am.y, am.z, am.w}, pw[4] = {ap.x, ap.y, ap.z, ap.w};
            float xr[8], xk[8], xv[8], xx[8];
            const f32x4_t ga = *(const f32x4_t*)(gain + col), gb = *(const f32x4_t*)(gain + col + 4);
            const f32x4_t ra = *(const f32x4_t*)(mu + col), rb = *(const f32x4_t*)(mu + col + 4), ka = *(const f32x4_t*)(mu + 2048 + col), kb = *(const f32x4_t*)(mu + 2048 + col + 4), va = *(const f32x4_t*)(mu + 3072 + col), vb = *(const f32x4_t*)(mu + 3072 + col + 4);
            const float keep = pad ? 0.f : 1.f;
#pragma unroll
            for (int q = 0; q < 4; ++q) {
#pragma unroll
                for (int hh = 0; hh < 2; ++hh) { const int i8 = 2 * q + hh; const float g0 = (i8 < 4 ? ga[i8 & 3] : gb[i8 & 3]) * keep;
                    const float mr = i8 < 4 ? ra[i8 & 3] : rb[i8 & 3], mk = i8 < 4 ? ka[i8 & 3] : kb[i8 & 3], mv = i8 < 4 ? va[i8 & 3] : vb[i8 & 3];
                    const float x0 = (hh ? __uint_as_float(aw[q] & 0xffff0000u) : __uint_as_float(aw[q] << 16)) * rs * g0;
                    const float m0 = (hh ? __uint_as_float(mw[q] & 0xffff0000u) : __uint_as_float(mw[q] << 16)) * rsm * g0;
                    const float p0 = (hh ? __uint_as_float(pw[q] & 0xffff0000u) : __uint_as_float(pw[q] << 16)) * rsp * g0;
                    const float d0 = 0.5f * (m0 + p0) - x0;
                    xx[i8] = d0; xr[i8] = x0 + d0 * mr; xk[i8] = x0 + d0 * mk; xv[i8] = x0 + d0 * mv; } }
            u32x4_t w; w.x = pk2(xr[0], xr[1]); w.y = pk2(xr[2], xr[3]); w.z = pk2(xr[4], xr[5]); w.w = pk2(xr[6], xr[7]);
            *(u32x4_t*)(P0 + (size_t)lr * 2048 + col) = w;
            w.x = pk2(xx[0], xx[1]); w.y = pk2(xx[2], xx[3]); w.z = pk2(xx[4], xx[5]); w.w = pk2(xx[6], xx[7]);
            *(u32x4_t*)(P0 + (size_t)lr * 2048 + 1024 + col) = w;
            w.x = pk2(xk[0], xk[1]); w.y = pk2(xk[2], xk[3]); w.z = pk2(xk[4], xk[5]); w.w = pk2(xk[6], xk[7]);
            *(u32x4_t*)(P1 + (size_t)lr * 2048 + col) = w;
            w.x = pk2(xv[0], xv[1]); w.y = pk2(xv[2], xv[3]); w.z = pk2(xv[4], xv[5]); w.w = pk2(xv[6], xv[7]);
            *(u32x4_t*)(P1 + (size_t)lr * 2048 + 1024 + col) = w; }
    }
}

__device__ __forceinline__ void rwkv_scan_seq(unsigned char* lds, const bf16* Rb, const bf16* Kb, const bf16* Vb, const bf16* HWb, const bf16* HAb, bf16* OFb, bf16* OBb, float* beta,
                                              ArgP a, int slab, int tid) {
    float* w2s = (float*)lds; float* a2s = w2s + 4096; float* rS = a2s + 4096; float* kdS = rS + 4096; float* vS = kdS + 4096; float* wS = vS + 4096; float* kkS = wS + 4096; float* kkaS = kkS + 4096;
    const int nitems = (slab == 0 ? 2 : 1) * 32, nch = slab == 0 ? 129 : 257;
    const int j = tid >> 3, part = tid & 7, c8 = part * 8;
    for (int item = blockIdx.x; item < nitems; item += gridDim.x) {
        const int d = item & 1, head = (item >> 1) & 15, sq = item >> 5; const int seqbase = sq * 8256; const int hc8 = head * 64 + c8;
        bf16* Op = d ? OBb : OFb;
        const float* w0 = a->in[15] + d * 1024; const float* w2 = a->in[17] + (size_t)d * 64 * 1024; const float* a0 = a->in[18] + d * 1024; const float* a2 = a->in[20] + (size_t)d * 64 * 1024;
        const float* pkk = a->in[23]; const float* pka = a->in[24]; const float* prk = a->in[25];
        __syncthreads();
        for (int i = tid; i < 4096; i += 512) { const int l = i >> 6, cc = i & 63; w2s[i] = w2[(size_t)l * 1024 + head * 64 + cc]; a2s[i] = a2[(size_t)l * 1024 + head * 64 + cc]; }
        float s[8];
#pragma unroll
        for (int e = 0; e < 8; ++e) s[e] = 0.f;
        __syncthreads();
        for (int p = 0; p < nch; ++p) {
            const int cidx = d ? nch - 1 - p : p; const int cbase = seqbase + cidx * 64;
            const size_t row = cbase + (d ? 63 - j : j);
            asm volatile("" ::: "memory");
            float w0c[8], a0c[8];
#pragma unroll
            for (int e = 0; e < 8; ++e) { w0c[e] = w0[hc8 + e]; a0c[e] = a0[hc8 + e]; }
            const u32x4_t rw = *(const u32x4_t*)(Rb + row * 1024 + hc8), kw = *(const u32x4_t*)(Kb + row * 1024 + hc8), vw = *(const u32x4_t*)(Vb + row * 1024 + hc8);
            const unsigned rwa[4] = {rw.x, rw.y, rw.z, rw.w}, kwa[4] = {kw.x, kw.y, kw.z, kw.w}, vwa[4] = {vw.x, vw.y, vw.z, vw.w};
            float rv[8], kv[8], vv[8], z[8], aa[8];
#pragma unroll
            for (int q = 0; q < 4; ++q) { rv[2 * q] = __uint_as_float(rwa[q] << 16); rv[2 * q + 1] = __uint_as_float(rwa[q] & 0xffff0000u); kv[2 * q] = __uint_as_float(kwa[q] << 16); kv[2 * q + 1] = __uint_as_float(kwa[q] & 0xffff0000u);
                vv[2 * q] = __uint_as_float(vwa[q] << 16); vv[2 * q + 1] = __uint_as_float(vwa[q] & 0xffff0000u); }
#pragma unroll
            for (int e = 0; e < 8; ++e) { z[e] = w0c[e]; aa[e] = a0c[e]; }
#pragma unroll 1
            for (int l8 = 0; l8 < 8; ++l8) { const u32x4_t hw = *(const u32x4_t*)(HWb + row * 128 + d * 64 + 8 * l8), ha = *(const u32x4_t*)(HAb + row * 128 + d * 64 + 8 * l8);
                const unsigned hwa[4] = {hw.x, hw.y, hw.z, hw.w}, haa[4] = {ha.x, ha.y, ha.z, ha.w};
#pragma unroll
                for (int q = 0; q < 4; ++q) {
#pragma unroll
                    for (int hh = 0; hh < 2; ++hh) { const int l = 8 * l8 + 2 * q + hh; const float hwv = hh ? __uint_as_float(hwa[q] & 0xffff0000u) : __uint_as_float(hwa[q] << 16); const float hav = hh ? __uint_as_float(haa[q] & 0xffff0000u) : __uint_as_float(haa[q] << 16);
                        const f32x4_t wa = *(const f32x4_t*)(w2s + l * 64 + c8), wb = *(const f32x4_t*)(w2s + l * 64 + c8 + 4), xa = *(const f32x4_t*)(a2s + l * 64 + c8), xb = *(const f32x4_t*)(a2s + l * 64 + c8 + 4);
#pragma unroll
                        for (int e = 0; e < 4; ++e) { z[e] += hwv * wa[e]; z[4 + e] += hwv * wb[e]; aa[e] += hav * xa[e]; aa[4 + e] += hav * xb[e]; }
                        if (hh) asm volatile("" ::: "memory"); } } }
            asm volatile("" ::: "memory");
            float kkc[8], kac[8], rkc[8];
#pragma unroll
            for (int e = 0; e < 8; ++e) { kkc[e] = pkk[hc8 + e]; kac[e] = pka[hc8 + e]; rkc[e] = prk[hc8 + e]; }
            float kk[8], ss = 0.f, bsum = 0.f;
#pragma unroll
            for (int e = 0; e < 8; ++e) { kk[e] = kv[e] * kkc[e]; ss += kk[e] * kk[e]; }
            ss += __shfl_xor(ss, 1); ss += __shfl_xor(ss, 2); ss += __shfl_xor(ss, 4);
            const float inv = rsqrtf(fmaxf(ss, 1e-24f));
#pragma unroll
            for (int e = 0; e < 8; ++e) { const float av = sigmoidf_(aa[e]); const float wv = __expf(-0.6065306597f * sigmoidf_(z[e])); const float kd = kv[e] * (1.0f + (av - 1.0f) * kac[e]); const float kkn = kk[e] * inv;
                bsum += rv[e] * kd * rkc[e];
                rS[j * 64 + c8 + e] = rv[e]; kdS[j * 64 + c8 + e] = kd; vS[j * 64 + c8 + e] = vv[e]; wS[j * 64 + c8 + e] = wv; kkS[j * 64 + c8 + e] = kkn; kkaS[j * 64 + c8 + e] = kkn * av; }
            bsum += __shfl_xor(bsum, 1); bsum += __shfl_xor(bsum, 2); bsum += __shfl_xor(bsum, 4);
            if (part == 0) beta[((size_t)d * SLAB + row) * 16 + head] = bsum;
            __syncthreads();
#pragma unroll 1
            for (int st = 0; st < 64; ++st) {
                const f32x4_t k0 = *(const f32x4_t*)(kkS + st * 64 + c8), k1 = *(const f32x4_t*)(kkS + st * 64 + c8 + 4);
                const f32x4_t wv0 = *(const f32x4_t*)(wS + st * 64 + c8), wv1 = *(const f32x4_t*)(wS + st * 64 + c8 + 4);
                const f32x4_t ka0 = *(const f32x4_t*)(kkaS + st * 64 + c8), ka1 = *(const f32x4_t*)(kkaS + st * 64 + c8 + 4);
                const f32x4_t kd0 = *(const f32x4_t*)(kdS + st * 64 + c8), kd1 = *(const f32x4_t*)(kdS + st * 64 + c8 + 4);
                const f32x4_t r0 = *(const f32x4_t*)(rS + st * 64 + c8), r1 = *(const f32x4_t*)(rS + st * 64 + c8 + 4);
                const float vi = vS[st * 64 + j];
                float sa = 0.f;
#pragma unroll
                for (int e = 0; e < 4; ++e) sa += s[e] * k0[e] + s[4 + e] * k1[e];
                sa += __shfl_xor(sa, 1); sa += __shfl_xor(sa, 2); sa += __shfl_xor(sa, 4);
                float y = 0.f;
#pragma unroll
                for (int e = 0; e < 4; ++e) { s[e] = s[e] * wv0[e] - sa * ka0[e] + vi * kd0[e]; s[4 + e] = s[4 + e] * wv1[e] - sa * ka1[e] + vi * kd1[e]; y += s[e] * r0[e] + s[4 + e] * r1[e]; }
                y += __shfl_xor(y, 1); y += __shfl_xor(y, 2); y += __shfl_xor(y, 4);
                if (part == 0) { const size_t orow = cbase + (d ? 63 - st : st); Op[orow * 1024 + head * 64 + j] = (bf16)f2bf(y); }
            }
            __syncthreads();
        }
    }
}

__device__ __forceinline__ void mm2(f32x4_t (&acc)[2], const bf16* A, const bf16* Bt, int mt, int ntb, int r16, int kq) {
#pragma unroll
    for (int kk = 0; kk < 2; ++kk) { const bf16x8_t av = *(const bf16x8_t*)(A + (16 * mt + r16) * 72 + 32 * kk + 8 * kq);
#pragma unroll
        for (int i = 0; i < 2; ++i) { const bf16x8_t bv = *(const bf16x8_t*)(Bt + (16 * (ntb + i) + r16) * 72 + 32 * kk + 8 * kq); acc[i] = __builtin_amdgcn_mfma_f32_16x16x32_bf16(av, bv, acc[i], 0, 0, 0); } }
}
__device__ __forceinline__ void st_rm(bf16* dst, const f32x4_t (&acc)[2], int mt, int ntb, int r16, int kq) {
#pragma unroll
    for (int i = 0; i < 2; ++i) { const unsigned w0 = pk2(acc[i][0], acc[i][1]), w1 = pk2(acc[i][2], acc[i][3]); bf16* d = dst + (16 * mt + 4 * kq) * 72 + 16 * (ntb + i) + r16;
        d[0] = (bf16)(w0 & 0xffffu); d[72] = (bf16)(w0 >> 16); d[144] = (bf16)(w1 & 0xffffu); d[216] = (bf16)(w1 >> 16); }
}
__device__ __forceinline__ void st_tr(bf16* dst, const f32x4_t (&acc)[2], int mt, int ntb, int r16, int kq) {
#pragma unroll
    for (int i = 0; i < 2; ++i) { u32x2_t w; w.x = pk2(acc[i][0], acc[i][1]); w.y = pk2(acc[i][2], acc[i][3]); *(u32x2_t*)(dst + (16 * (ntb + i) + r16) * 72 + 16 * mt + 4 * kq) = w; }
}
template <bool PA>
__device__ __forceinline__ void rwkv_scan_chunk(unsigned char* lds, const bf16* Rb, const bf16* Kb, const bf16* Vb, const bf16* HWb, const bf16* HAb, bf16* OFb, bf16* OBb, float* beta, float* segm, bf16* tbuf,
                                                ArgP a, int slab, int tid) {
    bf16* M = (bf16*)lds;
#define MAT(i) (M + (i) * 4608)
    bf16* w2T = MAT(13); bf16* a2T = MAT(14); float* wc = (float*)MAT(15); float* cst = wc + 64;
    float* zbuf = (float*)MAT(0); float* abuf = zbuf + 4096;
    float* cumb = (float*)MAT(10); float* segtot = cumb + 4096;
    const int nch = slab == 0 ? 129 : 257, G = slab == 0 ? 4 : 8, nitems = 256, NCHA = nch;
    const int lane = tid & 63, wave = tid >> 6, r16 = lane & 15, kq = lane >> 4, mt = wave >> 1, ntb = 2 * (wave & 1);
    const int j = tid >> 3, part = tid & 7, c8 = part * 8;
    const int tunit = ((j >> 3) + 1) * (4 * (j >> 3) + (j & 7)) + part; const bool tlow = part <= (j >> 3);
    for (int item = blockIdx.x; item < nitems; item += gridDim.x) {
        const int g = item % G, strm = item / G; const int p0 = g == 0 ? 0 : 1 + 32 * g, p1 = 33 + 32 * g;
        const bool haveT = !PA;
        const int d = strm & 1, head = (strm >> 1) & 15, sq = strm >> 5; const int seqbase = sq * 8256; const int hc8 = head * 64 + c8;
        bf16* Op = d ? OBb : OFb;
        const float* w0 = a->in[15] + d * 1024; const float* w2 = a->in[17] + (size_t)d * 64 * 1024; const float* a0 = a->in[18] + d * 1024; const float* a2 = a->in[20] + (size_t)d * 64 * 1024;
        __syncthreads();
        if (tid < 320) { const int wch = tid >> 6, cc = tid & 63; const float* src = wch == 0 ? w0 : (wch == 1 ? a0 : (wch == 2 ? a->in[23] : (wch == 3 ? a->in[24] : a->in[25]))); cst[tid] = src[head * 64 + cc]; }
        for (int i = tid; i < 4096; i += 512) { const int l = i >> 6, cc = i & 63; w2T[cc * 72 + l] = (bf16)f2bf(w2[(size_t)l * 1024 + head * 64 + cc]); a2T[cc * 72 + l] = (bf16)f2bf(a2[(size_t)l * 1024 + head * 64 + cc]); }
        f32x4_t Sacc[2], S2acc[2]; Sacc[0] = (f32x4_t){0.f, 0.f, 0.f, 0.f}; Sacc[1] = Sacc[0];
#pragma unroll
        for (int i = 0; i < 2; ++i)
#pragma unroll
            for (int e = 0; e < 4; ++e) S2acc[i][e] = (16 * mt + 4 * kq + e == 16 * (ntb + i) + r16) ? 1.f : 0.f;
        __syncthreads();
        if (!PA) {
            for (int gg = 0; gg < g; ++gg) {
                const float* Psi = segm + (size_t)(strm * G + gg) * 8192; const float* Phi = Psi + 4096;
                { const f32x4_t q0 = *(const f32x4_t*)(Phi + j * 64 + c8), q1 = *(const f32x4_t*)(Phi + j * 64 + c8 + 4);
#pragma unroll
                  for (int e = 0; e < 4; ++e) { MAT(1)[(c8 + e) * 72 + j] = (bf16)f2bf(q0[e]); MAT(1)[(c8 + 4 + e) * 72 + j] = (bf16)f2bf(q1[e]); } }
                st_rm(MAT(0), Sacc, mt, ntb, r16, kq);
                __syncthreads();
#pragma unroll
                for (int i = 0; i < 2; ++i)
#pragma unroll
                    for (int e = 0; e < 4; ++e) Sacc[i][e] = Psi[(16 * mt + 4 * kq + e) * 64 + 16 * (ntb + i) + r16];
                mm2(Sacc, MAT(0), MAT(1), mt, ntb, r16, kq);
                __syncthreads();
            }
        }
        for (int p = p0; p < p1; ++p) {
            const int cidx = d ? nch - 1 - p : p; const int cbase = seqbase + cidx * 64;
            float rv[8], kk[8], av[8], kd[8], lw[8]; u32x4_t tld = (u32x4_t){0u, 0u, 0u, 0u}, vraw = (u32x4_t){0u, 0u, 0u, 0u};
            {
                const size_t row = cbase + (d ? 63 - j : j);
                asm volatile("" ::: "memory");
                if (haveT && tlow) tld = *(const u32x4_t*)(tbuf + ((size_t)strm * NCHA + p) * 2304 + tunit * 8);
                *(u32x4_t*)(MAT(4) + j * 72 + c8) = *(const u32x4_t*)(HWb + row * 128 + d * 64 + c8);
                *(u32x4_t*)(MAT(5) + j * 72 + c8) = *(const u32x4_t*)(HAb + row * 128 + d * 64 + c8);
                const u32x4_t rw = *(const u32x4_t*)(Rb + row * 1024 + hc8), kw = *(const u32x4_t*)(Kb + row * 1024 + hc8), vw = *(const u32x4_t*)(Vb + row * 1024 + hc8);
                __syncthreads();
                { f32x4_t za[2], xa[2]; za[0] = (f32x4_t){0.f, 0.f, 0.f, 0.f}; za[1] = za[0]; xa[0] = za[0]; xa[1] = za[0];
                  mm2(za, MAT(4), w2T, mt, ntb, r16, kq); mm2(xa, MAT(5), a2T, mt, ntb, r16, kq);
#pragma unroll
                  for (int i = 0; i < 2; ++i)
#pragma unroll
                      for (int e = 0; e < 4; ++e) { zbuf[(16 * mt + 4 * kq + e) * 64 + 16 * (ntb + i) + r16] = za[i][e]; abuf[(16 * mt + 4 * kq + e) * 64 + 16 * (ntb + i) + r16] = xa[i][e]; } }
                __syncthreads();
                const unsigned rwa[4] = {rw.x, rw.y, rw.z, rw.w}, kwa[4] = {kw.x, kw.y, kw.z, kw.w};
                float kv[8], z[8], aa[8];
#pragma unroll
                for (int q = 0; q < 4; ++q) { rv[2 * q] = __uint_as_float(rwa[q] << 16); rv[2 * q + 1] = __uint_as_float(rwa[q] & 0xffff0000u); kv[2 * q] = __uint_as_float(kwa[q] << 16); kv[2 * q + 1] = __uint_as_float(kwa[q] & 0xffff0000u);
                }
                vraw = vw;
                { const f32x4_t z0 = *(const f32x4_t*)(zbuf + j * 64 + c8), z1 = *(const f32x4_t*)(zbuf + j * 64 + c8 + 4), x0 = *(const f32x4_t*)(abuf + j * 64 + c8), x1 = *(const f32x4_t*)(abuf + j * 64 + c8 + 4);
#pragma unroll
                  for (int e = 0; e < 4; ++e) { z[e] = cst[c8 + e] + z0[e]; z[4 + e] = cst[c8 + 4 + e] + z1[e]; aa[e] = cst[64 + c8 + e] + x0[e]; aa[4 + e] = cst[64 + c8 + 4 + e] + x1[e]; } }
                asm volatile("" ::: "memory");
                float ss = 0.f, bsum = 0.f;
#pragma unroll
                for (int e = 0; e < 8; ++e) { kk[e] = kv[e] * cst[128 + c8 + e]; ss += kk[e] * kk[e]; }
                ss += __shfl_xor(ss, 1); ss += __shfl_xor(ss, 2); ss += __shfl_xor(ss, 4);
                const float inv = rsqrtf(fmaxf(ss, 1e-24f));
#pragma unroll
                for (int e = 0; e < 8; ++e) { av[e] = sigmoidf_(aa[e]); lw[e] = -0.6065306597f * sigmoidf_(z[e]); kd[e] = kv[e] * (1.0f + (av[e] - 1.0f) * cst[192 + c8 + e]); kk[e] *= inv; bsum += rv[e] * kd[e] * cst[256 + c8 + e]; }
                bsum += __shfl_xor(bsum, 1); bsum += __shfl_xor(bsum, 2); bsum += __shfl_xor(bsum, 4);
                if (!PA && part == 0) beta[((size_t)d * SLAB + row) * 16 + head] = bsum;
                *(f32x4_t*)(cumb + j * 64 + c8) = (f32x4_t){lw[0], lw[1], lw[2], lw[3]}; *(f32x4_t*)(cumb + j * 64 + c8 + 4) = (f32x4_t){lw[4], lw[5], lw[6], lw[7]};
            }
            __syncthreads();
            { const int c = tid & 63, sg = tid >> 6; float run = 0.f;
#pragma unroll
              for (int i = 0; i < 8; ++i) { run += cumb[(8 * sg + i) * 64 + c]; cumb[(8 * sg + i) * 64 + c] = run; }
              segtot[sg * 64 + c] = run; }
            __syncthreads();
            { const int c = tid & 63, sg = tid >> 6; float off = 0.f;
#pragma unroll
              for (int s = 0; s < 7; ++s) off += (s < sg) ? segtot[s * 64 + c] : 0.f;
#pragma unroll
              for (int i = 0; i < 8; ++i) cumb[(8 * sg + i) * 64 + c] += off; }
            __syncthreads();
            {
                const f32x4_t c0 = *(const f32x4_t*)(cumb + j * 64 + c8), c1 = *(const f32x4_t*)(cumb + j * 64 + c8 + 4);
                float ah[8], bh[8], kh[8], rh[8];
#pragma unroll
                for (int e = 0; e < 8; ++e) { const float cu = e < 4 ? c0[e & 3] : c1[e & 3]; const float Wt = __expf(cu), iW = __expf(-cu), Wm1 = __expf(cu - lw[e]);
                    ah[e] = kk[e] * Wm1; bh[e] = -(kk[e] * av[e]) * iW; kh[e] = kd[e] * iW; rh[e] = rv[e] * Wt;
                    if (j == 63) wc[c8 + e] = Wt; }
                u32x4_t w;
                w.x = pk2(ah[0], ah[1]); w.y = pk2(ah[2], ah[3]); w.z = pk2(ah[4], ah[5]); w.w = pk2(ah[6], ah[7]); *(u32x4_t*)(MAT(0) + j * 72 + c8) = w;
                u32x4_t wb, wk;
                wb.x = pk2(bh[0], bh[1]); wb.y = pk2(bh[2], bh[3]); wb.z = pk2(bh[4], bh[5]); wb.w = pk2(bh[6], bh[7]); *(u32x4_t*)(MAT(1) + j * 72 + c8) = wb;
                wk.x = pk2(kh[0], kh[1]); wk.y = pk2(kh[2], kh[3]); wk.z = pk2(kh[4], kh[5]); wk.w = pk2(kh[6], kh[7]); *(u32x4_t*)(MAT(2) + j * 72 + c8) = wk;
                w.x = pk2(rh[0], rh[1]); w.y = pk2(rh[2], rh[3]); w.z = pk2(rh[4], rh[5]); w.w = pk2(rh[6], rh[7]); *(u32x4_t*)(MAT(3) + j * 72 + c8) = w;
                { const unsigned wba[4] = {wb.x, wb.y, wb.z, wb.w}, wka[4] = {wk.x, wk.y, wk.z, wk.w}, wva[4] = {vraw.x, vraw.y, vraw.z, vraw.w};
#pragma unroll
                  for (int q = 0; q < 4; ++q) { bf16* d4 = MAT(4) + (c8 + 2 * q) * 72 + j; bf16* d5 = MAT(5) + (c8 + 2 * q) * 72 + j; bf16* d6 = MAT(6) + (c8 + 2 * q) * 72 + j;
                      d4[0] = (bf16)(wba[q] & 0xffffu); d4[72] = (bf16)(wba[q] >> 16); d5[0] = (bf16)(wka[q] & 0xffffu); d5[72] = (bf16)(wka[q] >> 16); d6[0] = (bf16)(wva[q] & 0xffffu); d6[72] = (bf16)(wva[q] >> 16); } }
                if (haveT) *(u32x4_t*)(MAT(9) + j * 72 + c8) = tld;
                st_rm(MAT(7), Sacc, mt, ntb, r16, kq);
                if (PA) st_rm(MAT(12), S2acc, mt, ntb, r16, kq);
            }
            __syncthreads();
            f32x4_t Pacc[2], Tacc[2], Xacc[2], Yacc[2], tmp[2];
            const f32x4_t z4 = (f32x4_t){0.f, 0.f, 0.f, 0.f};
            Tacc[0] = z4; Tacc[1] = z4;
            if (!haveT) {
            Pacc[0] = z4; Pacc[1] = z4; mm2(Pacc, MAT(0), MAT(1), mt, ntb, r16, kq);
#pragma unroll
            for (int i = 0; i < 2; ++i)
#pragma unroll
                for (int e = 0; e < 4; ++e) { const int t = 16 * mt + 4 * kq + e, s = 16 * (ntb + i) + r16; Pacc[i][e] = (s < t) ? Pacc[i][e] : 0.f; Tacc[i][e] = Pacc[i][e] + ((s == t) ? 1.f : 0.f); }
            st_rm(MAT(8), Pacc, mt, ntb, r16, kq); st_tr(MAT(9), Pacc, mt, ntb, r16, kq);
            }
            tmp[0] = z4; tmp[1] = z4; mm2(tmp, MAT(0), MAT(2), mt, ntb, r16, kq);
#pragma unroll
            for (int i = 0; i < 2; ++i)
#pragma unroll
                for (int e = 0; e < 4; ++e) { const int t = 16 * mt + 4 * kq + e, s = 16 * (ntb + i) + r16; tmp[i][e] = (s < t) ? tmp[i][e] : 0.f; }
            st_rm(MAT(10), tmp, mt, ntb, r16, kq);
            f32x4_t X2acc[2]; X2acc[0] = z4; X2acc[1] = z4;
            if (PA) mm2(X2acc, MAT(0), MAT(12), mt, ntb, r16, kq);
            if (!PA) {
            tmp[0] = z4; tmp[1] = z4; mm2(tmp, MAT(3), MAT(1), mt, ntb, r16, kq);
#pragma unroll
            for (int i = 0; i < 2; ++i)
#pragma unroll
                for (int e = 0; e < 4; ++e) { const int t = 16 * mt + 4 * kq + e, s = 16 * (ntb + i) + r16; tmp[i][e] = (s <= t) ? tmp[i][e] : 0.f; }
            st_rm(MAT(11), tmp, mt, ntb, r16, kq);
            tmp[0] = z4; tmp[1] = z4; mm2(tmp, MAT(3), MAT(2), mt, ntb, r16, kq);
#pragma unroll
            for (int i = 0; i < 2; ++i)
#pragma unroll
                for (int e = 0; e < 4; ++e) { const int t = 16 * mt + 4 * kq + e, s = 16 * (ntb + i) + r16; tmp[i][e] = (s <= t) ? tmp[i][e] : 0.f; }
            st_rm(MAT(12), tmp, mt, ntb, r16, kq);
            }
            Xacc[0] = z4; Xacc[1] = z4; mm2(Xacc, MAT(0), MAT(7), mt, ntb, r16, kq);
            Yacc[0] = z4; Yacc[1] = z4; if (!PA) mm2(Yacc, MAT(3), MAT(7), mt, ntb, r16, kq);
            __syncthreads();
            if (!haveT) {
            tmp[0] = z4; tmp[1] = z4; mm2(tmp, MAT(8), MAT(9), mt, ntb, r16, kq);
            st_rm(MAT(0), tmp, mt, ntb, r16, kq); st_tr(MAT(1), tmp, mt, ntb, r16, kq); st_rm(MAT(2), Tacc, mt, ntb, r16, kq);
            __syncthreads();
#pragma unroll
            for (int i = 1; i <= 5; ++i) {
                bf16* Pc = (i & 1) ? MAT(0) : MAT(8); bf16* PcT = (i & 1) ? MAT(1) : MAT(9); bf16* Pn = (i & 1) ? MAT(8) : MAT(0); bf16* PnT = (i & 1) ? MAT(9) : MAT(1);
                bf16* Tc = (i & 1) ? MAT(2) : MAT(3); bf16* Tn = (i & 1) ? MAT(3) : MAT(2);
                mm2(Tacc, Tc, PcT, mt, ntb, r16, kq);
                if (i < 5) { tmp[0] = z4; tmp[1] = z4; mm2(tmp, Pc, PcT, mt, ntb, r16, kq); st_rm(Pn, tmp, mt, ntb, r16, kq); st_tr(PnT, tmp, mt, ntb, r16, kq); }
                st_rm(Tn, Tacc, mt, ntb, r16, kq);
                __syncthreads();
            }
            }
            if (PA && tlow) *(u32x4_t*)(tbuf + ((size_t)strm * NCHA + p) * 2304 + tunit * 8) = *(const u32x4_t*)(MAT(3) + j * 72 + c8);
            const bf16* Tm = haveT ? MAT(9) : MAT(3);
            mm2(Xacc, MAT(10), MAT(6), mt, ntb, r16, kq);
            st_tr(MAT(7), Xacc, mt, ntb, r16, kq);
            if (PA) st_tr(MAT(11), X2acc, mt, ntb, r16, kq);
            __syncthreads();
            tmp[0] = z4; tmp[1] = z4; mm2(tmp, Tm, MAT(7), mt, ntb, r16, kq);
            st_tr(MAT(8), tmp, mt, ntb, r16, kq);
            if (PA) { tmp[0] = z4; tmp[1] = z4; mm2(tmp, MAT(3), MAT(11), mt, ntb, r16, kq); st_tr(MAT(12), tmp, mt, ntb, r16, kq); }
            __syncthreads();
            if (!PA) { mm2(Yacc, MAT(11), MAT(8), mt, ntb, r16, kq); mm2(Yacc, MAT(12), MAT(6), mt, ntb, r16, kq);
            st_rm(MAT(7), Yacc, mt, ntb, r16, kq); }
            if (PA) mm2(S2acc, MAT(12), MAT(4), mt, ntb, r16, kq);
            mm2(Sacc, MAT(8), MAT(4), mt, ntb, r16, kq); mm2(Sacc, MAT(6), MAT(5), mt, ntb, r16, kq);
#pragma unroll
            for (int i = 0; i < 2; ++i) { const float wk = wc[16 * (ntb + i) + r16];
#pragma unroll
                for (int e = 0; e < 4; ++e) { Sacc[i][e] *= wk; S2acc[i][e] *= wk; } }
            __syncthreads();
            if (!PA) { const size_t orow = cbase + (d ? 63 - j : j); *(u32x4_t*)(Op + orow * 1024 + hc8) = *(const u32x4_t*)(MAT(7) + j * 72 + c8); }
        }
        if (PA) { float* Psi = segm + (size_t)item * 8192; float* Phi = Psi + 4096;
#pragma unroll
            for (int i = 0; i < 2; ++i)
#pragma unroll
                for (int e = 0; e < 4; ++e) { Psi[(16 * mt + 4 * kq + e) * 64 + 16 * (ntb + i) + r16] = Sacc[i][e]; Phi[(16 * mt + 4 * kq + e) * 64 + 16 * (ntb + i) + r16] = S2acc[i][e]; } }
    }
#undef MAT
}

__device__ __forceinline__ void rwkv_gn(bf16* OFb, const bf16* OBb, const bf16* Vb, const float* beta, const float* gnw, const float* gnb, int tid) {
    const int lane = tid & 63, wave = tid >> 6; const int gw = blockIdx.x * 8 + wave, NGW = gridDim.x * 8;
    for (int r = gw; r < SLAB; r += NGW) {
        const size_t off = (size_t)r * 1024 + 16 * lane; const int head = lane >> 2;
        float y[16], v[16]; float sm = 0.f;
#pragma unroll
        for (int h = 0; h < 2; ++h) { const u32x4_t a = *(const u32x4_t*)(OFb + off + 8 * h), b = *(const u32x4_t*)(OBb + off + 8 * h), vv = *(const u32x4_t*)(Vb + off + 8 * h);
            const unsigned aw[4] = {a.x, a.y, a.z, a.w}, bw[4] = {b.x, b.y, b.z, b.w}, vw[4] = {vv.x, vv.y, vv.z, vv.w};
#pragma unroll
            for (int q = 0; q < 4; ++q) { y[8 * h + 2 * q] = __uint_as_float(aw[q] << 16) + __uint_as_float(bw[q] << 16); y[8 * h + 2 * q + 1] = __uint_as_float(aw[q] & 0xffff0000u) + __uint_as_float(bw[q] & 0xffff0000u);
                v[8 * h + 2 * q] = __uint_as_float(vw[q] << 16); v[8 * h + 2 * q + 1] = __uint_as_float(vw[q] & 0xffff0000u); } }
#pragma unroll
        for (int i = 0; i < 16; ++i) sm += y[i];
        sm += __shfl_xor(sm, 1); sm += __shfl_xor(sm, 2);
        const float mean = sm * (1.0f / 64.0f); float sv = 0.f;
#pragma unroll
        for (int i = 0; i < 16; ++i) { const float dd = y[i] - mean; sv += dd * dd; }
        sv += __shfl_xor(sv, 1); sv += __shfl_xor(sv, 2);
        const float rs = rsqrtf(sv * (1.0f / 64.0f) + 64e-5f);
        const float bt = beta[(size_t)r * 16 + head] + beta[((size_t)SLAB + r) * 16 + head];
        float res[16];
#pragma unroll
        for (int i = 0; i < 16; ++i) res[i] = (y[i] - mean) * rs * gnw[16 * lane + i] + gnb[16 * lane + i] + bt * v[i];
#pragma unroll
        for (int h = 0; h < 2; ++h) { u32x4_t w; w.x = pk2(res[8 * h], res[8 * h + 1]); w.y = pk2(res[8 * h + 2], res[8 * h + 3]); w.z = pk2(res[8 * h + 4], res[8 * h + 5]); w.w = pk2(res[8 * h + 6], res[8 * h + 7]);
            *(u32x4_t*)(OFb + off + 8 * h) = w; }
    }
}

__device__ __forceinline__ void final_norm(const bf16* HBN, const float* ssq, const float* gain, float* out, int tid) {
    const int lane = tid & 63, wave = tid >> 6; const int gw = blockIdx.x * 8 + wave, NGW = gridDim.x * 8;
    for (int g = gw; g < 32768; g += NGW) {
        const int row = (g < 16384) ? 16640 + 64 + g : (g < 24576 ? 64 + (g - 16384) : 8256 + 64 + (g - 24576));
        const float rs = rsqrtf(pg8::row_ssq16(ssq, row) * (1.0f / 1024.0f) + NEPS);
#pragma unroll
        for (int jx = 0; jx < 4; ++jx) { const int col = 4 * lane + 256 * jx; const u32x2_t w = *(const u32x2_t*)(HBN + (size_t)row * 1024 + col); const f32x4_t gg = *(const f32x4_t*)(gain + col);
            f32x4_t o; o[0] = __uint_as_float(w.x << 16) * rs * gg[0]; o[1] = __uint_as_float(w.x & 0xffff0000u) * rs * gg[1]; o[2] = __uint_as_float(w.y << 16) * rs * gg[2]; o[3] = __uint_as_float(w.y & 0xffff0000u) * rs * gg[3];
            __builtin_nontemporal_store(o, (f32x4_t*)(out + (size_t)g * 1024 + col)); }
    }
}

#ifndef PHM
#define PHM 4095
#endif
__global__ void __launch_bounds__(512, 2) fwd_mega(Args a_) {
    ArgP ap0 = (ArgP)__builtin_amdgcn_kernarg_segment_ptr();
    extern __shared__ __attribute__((aligned(16))) unsigned char lds[];
    cg::grid_group grid = cg::this_grid();
    PG8_LAS float* edge = (PG8_LAS float*)((PG8_LAS unsigned char*)lds + RING_BYTES);
    volatile LAS unsigned* bst = (volatile LAS unsigned*)((LAS unsigned char*)lds + LDS_BYTES - 16);
    const int wave_s = __builtin_amdgcn_readfirstlane(threadIdx.x >> 6);
    if (threadIdx.x < 4) bst[threadIdx.x] = 0u;
    __syncthreads();
    XcdBarrier xbar = xcd_barrier_post((unsigned*)(ap0->ws + WS_BAR), bst);
    grid.sync();
#pragma unroll 1
    for (int phc = 0; phc < 30; ++phc) {
        int ph = phc; asm volatile("" : "+s"(ph));
        int kind = 15, slab = 0;
        if (ph == 0) kind = 0;
        else if (ph <= 10) { const int q = (ph - 1) % 5; slab = (ph - 1) / 5; kind = q == 0 ? 1 : (q == 1 ? 14 : (q == 2 ? 2 : (q == 3 ? 3 : 4))); }
        else if (ph == 11) kind = 5; else if (ph == 12) kind = 6;
        else if (ph <= 26) { kind = 7 + (ph - 13) % 7; slab = (ph - 13) / 7; }
        else if (ph == 27) { kind = 5; slab = 1; } else if (ph == 28) { kind = 6; slab = 1; }
        ArgP ap = LAUNDER_ARGS(ap0);
        unsigned char* dob = (unsigned char*)ap->out; unsigned char* ws = ap->ws;
        bf16* HB = (bf16*)(dob + DO_HB); float* ssq = (float*)(ws + WS_SSQ); bf16* BIG = (bf16*)(ws + WS_BIG);
        unsigned zl = 0u; asm volatile("" : "+v"(zl));
        const int tid = wave_s * 64 + (int)__builtin_amdgcn_mbcnt_hi(~0u, __builtin_amdgcn_mbcnt_lo(~0u, zl));
        const int row0 = slab * SLAB;
        switch (kind) {
        case 0: if (PHM & 1) p0_prologue(ap, lds, tid); break;
        case 1: { pg8::EpiHgIn E{BIG, ssq + row0};
                  if (PHM & 2) run_gemm<pg8::EpiHgIn, true>(lds, HB + (size_t)row0 * 1024, (const bf16*)(dob + DO_WHG), 65, 20, 1024, 256, E, tid); } break;
        case 2: if (PHM & 4) hgrn_scan<false>(lds, BIG, BIG + SLABE, BIG + 2 * SLABE, BIG + 3 * SLABE, BIG + 5 * SLABE, BIG + 6 * SLABE, ap->in[8], (float*)(ws + WS_HW), slab, tid); break;
        case 14: if (PHM & 4) hgrn_scan<true>(lds, BIG, BIG + SLABE, BIG + 2 * SLABE, BIG + 3 * SLABE, BIG + 5 * SLABE, BIG + 6 * SLABE, ap->in[8], (float*)(ws + WS_HW), slab, tid); break;
        case 3: if (PHM & 8) hgrn_gate(BIG + 5 * SLABE, BIG + 6 * SLABE, BIG + 4 * SLABE, ap->in[9], tid); break;
        case 4: case 6: case 13: {
                  const bf16* A; const bf16* Bt; int nM, K, r0; float* sq; bf16* hout = HB;
                  if (kind == 4) { A = BIG + 4 * SLABE; Bt = (const bf16*)(dob + DO_WHGO); nM = 65; K = 1024; r0 = row0; sq = (float*)(ws + WS_PA); }
                  else if (kind == 13) { A = BIG; Bt = (const bf16*)(dob + DO_WRWO); nM = 65; K = 1024; r0 = row0; sq = (float*)(ws + WS_PA); }
                  else { A = (const bf16*)(ws + WS_ACT); Bt = (const bf16*)(dob + (slab ? DO_WF1O : DO_WF0O)); nM = 130; K = 2816; r0 = 0; sq = (float*)(ws + WS_PB); if (slab) hout = (bf16*)(ws + WS_HBNEW); }
                  pg8::EpiRes E{HB, hout, sq, r0};
                  if (PHM & 16) run_gemm<pg8::EpiRes, true>(lds, A, Bt, nM, 4, K, 256, E, tid); } break;
        case 5: { pg8::EpiFfnIn E{(bf16*)(ws + WS_ACT), (const float*)(ws + WS_PA), ap->in[29] + slab * 3 * FFN, ap->in[30] + slab * FFN, edge};
                  if (PHM & 32) run_gemm<pg8::EpiFfnIn, true>(lds, HB, (const bf16*)(dob + (slab ? DO_WF1I : DO_WF0I)), 131, 22, 1024, 254, E, tid); } break;
        case 7: if (PHM & 64) rwkv_mix(HB, (const float*)(ws + WS_PB), ap->in[3] + 1024, ap->in[10], BIG, BIG + 2 * SLABE, row0, tid); break;
        case 8: {
                  int c = (int)blockIdx.x, gd = (int)gridDim.x; asm volatile("" : "+s"(c), "+s"(gd));
                  { pg8::BalOrder S{65, 2, 130, gd, c, 0};
                    pg8::EpiLora E{(bf16*)(ws + WS_HW), (bf16*)(ws + WS_HA), (bf16*)(ws + WS_HG)};
                    if (PHM & 128) run_gemm_list<pg8::EpiLora>(lds, BIG, (const bf16*)(dob + DO_WLORA), 2048, 2048, 0u, 0u, S, E, tid); }
                  { pg8::BalOrder S{65, 12, 780, gd, c, 1};
                    pg8::EpiRkv E{BIG + 4 * SLABE};
                    if (PHM & 128) run_gemm_list<pg8::EpiRkv>(lds, BIG, (const bf16*)(dob + DO_WRW1), 1024, 2048, (unsigned)(2 * SLABE * 2), (unsigned)(2 * SLABE * 2 + 2048), S, E, tid); } } break;
        case 9: if (PHM & 256) rwkv_scan_chunk<true>(lds, BIG + 4 * SLABE, BIG + 5 * SLABE, BIG + 6 * SLABE, (const bf16*)(ws + WS_HW), (const bf16*)(ws + WS_HA), BIG + 2 * SLABE, BIG + 3 * SLABE, (float*)(ws + WS_BETA), (float*)BIG, (bf16*)((unsigned char*)BIG + 8388608), ap, slab, tid); break;
        case 10: if (PHM & 256) rwkv_scan_chunk<false>(lds, BIG + 4 * SLABE, BIG + 5 * SLABE, BIG + 6 * SLABE, (const bf16*)(ws + WS_HW), (const bf16*)(ws + WS_HA), BIG + 2 * SLABE, BIG + 3 * SLABE, (float*)(ws + WS_BETA), (float*)BIG, (bf16*)((unsigned char*)BIG + 8388608), ap, slab, tid); break;
        case 11: if (PHM & 512) rwkv_gn(BIG + 2 * SLABE, BIG + 3 * SLABE, BIG + 6 * SLABE, (const float*)(ws + WS_BETA), ap->in[26], ap->in[27], tid); break;
        case 12: { pg8::EpiGate E{BIG + 2 * SLABE, BIG};
                  if (PHM & 1024) run_gemm<pg8::EpiGate, true>(lds, (const bf16*)(ws + WS_HG), (const bf16*)(dob + DO_WG2), 65, 4, 256, 256, E, tid); } break;
        default: if (PHM & 2048) final_norm((const bf16*)(ws + WS_HBNEW), (const float*)(ws + WS_PB), ap->in[5], ap->out, tid); break;
        }
        if (phc < 29) { unsigned z2 = 0u; asm volatile("" : "+v"(z2)); const int t2 = wave_s * 64 + (int)__builtin_amdgcn_mbcnt_hi(~0u, __builtin_amdgcn_mbcnt_lo(~0u, z2)); xcd_barrier(xbar, t2); }
    }
}

extern "C" void kernel_launch(void* const* d_in, const int* in_sizes, int n_in, void* d_out, int out_size, void* d_ws, size_t ws_size, hipStream_t stream) {
    static int grid = 0;
    if (grid == 0) {
        if (n_in != 32 || ws_size < WS_NEED || out_size != 32768 * 1024) { fprintf(stderr, "kernel_launch: unexpected shapes (n_in %d, ws %zu, out %d)\n", n_in, ws_size, out_size); grid = -1; return; }
        int dev = 0, cus = 0, per_cu = 0;
        hipGetDevice(&dev); hipDeviceGetAttribute(&cus, hipDeviceAttributeMultiprocessorCount, dev);
        if (hipFuncSetAttribute((const void*)fwd_mega, hipFuncAttributeMaxDynamicSharedMemorySize, LDS_BYTES) != hipSuccess) { fprintf(stderr, "kernel_launch: hipFuncSetAttribute failed\n"); grid = -1; return; }
        if (hipOccupancyMaxActiveBlocksPerMultiprocessor(&per_cu, (const void*)fwd_mega, 512, LDS_BYTES) != hipSuccess || per_cu < 1) { fprintf(stderr, "kernel_launch: occupancy query says %d\n", per_cu); per_cu = 1; }
        (void)hipGetLastError();
        grid = cus;
    }
    if (grid < 0) return;
    if (hipMemsetAsync((char*)d_ws + WS_BAR, 0, 16384, stream) != hipSuccess) { fprintf(stderr, "kernel_launch: memset failed\n"); return; }
    Args a{};
    for (int i = 0; i < 32; ++i) a.in[i] = (const float*)d_in[i];
    a.out = (float*)d_out; a.ws = (unsigned char*)d_ws;
    void* args[] = {&a};
    hipError_t e = hipLaunchCooperativeKernel((const void*)fwd_mega, dim3(grid), dim3(512), args, LDS_BYTES, stream);
    if (e != hipSuccess) fprintf(stderr, "kernel_launch: cooperative launch failed: %s (grid %d)\n", hipGetErrorString(e), grid);
}
```

```cpp
#include <hip/hip_runtime.h>
#include <hip/hip_cooperative_groups.h>
#include <cstdio>
#include <cstdint>
namespace cg = cooperative_groups;

constexpr int D_ = 1024, FFN = 2816, TROWS = 33280, SLAB = 16640;
constexpr size_t SLABE = (size_t)SLAB * 1024;
constexpr float NEPS = 1e-6f;
__host__ __device__ __forceinline__ bool row_is_pad(int r) {
    int o;
    if (r < 8256) o = r; else if (r < 16512) o = r - 8256; else if (r < 16640) return true; else if (r < 33088) o = r - 16640; else return true;
    return o < 48;
}
__device__ __forceinline__ float bf2f(unsigned short v) { return __uint_as_float(((unsigned)v) << 16); }
typedef float f32x2_cv __attribute__((ext_vector_type(2)));
typedef __bf16 bf16x2_cv __attribute__((ext_vector_type(2)));
__device__ __forceinline__ unsigned pk2(float lo, float hi) { const f32x2_cv v = {lo, hi}; const bf16x2_cv b = __builtin_convertvector(v, bf16x2_cv); return __builtin_bit_cast(unsigned, b); }
__device__ __forceinline__ unsigned f2bf(float f) { return pk2(f, 0.f) & 0xffffu; }
__device__ __forceinline__ float sigmoidf_(float x) { return __builtin_amdgcn_rcpf(1.0f + __expf(-x)); }
namespace pg8 {
#define PG8_LAS __attribute__((address_space(3)))
typedef unsigned short bf16_t;
typedef short bf16x8 __attribute__((ext_vector_type(8)));
typedef float f32x4 __attribute__((ext_vector_type(4)));
typedef unsigned u32x4 __attribute__((ext_vector_type(4)));
constexpr int BM = 256, BK = 64, HALF = 128, HTB = HALF * BK * 2  , STAGE_BYTES = 8 * HTB, NXCD = 8, WGM = 8;

__host__ __device__ __forceinline__ int lds_byte(int r, int c) { const int st = (r >> 4) * 2 + (c >> 5), rr = r & 15, cc = c & 31, ob = rr * 64 + cc * 2; return st * 1024 + (ob ^ (((ob >> 9) & 1) << 5)); }
__host__ __device__ __forceinline__ void stage_rc(int b, int& R, int& C) { const int st = b / 1024, sb = b % 1024, swz = sb ^ (((sb >> 9) & 1) << 5); R = (st >> 1) * 16 + swz / 64; C = (st & 1) * 32 + (swz % 64) / 2; }
__host__ __device__ __forceinline__ int perm32(int rho) { const int n = rho >> 4, i = rho & 15; return 8 * (i >> 2) + 4 * n + (i & 3); }

struct Unit { int pm, pn; };
struct Gemm { const bf16_t* A; const bf16_t* Bt; int M, N, K, a_tile_rows, lda; unsigned a_off1, a_off2; };
__device__ __forceinline__ size_t a_unit_off(const Gemm& g, int pn) { return pn >= 8 ? (size_t)g.a_off2 : (pn >= 4 ? (size_t)g.a_off1 : (size_t)0); }

struct StaticOrder {
    int nM, nN, nwg, G, c;
    __host__ __device__ void init(int M, int N, int G_, int c_) { nM = M / BM; nN = N / BM; nwg = nM * nN; G = G_; c = c_; }
    __host__ __device__ bool next(int i, Unit& u) const {
        const long L = (long)i * G + c; if (L >= nwg) return false;
        int wgid = (int)L; { const int q = nwg / NXCD, r = nwg % NXCD, xcd = wgid % NXCD, off = wgid / NXCD; wgid = (xcd < r ? xcd * (q + 1) : r * (q + 1) + (xcd - r) * q) + off; }
        const int nig = WGM * nN, gid = wgid / nig, fm = gid * WGM, gsz = (nM - fm) < WGM ? (nM - fm) : WGM;
        u.pm = fm + ((wgid % nig) % gsz); u.pn = (wgid % nig) / gsz; return true;
    }
    __device__ __forceinline__ void a_ready(const Unit&) const {}
    __device__ __forceinline__ void done(const Unit&) const {}
};

struct BalOrder {
    int nM, nN, nwg, G, c, mode;
    __device__ bool next(int i, Unit& u) const {
        long L;
        if (G != 256) { L = (long)i * G + c; }
        else if (mode == 0) { if (i > 0 || c >= 130) return false; L = c; }
        else { if (i < 2) L = 256 * i + c; else { if (c < 130) return false; const int h = c - 130; if (i == 2) L = 512 + h; else if (i == 3) L = 638 + h; else if (i == 4 && h < 16) L = 764 + h; else return false; } }
        if (L >= nwg) return false;
        int wgid = (int)L; { const int q = nwg / NXCD, r = nwg % NXCD, xcd = wgid % NXCD, off = wgid / NXCD; wgid = (xcd < r ? xcd * (q + 1) : r * (q + 1) + (xcd - r) * q) + off; }
        const int nig = WGM * nN, gid = wgid / nig, fm = gid * WGM, gsz = (nM - fm) < WGM ? (nM - fm) : WGM;
        u.pm = fm + ((wgid % nig) % gsz); u.pn = (wgid % nig) / gsz; return true;
    }
    __device__ __forceinline__ void a_ready(const Unit&) const {}
    __device__ __forceinline__ void done(const Unit&) const {}
};

__device__ __forceinline__ unsigned cvt_pk_bf16(float lo, float hi) { return pk2(lo, hi); }
typedef float f32x2 __attribute__((ext_vector_type(2)));
__device__ __forceinline__ f32x2 gelu_pk(f32x2 v) {
    const f32x2 av = __builtin_elementwise_abs(v), d = av * 0.2316418882f + 1.0f;
    f32x2 t; t.x = __builtin_amdgcn_rcpf(d.x); t.y = __builtin_amdgcn_rcpf(d.y);
    f32x2 q = t * 0.5307027145f + (-0.7265760135f); q = q * t + 0.7107068705f; q = q * t + (-0.142248368f); q = q * t + 0.127414796f; q = q * t;
    const f32x2 s = (v * v) * (-0.72134752044f);
    f32x2 e; e.x = __builtin_amdgcn_exp2f(s.x); e.y = __builtin_amdgcn_exp2f(s.y);
    const f32x2 m = v * (q * e), r = v - m;
    f32x2 o; o.x = v.x < 0.f ? m.x : r.x; o.y = v.y < 0.f ? m.y : r.y; return o;
}


typedef unsigned u32x2 __attribute__((ext_vector_type(2)));
__device__ __forceinline__ u32x4 pack8(const f32x4 a, const f32x4 b) { u32x4 w; w.x = cvt_pk_bf16(a[0], a[1]); w.y = cvt_pk_bf16(a[2], a[3]); w.z = cvt_pk_bf16(b[0], b[1]); w.w = cvt_pk_bf16(b[2], b[3]); return w; }
__device__ __forceinline__ float silu_(float v) { return v * __builtin_amdgcn_rcpf(1.0f + __expf(-v)); }
__device__ __forceinline__ float gelu_tanh_(float x) { const float y = 1.5957691216f * (x + 0.044715f * x * x * x); return x * __builtin_amdgcn_rcpf(1.0f + __expf(-y)); }

__device__ __forceinline__ float row_ssq16(const float* part, int row) { const f32x4* p = (const f32x4*)(part + (size_t)row * 16); const f32x4 a = p[0], b = p[1], c = p[2], d = p[3];
    return (((a[0] + a[1]) + (a[2] + a[3])) + ((b[0] + b[1]) + (b[2] + b[3]))) + (((c[0] + c[1]) + (c[2] + c[3])) + ((d[0] + d[1]) + (d[2] + d[3]))); }

struct EpiHgIn {
    static constexpr bool PERM = true, AFTER_DRAIN = false;
    bf16_t* base; const float* ssq;
    __device__ __forceinline__ void operator()(const f32x4 (&acc)[2][2][4][2], const Unit& u, int wr, int wc, int fr, int fq) const {
        const int which = u.pn >> 2; const int colt = (u.pn & 3) * 256 + wc * 32 + 8 * fq;
        bf16_t* dst = base + (size_t)which * SLABE; const bool act = (which == 0) || (which == 4);
#pragma unroll
        for (int ai = 0; ai < 2; ++ai)
#pragma unroll
            for (int m = 0; m < 4; ++m) { const int row = u.pm * 256 + ai * 128 + wr * 64 + m * 16 + fr; const float rs = rsqrtf(ssq[row] * (1.0f / 1024.0f) + NEPS);
#pragma unroll
                for (int bj = 0; bj < 2; ++bj) { f32x4 v0 = acc[ai][bj][m][0] * rs, v1 = acc[ai][bj][m][1] * rs;
                    if (act) {
#pragma unroll
                        for (int e = 0; e < 4; ++e) { v0[e] = silu_(v0[e]); v1[e] = silu_(v1[e]); } }
                    *(u32x4*)(dst + (size_t)row * 1024 + colt + bj * 128) = pack8(v0, v1); } }
    }
};

struct EpiRes {
    static constexpr bool PERM = true, AFTER_DRAIN = false;
    const bf16_t* hin; bf16_t* hout; float* ssq; int row0;
    __device__ __forceinline__ void operator()(const f32x4 (&acc)[2][2][4][2], const Unit& u, int wr, int wc, int fr, int fq) const {
        const int col0 = u.pn * 256 + wc * 32 + 8 * fq;
#pragma unroll
        for (int ai = 0; ai < 2; ++ai)
#pragma unroll
            for (int m = 0; m < 4; ++m) { const int row = row0 + u.pm * 256 + ai * 128 + wr * 64 + m * 16 + fr; const bool pad = row_is_pad(row); float s = 0.f;
#pragma unroll
                for (int bj = 0; bj < 2; ++bj) { const size_t off = (size_t)row * 1024 + col0 + bj * 128; const u32x4 hv = *(const u32x4*)(hin + off);
                    f32x4 v0 = acc[ai][bj][m][0], v1 = acc[ai][bj][m][1];
                    v0[0] += __uint_as_float(hv.x << 16); v0[1] += __uint_as_float(hv.x & 0xffff0000u); v0[2] += __uint_as_float(hv.y << 16); v0[3] += __uint_as_float(hv.y & 0xffff0000u);
                    v1[0] += __uint_as_float(hv.z << 16); v1[1] += __uint_as_float(hv.z & 0xffff0000u); v1[2] += __uint_as_float(hv.w << 16); v1[3] += __uint_as_float(hv.w & 0xffff0000u);
#pragma unroll
                    for (int e = 0; e < 4; ++e) s += v0[e] * v0[e] + v1[e] * v1[e];
                    if (!pad) *(u32x4*)(hout + off) = pack8(v0, v1); }
                s += __shfl_xor(s, 16); s += __shfl_xor(s, 32);
                if (fq == 0) ssq[(size_t)row * 16 + u.pn * 4 + wc] = pad ? 0.f : s;
                if (m & 1) asm volatile("" ::: "memory"); }
    }
};

struct EpiFfnIn {
    static constexpr bool PERM = true, AFTER_DRAIN = false;
    bf16_t* act; const float* ssq; const float* cw; const float* cb; PG8_LAS float* edge;
    __device__ __forceinline__ void operator()(f32x4 (&acc)[2][2][4][2], const Unit& u, int wr, int wc, int fr, int fq) const {
        const int lane = fq * 16 + fr;
        const int rowt = u.pm * 254;
#pragma unroll
        for (int ai = 0; ai < 2; ++ai)
#pragma unroll
            for (int m = 0; m < 4; ++m) { const int row = rowt + ai * 128 + wr * 64 + m * 16 + fr; const f32x4 pv = *(const f32x4*)(ssq + (size_t)row * 16 + 4 * fq); float sq = (pv[0] + pv[1]) + (pv[2] + pv[3]); sq += __shfl_xor(sq, 16); sq += __shfl_xor(sq, 32);
                const float rs = rsqrtf(sq * (1.0f / 1024.0f) + NEPS);
#pragma unroll
                for (int bj = 0; bj < 2; ++bj)
#pragma unroll
                    for (int n = 0; n < 2; ++n) acc[ai][bj][m][n] = acc[ai][bj][m][n] * rs;
                asm volatile("" ::: "memory"); }
        const int colw = wc * 32 + 8 * fq;
        PG8_LAS float* edgeF = edge; PG8_LAS float* edgeL = edge + 512;
#pragma unroll
        for (int ai = 0; ai < 2; ++ai) { const int blk = 2 * ai + wr;
            if (fr == 0) {
#pragma unroll
                for (int n = 0; n < 2; ++n)
#pragma unroll
                    for (int e = 0; e < 4; ++e) edgeF[blk * 128 + colw + 4 * n + e] = acc[ai][0][0][n][e]; }
            if (fr == 15) {
#pragma unroll
                for (int n = 0; n < 2; ++n)
#pragma unroll
                    for (int e = 0; e < 4; ++e) edgeL[blk * 128 + colw + 4 * n + e] = acc[ai][0][3][n][e]; } }
        asm volatile("s_waitcnt lgkmcnt(0)" ::: "memory"); __builtin_amdgcn_s_barrier(); asm volatile("" ::: "memory");
        const int lprev = (lane & 48) | ((fr + 15) & 15), lnext = (lane & 48) | ((fr + 1) & 15);
        const int colg = u.pn * 128 + colw;
        const bool f0 = (fr == 0), f15 = (fr == 15);
#pragma unroll
        for (int ai = 0; ai < 2; ++ai) { const int blk = 2 * ai + wr;
#pragma unroll
            for (int n = 0; n < 2; ++n) {
                const f32x4 w0v = *(const f32x4*)(cw + colg + 4 * n), w1v = *(const f32x4*)(cw + FFN + colg + 4 * n), w2v = *(const f32x4*)(cw + 2 * FFN + colg + 4 * n), cbv = *(const f32x4*)(cb + colg + 4 * n);
                f32x4 res[4];
#pragma unroll
                for (int p = 0; p < 2; ++p) {
                    const f32x2 w0 = {w0v[2 * p], w0v[2 * p + 1]}, w1 = {w1v[2 * p], w1v[2 * p + 1]}, w2 = {w2v[2 * p], w2v[2 * p + 1]}, bb = {cbv[2 * p], cbv[2 * p + 1]};
                    f32x2 c[4], ps[4], ns[4];
#pragma unroll
                    for (int m = 0; m < 4; ++m) { c[m] = (f32x2){acc[ai][0][m][n][2 * p], acc[ai][0][m][n][2 * p + 1]};
                        ps[m] = (f32x2){__shfl(c[m].x, lprev), __shfl(c[m].y, lprev)}; ns[m] = (f32x2){__shfl(c[m].x, lnext), __shfl(c[m].y, lnext)}; }
                    f32x2 pe = {0.f, 0.f}, ne = {0.f, 0.f};
                    if (blk > 0) pe = (f32x2){edgeL[(blk - 1) * 128 + colw + 4 * n + 2 * p], edgeL[(blk - 1) * 128 + colw + 4 * n + 2 * p + 1]};
                    if (blk < 3) ne = (f32x2){edgeF[(blk + 1) * 128 + colw + 4 * n + 2 * p], edgeF[(blk + 1) * 128 + colw + 4 * n + 2 * p + 1]};
#pragma unroll
                    for (int m = 0; m < 4; ++m) {
                        const f32x2 pvm = f0 ? (m == 0 ? pe : ps[m == 0 ? 0 : m - 1]) : ps[m];
                        const f32x2 nvm = f15 ? (m == 3 ? ne : ns[m == 3 ? 3 : m + 1]) : ns[m];
                        f32x2 cu = w1 * c[m] + bb; cu = w0 * pvm + cu; cu = w2 * nvm + cu;
                        f32x2 tq = (cu * cu) * cu; tq = tq * 0.044715f + cu;
                        const f32x2 ea = tq * (-2.3022082f);
                        f32x2 dn; dn.x = __builtin_amdgcn_exp2f(ea.x); dn.y = __builtin_amdgcn_exp2f(ea.y); dn = dn + 1.0f;
                        f32x2 rc; rc.x = __builtin_amdgcn_rcpf(dn.x); rc.y = __builtin_amdgcn_rcpf(dn.y);
                        const f32x2 vv = {acc[ai][1][m][n][2 * p], acc[ai][1][m][n][2 * p + 1]};
                        const f32x2 o = (cu * rc) * vv;
                        res[m][2 * p] = o.x; res[m][2 * p + 1] = o.y; }
                }
#pragma unroll
                for (int m = 0; m < 4; ++m) { const int j = ai * 128 + wr * 64 + m * 16 + fr;
                    u32x2 w; w.x = cvt_pk_bf16(res[m][0], res[m][1]); w.y = cvt_pk_bf16(res[m][2], res[m][3]);
                    if (j >= 1 && j <= 254) *(u32x2*)(act + (size_t)(rowt + j) * FFN + colg + 4 * n) = w; }
                asm volatile("" ::: "memory");
            }
        }
        asm volatile("" ::: "memory");
    }
};

struct EpiRkv {
    static constexpr bool PERM = true, AFTER_DRAIN = false;
    bf16_t* base;
    __device__ __forceinline__ void operator()(const f32x4 (&acc)[2][2][4][2], const Unit& u, int wr, int wc, int fr, int fq) const {
        const int colw = wc * 32 + 8 * fq;
        bf16_t* dst0 = base + (size_t)(u.pn >> 2) * SLABE + (u.pn & 3) * 256 + colw;
#pragma unroll
        for (int ai = 0; ai < 2; ++ai)
#pragma unroll
            for (int m = 0; m < 4; ++m) { const int row = u.pm * 256 + ai * 128 + wr * 64 + m * 16 + fr; bf16_t* dst = dst0 + (size_t)row * 1024;
#pragma unroll
                for (int bj = 0; bj < 2; ++bj) *(u32x4*)(dst + bj * 128) = pack8(acc[ai][bj][m][0], acc[ai][bj][m][1]);
                asm volatile("" ::: "memory"); }
    }
};
struct EpiLora {
    static constexpr bool PERM = true, AFTER_DRAIN = false;
    bf16_t* hw; bf16_t* ha; bf16_t* hg;
    __device__ __forceinline__ void operator()(const f32x4 (&acc)[2][2][4][2], const Unit& u, int wr, int wc, int fr, int fq) const {
        const int colw = wc * 32 + 8 * fq;
#pragma unroll
        for (int ai = 0; ai < 2; ++ai)
#pragma unroll
            for (int m = 0; m < 4; ++m) { const int row = u.pm * 256 + ai * 128 + wr * 64 + m * 16 + fr;
                if (u.pn == 0) { f32x4 v0 = acc[ai][0][m][0], v1 = acc[ai][0][m][1];
#pragma unroll
                    for (int e = 0; e < 4; ++e) { v0[e] = 2.0f * __builtin_amdgcn_rcpf(1.0f + __expf(-2.0f * v0[e])) - 1.0f; v1[e] = 2.0f * __builtin_amdgcn_rcpf(1.0f + __expf(-2.0f * v1[e])) - 1.0f; }
                    *(u32x4*)(hw + (size_t)row * 128 + colw) = pack8(v0, v1);
                    *(u32x4*)(ha + (size_t)row * 128 + colw) = pack8(acc[ai][1][m][0], acc[ai][1][m][1]);
                } else {
#pragma unroll
                    for (int bj = 0; bj < 2; ++bj) { f32x4 v0 = acc[ai][bj][m][0], v1 = acc[ai][bj][m][1];
#pragma unroll
                        for (int e = 0; e < 4; ++e) { v0[e] = __builtin_amdgcn_rcpf(1.0f + __expf(-v0[e])); v1[e] = __builtin_amdgcn_rcpf(1.0f + __expf(-v1[e])); }
                        *(u32x4*)(hg + (size_t)row * 256 + bj * 128 + colw) = pack8(v0, v1); } }
                asm volatile("" ::: "memory"); }
    }
};

struct EpiGate {
    static constexpr bool PERM = true, AFTER_DRAIN = false;
    const bf16_t* yb; bf16_t* outb;
    __device__ __forceinline__ void operator()(const f32x4 (&acc)[2][2][4][2], const Unit& u, int wr, int wc, int fr, int fq) const {
        const int col0 = u.pn * 256 + wc * 32 + 8 * fq;
#pragma unroll
        for (int ai = 0; ai < 2; ++ai)
#pragma unroll
            for (int m = 0; m < 4; ++m) { const int row = u.pm * 256 + ai * 128 + wr * 64 + m * 16 + fr;
#pragma unroll
                for (int bj = 0; bj < 2; ++bj) { const size_t off = (size_t)row * 1024 + col0 + bj * 128; const u32x4 hv = *(const u32x4*)(yb + off);
                    f32x4 v0 = acc[ai][bj][m][0], v1 = acc[ai][bj][m][1];
                    v0[0] *= __uint_as_float(hv.x << 16); v0[1] *= __uint_as_float(hv.x & 0xffff0000u); v0[2] *= __uint_as_float(hv.y << 16); v0[3] *= __uint_as_float(hv.y & 0xffff0000u);
                    v1[0] *= __uint_as_float(hv.z << 16); v1[1] *= __uint_as_float(hv.z & 0xffff0000u); v1[2] *= __uint_as_float(hv.w << 16); v1[3] *= __uint_as_float(hv.w & 0xffff0000u);
                    *(u32x4*)(outb + off) = pack8(v0, v1); }
                asm volatile("" ::: "memory"); }
    }
};
template <class Epi, class Sched, bool ALIGN_EPI = false, bool SP2 = false>
__device__ __forceinline__ void gemm_phase(PG8_LAS unsigned char* lds, const Gemm g, const Sched& S, const Epi& E, int tid_in) {
    int tid_l = tid_in;
    const int tid = tid_l, wid = __builtin_amdgcn_readfirstlane(tid >> 6), lane = tid & 63, wr = wid >> 2, wc = wid & 3, fr = lane & 15, fq = lane >> 4;
    const int K = g.K, nt = K / BK;
    unsigned voffA[2], voffB[2];
#pragma unroll
    for (int i = 0; i < 2; ++i) { int R, C; stage_rc(tid * 16 + i * 8192, R, C); const int Rb = Epi::PERM ? ((R & ~31) + perm32(R & 31)) : R;
        voffA[i] = (unsigned)(R * g.lda + C) * 2u; voffB[i] = (unsigned)(Rb * K + C) * 2u; }
    const size_t kstep = (size_t)(BK * 2);
    const size_t hstep = (size_t)HALF * K * 2;
    const size_t hstepA = (size_t)HALF * g.lda * 2;
    const size_t tstepA = (size_t)g.a_tile_rows * g.lda * 2, tstepB = 2 * hstep;
    const unsigned ldsw = (unsigned)wid * 1024u;
    const int aoff = lds_byte(wr * 64 + fr, fq * 8), boff = lds_byte(wc * 32 + fr, fq * 8);
#define PG8_SA(b, h) (((b) * 2 + (h)) * HTB)
#define PG8_SB(b, h) ((4 + (b) * 2 + (h)) * HTB)
#define PG8_STAGE(bufoff, gbase, voff) do { _Pragma("unroll") for (int _i = 0; _i < 2; ++_i) \
        __builtin_amdgcn_global_load_lds((const unsigned*)((const char*)(gbase) + (voff)[_i]), (PG8_LAS unsigned*)(lds + (bufoff) + ldsw + _i * 8192), 16, 0, 0); } while (0)
#define PG8_LDA(dst, b, h) do { _Pragma("unroll") for (int m = 0; m < 4; ++m) _Pragma("unroll") for (int k = 0; k < 2; ++k) dst[m][k] = *(const PG8_LAS bf16x8*)(lds + PG8_SA(b, h) + aoff + m * 2048 + k * 1024); } while (0)
#define PG8_LDB(dst, b, h) do { _Pragma("unroll") for (int n = 0; n < 2; ++n) _Pragma("unroll") for (int k = 0; k < 2; ++k) dst[n][k] = *(const PG8_LAS bf16x8*)(lds + PG8_SB(b, h) + boff + n * 2048 + k * 1024); } while (0)
#define PG8_MMA(ai, bj, At, Bt) do { __builtin_amdgcn_s_setprio(1); _Pragma("unroll") for (int m = 0; m < 4; ++m) _Pragma("unroll") for (int n = 0; n < 2; ++n) _Pragma("unroll") for (int k = 0; k < 2; ++k) \
        acc[ai][bj][m][n] = __builtin_amdgcn_mfma_f32_16x16x32_bf16(Bt[n][k], At[m][k], acc[ai][bj][m][n], 0, 0, 0); __builtin_amdgcn_s_setprio(0); } while (0)
#define PG8_WAIT_V(n) asm volatile("s_waitcnt vmcnt(" #n ")" ::: "memory")
#define PG8_WAIT_L(n) asm volatile("s_waitcnt lgkmcnt(" #n ")" ::: "memory")
#define PG8_BAR __builtin_amdgcn_s_barrier()
#define PG8_SCHED __builtin_amdgcn_sched_barrier(0)
    Unit cur, nxt; int ui = 0;
    if (!S.next(0, cur)) return;
    f32x4 acc[2][2][4][2];
#pragma unroll
    for (int a = 0; a < 2; ++a)
#pragma unroll
        for (int b = 0; b < 2; ++b)
#pragma unroll
            for (int m = 0; m < 4; ++m)
#pragma unroll
                for (int n = 0; n < 2; ++n) acc[a][b][m][n] = (f32x4){0.f, 0.f, 0.f, 0.f};
    bf16x8 At[4][2], B0[2][2], B1[2][2];
    const char* cA = (const char*)g.A + (size_t)cur.pm * tstepA + a_unit_off(g, cur.pn); const char* cB = (const char*)g.Bt + (size_t)cur.pn * tstepB;
    S.a_ready(cur);
    if constexpr (SP2) {
        PG8_STAGE(PG8_SB(0, 0), cB, voffB); PG8_STAGE(PG8_SB(0, 1), cB + hstep, voffB); PG8_STAGE(PG8_SA(0, 0), cA, voffA); PG8_STAGE(PG8_SA(0, 1), cA + hstepA, voffA);
        if (wr == 1) PG8_BAR;
        PG8_WAIT_V(2); PG8_BAR;
        PG8_STAGE(PG8_SB(1, 0), cB + kstep, voffB); PG8_STAGE(PG8_SA(1, 0), cA + kstep, voffA); PG8_STAGE(PG8_SB(1, 1), cB + hstep + kstep, voffB);
        PG8_WAIT_V(6); PG8_BAR;
    } else {
        PG8_STAGE(PG8_SB(0, 0), cB, voffB); PG8_STAGE(PG8_SA(0, 0), cA, voffA); PG8_STAGE(PG8_SB(0, 1), cB + hstep, voffB); PG8_STAGE(PG8_SA(0, 1), cA + hstepA, voffA);
        if (wr == 1) PG8_BAR;
        PG8_WAIT_V(4); PG8_BAR;
        PG8_STAGE(PG8_SB(1, 0), cB + kstep, voffB); PG8_STAGE(PG8_SA(1, 0), cA + kstep, voffA); PG8_STAGE(PG8_SB(1, 1), cB + hstep + kstep, voffB);
        PG8_WAIT_V(6); PG8_BAR;
    }
    for (;;) {
        const bool has_next = S.next(ui + 1, nxt);
        const char* nA = has_next ? (const char*)g.A + (size_t)nxt.pm * tstepA + a_unit_off(g, nxt.pn) : cA; const char* nB = has_next ? (const char*)g.Bt + (size_t)nxt.pn * tstepB : cB;
#pragma unroll 1
        for (int t = 0; t < nt; t += 2) {
            const bool last = (t == nt - 2);
            const char* a1 = cA + (size_t)(t + 1) * kstep;
            const char* a2 = last ? nA : cA + (size_t)(t + 2) * kstep; const char* b2 = last ? nB : cB + (size_t)(t + 2) * kstep;
            const char* a3 = a2 + kstep; const char* b3 = b2 + kstep;
            if (last && has_next) S.a_ready(nxt);
            if constexpr (SP2) {
            PG8_LDB(B0, 0, 0); PG8_LDB(B1, 0, 1); PG8_SCHED; PG8_LDA(At, 0, 0); PG8_STAGE(PG8_SA(1, 1), a1 + hstepA, voffA);
            PG8_WAIT_V(8); PG8_WAIT_L(0); PG8_BAR; PG8_MMA(0, 0, At, B0); PG8_MMA(0, 1, At, B1); PG8_BAR; PG8_SCHED;
            PG8_LDA(At, 0, 1); PG8_STAGE(PG8_SB(0, 0), b2, voffB); PG8_STAGE(PG8_SB(0, 1), b2 + hstep, voffB); PG8_STAGE(PG8_SA(0, 0), a2, voffA);
            PG8_WAIT_V(8); PG8_WAIT_L(0); PG8_BAR; PG8_MMA(1, 0, At, B0); PG8_MMA(1, 1, At, B1); PG8_BAR; PG8_SCHED;
            PG8_LDB(B0, 1, 0); PG8_LDB(B1, 1, 1); PG8_SCHED; PG8_LDA(At, 1, 0); PG8_STAGE(PG8_SA(0, 1), a2 + hstepA, voffA);
            PG8_WAIT_V(8); PG8_WAIT_L(0); PG8_BAR; PG8_MMA(0, 0, At, B0); PG8_MMA(0, 1, At, B1); PG8_BAR; PG8_SCHED;
            PG8_LDA(At, 1, 1); PG8_STAGE(PG8_SB(1, 0), b3, voffB); PG8_STAGE(PG8_SB(1, 1), b3 + hstep, voffB); PG8_STAGE(PG8_SA(1, 0), a3, voffA);
            PG8_WAIT_V(8); PG8_WAIT_L(0); PG8_BAR; PG8_MMA(1, 0, At, B0); PG8_MMA(1, 1, At, B1); PG8_BAR; PG8_SCHED;
            } else {
            PG8_LDB(B0, 0, 0); PG8_SCHED; PG8_LDA(At, 0, 0); PG8_STAGE(PG8_SA(1, 1), a1 + hstepA, voffA);
            PG8_WAIT_L(8); PG8_BAR; PG8_WAIT_L(0); PG8_MMA(0, 0, At, B0); PG8_BAR; PG8_SCHED;
            PG8_LDB(B1, 0, 1); PG8_STAGE(PG8_SB(0, 0), b2, voffB);
            PG8_BAR; PG8_WAIT_L(0); PG8_MMA(0, 1, At, B1); PG8_BAR;
            PG8_LDA(At, 0, 1); PG8_STAGE(PG8_SA(0, 0), a2, voffA);
            PG8_BAR; PG8_WAIT_L(0); PG8_MMA(1, 0, At, B0); PG8_BAR; PG8_SCHED;
            PG8_STAGE(PG8_SB(0, 1), b2 + hstep, voffB);
            PG8_WAIT_V(6); PG8_BAR; PG8_MMA(1, 1, At, B1); PG8_BAR;
            PG8_LDB(B0, 1, 0); PG8_SCHED; PG8_LDA(At, 1, 0); PG8_STAGE(PG8_SA(0, 1), a2 + hstepA, voffA);
            PG8_WAIT_L(8); PG8_BAR; PG8_WAIT_L(0); PG8_MMA(0, 0, At, B0); PG8_BAR; PG8_SCHED;
            PG8_LDB(B1, 1, 1); PG8_STAGE(PG8_SB(1, 0), b3, voffB);
            PG8_BAR; PG8_WAIT_L(0); PG8_MMA(0, 1, At, B1); PG8_BAR;
            PG8_LDA(At, 1, 1); PG8_STAGE(PG8_SA(1, 0), a3, voffA);
            PG8_BAR; PG8_WAIT_L(0); PG8_MMA(1, 0, At, B0); PG8_BAR; PG8_SCHED;
            PG8_STAGE(PG8_SB(1, 1), b3 + hstep, voffB);
            PG8_WAIT_V(6); PG8_BAR; PG8_MMA(1, 1, At, B1); PG8_BAR;
            }
        }
        if constexpr (ALIGN_EPI) { if (wr == 0) PG8_BAR; }
        if constexpr (!Epi::AFTER_DRAIN) { E(acc, cur, wr, wc, fr, fq); S.done(cur); }
        if (!has_next) break;
#pragma unroll
        for (int a = 0; a < 2; ++a)
#pragma unroll
            for (int b = 0; b < 2; ++b)
#pragma unroll
                for (int m = 0; m < 4; ++m)
#pragma unroll
                    for (int n = 0; n < 2; ++n) acc[a][b][m][n] = (f32x4){0.f, 0.f, 0.f, 0.f};
        cur = nxt; cA = nA; cB = nB; ++ui;
        if constexpr (ALIGN_EPI) { if (wr == 1) PG8_BAR; }
    }
    PG8_WAIT_V(0);
    if constexpr (!ALIGN_EPI) { if (wr == 0) PG8_BAR; }
    PG8_BAR;
    if constexpr (Epi::AFTER_DRAIN) { E.fused(acc, cur, wr, wc, fr, fq, lds, wid, lane); S.done(cur); }
#undef PG8_SA
#undef PG8_SB
#undef PG8_STAGE
#undef PG8_LDA
#undef PG8_LDB
#undef PG8_MMA
#undef PG8_WAIT_V
#undef PG8_WAIT_L
#undef PG8_BAR
#undef PG8_SCHED
}
}

#define LAS __attribute__((address_space(3)))
typedef unsigned short bf16;
typedef short bf16x8_t __attribute__((ext_vector_type(8)));
typedef float f32x4_t __attribute__((ext_vector_type(4)));
typedef unsigned u32x4_t __attribute__((ext_vector_type(4)));
typedef unsigned u32x2_t __attribute__((ext_vector_type(2)));
constexpr int LDS_BYTES = 147456, RING_BYTES = 131072;

constexpr size_t DO_WLORA = 98041856 + 6291456, DO_HB = 0, DO_WHG = 68157440, DO_WHGO = 78643200, DO_WF0I = 80740352, DO_WF0O = 92274688, DO_WRW1 = 98041856, DO_WRWO = 113770496,
                 DO_WG2 = 115867648, DO_WF1I = 116391936, DO_WF1O = 127926272, DO_END = 133693440;
constexpr size_t WS_BAR = 720896, WS_SSQ = 0, WS_BETA = 1048576, WS_PA = 3211264, WS_PB = 5373952, WS_HW = 7536640, WS_HA = 11796480, WS_HG = 16056320, WS_BIG = 25165824, WS_SLOTB = 34078720,
                 WS_NEED = 268435456, WS_ACT = WS_NEED - (size_t)TROWS * FFN * 2, WS_HBNEW = 8388608;
static_assert(WS_BETA + 2 * (size_t)SLAB * 64 <= WS_PA && WS_PA + (size_t)TROWS * 64 <= WS_PB && WS_PB + (size_t)TROWS * 64 <= WS_HW && WS_HW + (size_t)SLAB * 256 <= WS_HA && WS_HA + (size_t)SLAB * 256 <= WS_HG && WS_HG + (size_t)SLAB * 512 <= WS_BIG, "small map");
static_assert(8388608 + (size_t)64 * 129 * 4608 <= 2 * WS_SLOTB && 8388608 + (size_t)32 * 257 * 4608 <= 2 * WS_SLOTB && WS_HW + (size_t)256 * 16512 * 4 <= WS_BIG && WS_BIG + 7 * WS_SLOTB <= WS_NEED && WS_HBNEW + (size_t)TROWS * 2048 <= WS_ACT && DO_END <= 134217728, "maps");

struct Args { const float* in[32]; float* out; unsigned char* ws; };
typedef const __attribute__((address_space(4))) Args* ArgP;
#define LAUNDER_ARGS(ap0) ({ ArgP _p = (ap0); asm volatile("" : "+s"(_p)); _p; })

__device__ __forceinline__ float wave_sum(float v) {
#pragma unroll
    for (int o = 1; o < 64; o <<= 1) v += __shfl_xor(v, o);
    return v;
}

__device__ __forceinline__ void tr_item(const float* W, int N, int Klim, int k0, int n0, bf16* WT, int ldk, int drow, int dcol, const float* sc, float* scr, int lane, const float* sc2 = nullptr, bool nts = true) {
    if (k0 + 64 <= Klim) {
#pragma unroll 8
        for (int i = 0; i < 32; ++i) { const int kk = 2 * i + (lane >> 5); scr[kk * 33 + (lane & 31)] = __builtin_nontemporal_load(W + (size_t)(k0 + kk) * N + n0 + (lane & 31)); }
    } else {
#pragma unroll 8
        for (int i = 0; i < 32; ++i) { const int kk = 2 * i + (lane >> 5); const int k = k0 + kk; float v = 0.f; if (k < Klim) v = W[(size_t)k * N + n0 + (lane & 31)]; scr[kk * 33 + (lane & 31)] = v; }
    }
    asm volatile("s_waitcnt lgkmcnt(0)" ::: "memory");
    const int c = lane & 7;
    f32x4_t sa = (f32x4_t){1.f, 1.f, 1.f, 1.f}, sb = sa;
    if (sc) { sa = *(const f32x4_t*)(sc + k0 + 8 * c); sb = *(const f32x4_t*)(sc + k0 + 8 * c + 4);
        if (sc2) { sa = sa - *(const f32x4_t*)(sc2 + k0 + 8 * c); sb = sb - *(const f32x4_t*)(sc2 + k0 + 8 * c + 4); } }
#pragma unroll
    for (int j = 0; j < 4; ++j) { const int n = (lane >> 3) + 8 * j; const float* s = scr + (8 * c) * 33 + n;
        u32x4_t o; o.x = pk2(s[0 * 33] * sa[0], s[1 * 33] * sa[1]); o.y = pk2(s[2 * 33] * sa[2], s[3 * 33] * sa[3]); o.z = pk2(s[4 * 33] * sb[0], s[5 * 33] * sb[1]); o.w = pk2(s[6 * 33] * sb[2], s[7 * 33] * sb[3]);
        if (nts) __builtin_nontemporal_store(o, (u32x4_t*)(WT + (size_t)(drow + n) * ldk + dcol + k0 + 8 * c)); else *(u32x4_t*)(WT + (size_t)(drow + n) * ldk + dcol + k0 + 8 * c) = o; }
    asm volatile("s_waitcnt lgkmcnt(0)" ::: "memory");
}

__device__ __forceinline__ void p0_prologue(ArgP ap, unsigned char* lds, int tid) {
    const int lane = tid & 63, wave = tid >> 6;
    float* scr = (float*)(lds + wave * 16384);
    int gdim = gridDim.x; asm volatile("" : "+s"(gdim));
    const int gw = blockIdx.x * 8 + wave, NGW = gdim * 8;
    unsigned char* dob = (unsigned char*)ap->out;
    bf16* WHG = (bf16*)(dob + DO_WHG); bf16* WHGO = (bf16*)(dob + DO_WHGO); bf16* WF0I = (bf16*)(dob + DO_WF0I); bf16* WF0O = (bf16*)(dob + DO_WF0O);
    bf16* WRW1 = (bf16*)(dob + DO_WRW1); bf16* WLORA = (bf16*)(dob + DO_WLORA); bf16* WRWO = (bf16*)(dob + DO_WRWO); bf16* WG2 = (bf16*)(dob + DO_WG2); bf16* WF1I = (bf16*)(dob + DO_WF1I); bf16* WF1O = (bf16*)(dob + DO_WF1O);
    const float* mu = ap->in[10];
    constexpr int I_HG = 16 * 160, I_SQ = 16 * 32, I_FI = 16 * 176, I_FO = 44 * 32, I_L64 = 16 * 2, I_G1 = 16 * 5, I_G2 = 4 * 32;
    constexpr int NITEMS = I_HG + I_SQ + 2 * I_FI + 2 * I_FO + 3 * I_SQ + 4 * I_L64 + 4 * I_L64 + 2 * I_G1 + I_SQ + I_G2;
    for (int it = gw; it < NITEMS; it += NGW) {
        int r = it;
        if (r < I_HG) { const int kb = r / 160, nb = r % 160; tr_item(ap->in[6], 5120, 1024, 64 * kb, 32 * nb, WHG, 1024, 32 * nb, 0, ap->in[3], scr, lane, nullptr, false); continue; } r -= I_HG;
        if (r < I_SQ) { const int kb = r / 32, nb = r % 32; tr_item(ap->in[7], 1024, 1024, 64 * kb, 32 * nb, WHGO, 1024, 32 * nb, 0, nullptr, scr, lane); continue; } r -= I_SQ;
        if (r < 2 * I_FI) { const int l = r / I_FI; r -= l * I_FI; const int kb = r / 176, nb = r % 176; const int n0 = 32 * nb; const int half = n0 / FFN, c = n0 % FFN;
            const int drow = 256 * (c / 128) + 128 * half + (c % 128);
            tr_item(ap->in[28] + (size_t)l * 1024 * 5632, 5632, 1024, 64 * kb, n0, l ? WF1I : WF0I, 1024, drow, 0, ap->in[4] + l * 1024, scr, lane); continue; } r -= 2 * I_FI;
        if (r < 2 * I_FO) { const int l = r / I_FO; r -= l * I_FO; const int kb = r / 32, nb = r % 32;
            tr_item(ap->in[31] + (size_t)l * 2816 * 1024, 1024, 2816, 64 * kb, 32 * nb, l ? WF1O : WF0O, 2816, 32 * nb, 0, nullptr, scr, lane); continue; } r -= 2 * I_FO;
        if (r < 3 * I_SQ) { const int m3 = r / I_SQ; r -= m3 * I_SQ; const int kb = r / 32, nb = r % 32;
            tr_item(ap->in[11 + m3], 1024, 1024, 64 * kb, 32 * nb, WRW1, 1024, m3 * 1024 + 32 * nb, 0, nullptr, scr, lane); continue; } r -= 3 * I_SQ;
        if (r < 4 * I_L64) { const int d = r / (2 * I_L64); r -= d * 2 * I_L64; const int half = r / I_L64; r -= half * I_L64; const int kb = r / 2, nb = r % 2;
            tr_item(ap->in[16] + (size_t)d * 1024 * 64, 64, 1024, 64 * kb, 32 * nb, WLORA, 2048, d * 64 + 32 * nb, half * 1024, half ? mu + 1 * 1024 : nullptr, scr, lane, mu); continue; } r -= 4 * I_L64;
        if (r < 4 * I_L64) { const int d = r / (2 * I_L64); r -= d * 2 * I_L64; const int half = r / I_L64; r -= half * I_L64; const int kb = r / 2, nb = r % 2;
            tr_item(ap->in[19] + (size_t)d * 1024 * 64, 64, 1024, 64 * kb, 32 * nb, WLORA, 2048, 128 + d * 64 + 32 * nb, half * 1024, half ? mu + 4 * 1024 : nullptr, scr, lane, mu); continue; } r -= 4 * I_L64;
        if (r < 2 * I_G1) { const int half = r / I_G1; r -= half * I_G1; const int kb = r / 5, nb = r % 5;
            tr_item(ap->in[21], 160, 1024, 64 * kb, 32 * nb, WLORA, 2048, 256 + 32 * nb, half * 1024, half ? mu + 5 * 1024 : nullptr, scr, lane, mu); continue; } r -= 2 * I_G1;
        if (r < I_SQ) { const int kb = r / 32, nb = r % 32; tr_item(ap->in[14], 1024, 1024, 64 * kb, 32 * nb, WRWO, 1024, 32 * nb, 0, nullptr, scr, lane); continue; } r -= I_SQ;
        { const int kb = r / 32, nb = r % 32; tr_item(ap->in[22], 1024, 160, 64 * kb, 32 * nb, WG2, 256, 32 * nb, 0, nullptr, scr, lane); }
    }
    {
        const int gt = blockIdx.x * 512 + tid, NGT = gdim * 512;
        for (int i = gt; i < 96 * 256; i += NGT) { const int rr = i >> 8, cc = i & 255;
            unsigned zz = 0u; asm volatile("" : "+v"(zz)); *(u32x4_t*)(WLORA + (size_t)(416 + rr) * 2048 + cc * 8) = (u32x4_t){zz, zz, zz, zz}; }
    }
    bf16* HB = (bf16*)(dob + DO_HB); float* ssq0 = (float*)(ap->ws + WS_SSQ);
    for (int r = gw; r < TROWS; r += NGW) {
        int o, tokbase; bool pad = false;
        if (r < 8256) { o = r; tokbase = 16384; } else if (r < 16512) { o = r - 8256; tokbase = 24576; } else if (r < 16640) { pad = true; o = 0; tokbase = 0; }
        else if (r < 33088) { o = r - 16640; tokbase = 0; } else { pad = true; o = 0; tokbase = 0; }
        if (o < 48) pad = true;
        const float* src = nullptr;
        if (!pad) { if (o < 64) src = ap->in[2] + (size_t)(o - 48) * 1024; else { const int g = tokbase + o - 64; src = (g < 16384) ? ap->in[0] + (size_t)g * 1024 : ap->in[1] + (size_t)(g - 16384) * 1024; } }
        float s = 0.f;
#pragma unroll
        for (int j = 0; j < 4; ++j) { f32x4_t v = (f32x4_t){0.f, 0.f, 0.f, 0.f}; if (src) v = __builtin_nontemporal_load((const f32x4_t*)(src + 4 * lane + 256 * j));
            s += v[0] * v[0] + v[1] * v[1] + v[2] * v[2] + v[3] * v[3];
            u32x2_t w; w.x = pk2(v[0], v[1]); w.y = pk2(v[2], v[3]); *(u32x2_t*)(HB + (size_t)r * 1024 + 4 * lane + 256 * j) = w; }
        s = wave_sum(s); if (lane == 0) ssq0[r] = s;
    }
}

#define XB_TMO      128
#define XB_XCNT(j)  (256  + 64 * (j))
#define XB_XSUB(j)  (1280 + 64 * (j))
#define XB_XGEN(j)  (2304 + 64 * (j))
#define XB_TOP      3328
#define XB_TOPGEN   3392
#define XCD_BAR_WORDS 3456
#define XB_SPIN_CAP (1u << 18)

__device__ __forceinline__ unsigned xb_ld(unsigned* p)              { return __hip_atomic_load(p, __ATOMIC_RELAXED, __HIP_MEMORY_SCOPE_AGENT); }
__device__ __forceinline__ unsigned xb_add(unsigned* p, unsigned v) { return __hip_atomic_fetch_add(p, v, __ATOMIC_RELAXED, __HIP_MEMORY_SCOPE_AGENT); }
__device__ __forceinline__ unsigned xb_xcc_id() { return (unsigned)__builtin_amdgcn_s_getreg((3 << 11) | 20) & 0xFu; }
#define XB_SPIN(cond, bar) do { unsigned _sp = 0; while (cond) { __builtin_amdgcn_s_sleep(1); \
    if ((++_sp & 255u) == 0u) { if (xb_ld(&(bar)[XB_TMO])) break; if (_sp > XB_SPIN_CAP) { atomicAdd(&(bar)[XB_TMO], 1u); break; } } } } while (0)

struct XcdBarrier {
    unsigned* bar; unsigned x;
    volatile LAS unsigned* st;
};

__device__ __forceinline__ XcdBarrier xcd_barrier_post(unsigned* bar, volatile LAS unsigned* st) {
    XcdBarrier b; b.bar = bar; b.x = xb_xcc_id(); b.st = st;
    if (threadIdx.x == 0) (void)xb_add(&bar[XB_XCNT(b.x)], 1u);
    return b;
}
__device__ __forceinline__ void xcd_barrier_complete(unsigned* bar, unsigned x, unsigned& nloc, unsigned& nx) {
    const unsigned G = gridDim.x * gridDim.y * gridDim.z;
    unsigned sum, cnt, mine, sp = 0u;
    for (;;) {
        sum = 0u; cnt = 0u; mine = 0u;
#pragma unroll
        for (unsigned j = 0; j < 16; ++j) { const unsigned c = xb_ld(&bar[XB_XCNT(j)]); sum += c; cnt += (c > 0u) ? 1u : 0u; mine = (j == x) ? c : mine; }
        if (sum == G) break;
        __builtin_amdgcn_s_sleep(1);
        if ((++sp & 255u) == 0u) { if (xb_ld(&bar[XB_TMO])) break; if (sp > XB_SPIN_CAP) { atomicAdd(&bar[XB_TMO], 1u); break; } }
    }
    nloc = mine > 0u ? mine : 1u; nx = cnt > 0u ? cnt : 1u;
}

__device__ __forceinline__ void xcd_barrier(const XcdBarrier& b, int tid_) {
    asm volatile("s_waitcnt vmcnt(0)" ::: "memory");
    __syncthreads();
    if (tid_ == 0) {
        unsigned* bar = b.bar;
        __builtin_amdgcn_s_waitcnt(0);
        unsigned nloc = b.st[0], nx = b.st[1];
        if (nloc == 0u) { xcd_barrier_complete(bar, b.x, nloc, nx); b.st[0] = nloc; b.st[1] = nx; }
        const unsigned old = xb_add(&bar[XB_XSUB(b.x)], 1u);
        const unsigned gen = old / nloc;
        if (old + 1u == (gen + 1u) * nloc) {
            __builtin_amdgcn_fence(__ATOMIC_RELEASE, "agent");
            asm volatile("s_waitcnt vmcnt(0)" ::: "memory");
            const unsigned og = xb_add(&bar[XB_TOP], 1u);
            const unsigned tg = og / nx;
            if (og + 1u == (tg + 1u) * nx) xb_add(&bar[XB_TOPGEN], 1u);
            else XB_SPIN(xb_ld(&bar[XB_TOPGEN]) == tg, bar);
            __builtin_amdgcn_fence(__ATOMIC_ACQUIRE, "agent");
            xb_add(&bar[XB_XGEN(b.x)], 1u);
            asm volatile("s_waitcnt vmcnt(0)" ::: "memory");
        } else {
            XB_SPIN(xb_ld(&bar[XB_XGEN(b.x)]) == gen, bar);
            __builtin_amdgcn_fence(__ATOMIC_ACQUIRE, "agent");
            asm volatile("s_waitcnt vmcnt(0)" ::: "memory");
        }
    }
    __syncthreads();
}

template <class Epi, bool ALIGN>
__device__ __forceinline__ void run_gemm(unsigned char* lds, const bf16* A, const bf16* Bt, int nM, int nN, int K, int a_tile_rows, const Epi& E, int tid) {
    asm volatile("" : "+s"(K));
    pg8::Gemm g{A, Bt, nM * 256, nN * 256, K, a_tile_rows, K, 0u, 0u}; pg8::StaticOrder S; S.init(nM * 256, nN * 256, (int)gridDim.x, (int)blockIdx.x);
    pg8::gemm_phase<Epi, pg8::StaticOrder, ALIGN, true>((PG8_LAS unsigned char*)lds, g, S, E, tid);
}
template <class Epi>
__device__ __forceinline__ void run_gemm_list(unsigned char* lds, const bf16* A, const bf16* Bt, int K, int lda, unsigned a_off1, unsigned a_off2, const pg8::BalOrder& S, const Epi& E, int tid) {
    asm volatile("" : "+s"(K));
    pg8::Gemm g{A, Bt, 0, 0, K, 256, lda, a_off1, a_off2};
    pg8::gemm_phase<Epi, pg8::BalOrder, true, true>((PG8_LAS unsigned char*)lds, g, S, E, tid);
}

template <bool PA>
__device__ __forceinline__ void hgrn_scan(unsigned char* lds, const bf16* Q, const bf16* FFb, const bf16* FBb, const bf16* Ib, bf16* OFb, bf16* OBb, const float* lbp, float* segm, int slab, int tid) {
    const int lane = tid & 63, wave = tid >> 6, r16 = lane & 15, kq = lane >> 4;
    bf16* qin = (bf16*)lds;
    bf16* kin = qin + 64 * 136;
    bf16* kinT = kin + 64 * 136;
    bf16* Pm = kinT + 128 * 72;
    bf16* iT = Pm + 64 * 72;
    bf16* SbT = iT + 128 * 72;
    float* tot = (float*)(SbT + 128 * 136);
    float* c1 = tot + 512; float* c2 = c1 + 128; float* gtv = c2 + 128;
    const int G = slab == 0 ? 8 : 16, nch = slab == 0 ? 129 : 257;
    const int c = tid & 127, seg = tid >> 7;
    const int jr = tid >> 3, part = tid & 7;
    for (int item = blockIdx.x; item < 256; item += gridDim.x) {
        const int g = item % G, strm = item / G; const int p0 = g == 0 ? 0 : 1 + 16 * g, p1 = 17 + 16 * g;
        if (PA && g == G - 1) continue;
        const int dir = strm & 1, head = (strm >> 1) & 7, sq = strm >> 4;
        const int seqbase = sq * 8256;
        const bf16* Fp = dir ? FBb : FFb; bf16* Op = dir ? OBb : OFb;
        const int hc = head * 128 + c;
        const float l0 = lbp[hc], l1 = lbp[1024 + hc]; const float lb = 1.0f / (1.0f + __expf(l1 - l0));
        f32x4_t S[8];
#pragma unroll
        for (int vt = 0; vt < 8; ++vt) S[vt] = (f32x4_t){0.f, 0.f, 0.f, 0.f};
        float gprod = 1.f;
        float* myPsi = segm + (size_t)item * 16512; float* myG = myPsi + 16384;
        if (!PA) {
            for (int gg = 0; gg < g; ++gg) { const float* Psi = segm + (size_t)(strm * G + gg) * 16512; const float* Gv = Psi + 16384;
#pragma unroll
                for (int e = 0; e < 4; ++e) { const int kr = 16 * wave + 4 * kq + e; const float gk = Gv[kr];
#pragma unroll
                    for (int vt = 0; vt < 8; ++vt) S[vt][e] = gk * S[vt][e] + Psi[kr * 128 + 16 * vt + r16]; } }
        }
        unsigned short qraw[16], fraw[16];
        { const int cbase = seqbase + (dir ? nch - 1 - p0 : p0) * 64;
#pragma unroll
          for (int jj = 0; jj < 16; ++jj) { const int j = 16 * seg + jj; const unsigned bo = ((unsigned)(cbase + (dir ? 63 - j : j)) * 1024u + (unsigned)hc) * 2u; qraw[jj] = PA ? (unsigned short)0 : *(const unsigned short*)((const char*)Q + bo); fraw[jj] = *(const unsigned short*)((const char*)Fp + bo); } }
        __syncthreads();
        for (int p = p0; p < p1; ++p) {
            const int cidx = dir ? nch - 1 - p : p; const int cbase = seqbase + cidx * 64;
            float bl[16], kvv[16], qv[16]; float run = 1.f;
#pragma unroll
            for (int jj = 0; jj < 16; ++jj) { const float f = bf2f(fraw[jj]); const float fg = lb + (1.0f - lb) * sigmoidf_(f); run *= fg; bl[jj] = run; kvv[jj] = 1.0f - fg; qv[jj] = bf2f(qraw[jj]); }
            tot[seg * 128 + c] = run;
            { const size_t row = cbase + (dir ? 63 - jr : jr);
              const u32x4_t w0 = *(const u32x4_t*)(Ib + row * 1024 + head * 128 + part * 16), w1 = *(const u32x4_t*)(Ib + row * 1024 + head * 128 + part * 16 + 8);
              const unsigned wa[8] = {w0.x, w0.y, w0.z, w0.w, w1.x, w1.y, w1.z, w1.w};
#pragma unroll
              for (int q = 0; q < 8; ++q) { iT[(part * 16 + 2 * q) * 72 + jr] = (bf16)(wa[q] & 0xffff); iT[(part * 16 + 2 * q + 1) * 72 + jr] = (bf16)(wa[q] >> 16); } }
            if (p + 1 < p1) { const int nb = seqbase + (dir ? nch - 2 - p : p + 1) * 64;
#pragma unroll
                for (int jj = 0; jj < 16; ++jj) { const int j = 16 * seg + jj; const unsigned bo = ((unsigned)(nb + (dir ? 63 - j : j)) * 1024u + (unsigned)hc) * 2u; qraw[jj] = PA ? (unsigned short)0 : *(const unsigned short*)((const char*)Q + bo); fraw[jj] = *(const unsigned short*)((const char*)Fp + bo); } }
            __syncthreads();
            const float t0 = tot[c], t1 = tot[128 + c], t2 = tot[256 + c], t3 = tot[384 + c];
            const float off = seg == 0 ? 1.f : (seg == 1 ? t0 : (seg == 2 ? t0 * t1 : t0 * t1 * t2));
            const float aref = t0 * t1, alast = (t0 * t1) * (t2 * t3); const float iaref = __builtin_amdgcn_rcpf(aref);
#pragma unroll
            for (int jj = 0; jj < 16; ++jj) { const int j = 16 * seg + jj; const float at = off * bl[jj];
                const float ke = kvv[jj] * (aref * __builtin_amdgcn_rcpf(at)); const bf16 kb = (bf16)f2bf(ke); kinT[c * 72 + j] = kb;
                if (!PA) { const float qe = qv[jj] * (at * iaref); qin[j * 136 + c] = (bf16)f2bf(qe); kin[j * 136 + c] = kb; } }
            if (seg == 0) { c1[c] = aref; c2[c] = alast * iaref; gtv[c] = alast; gprod *= alast; }
            __syncthreads();
            if (!PA) {
                { const int cc = 16 * wave + 4 * kq; const float s0 = c1[cc], s1 = c1[cc + 1], s2 = c1[cc + 2], s3 = c1[cc + 3];
#pragma unroll
                  for (int vt = 0; vt < 8; ++vt) { u32x2_t w; w.x = pk2(s0 * S[vt][0], s1 * S[vt][1]); w.y = pk2(s2 * S[vt][2], s3 * S[vt][3]); *(u32x2_t*)(SbT + (16 * vt + r16) * 136 + cc) = w; } }
                { const int tt = wave >> 1;
#pragma unroll
                  for (int si = 0; si < 2; ++si) { const int ss = 2 * (wave & 1) + si; f32x4_t ac = (f32x4_t){0.f, 0.f, 0.f, 0.f};
#pragma unroll
                      for (int kk = 0; kk < 4; ++kk) { const bf16x8_t av = *(const bf16x8_t*)(qin + (16 * tt + r16) * 136 + 32 * kk + 8 * kq); const bf16x8_t bv = *(const bf16x8_t*)(kin + (16 * ss + r16) * 136 + 32 * kk + 8 * kq);
                          ac = __builtin_amdgcn_mfma_f32_16x16x32_bf16(av, bv, ac, 0, 0, 0); }
#pragma unroll
                      for (int e = 0; e < 4; ++e) { const int t = 16 * tt + 4 * kq + e, s = 16 * ss + r16; Pm[t * 72 + s] = (bf16)f2bf(s <= t ? ac[e] : 0.f); } } }
                __syncthreads();
            }
            f32x4_t kv[8];
            { const bf16x8_t a0 = *(const bf16x8_t*)(kinT + (16 * wave + r16) * 72 + 8 * kq), a1 = *(const bf16x8_t*)(kinT + (16 * wave + r16) * 72 + 32 + 8 * kq);
#pragma unroll
              for (int vt = 0; vt < 8; ++vt) { kv[vt] = (f32x4_t){0.f, 0.f, 0.f, 0.f};
                  kv[vt] = __builtin_amdgcn_mfma_f32_16x16x32_bf16(a0, *(const bf16x8_t*)(iT + (16 * vt + r16) * 72 + 8 * kq), kv[vt], 0, 0, 0);
                  kv[vt] = __builtin_amdgcn_mfma_f32_16x16x32_bf16(a1, *(const bf16x8_t*)(iT + (16 * vt + r16) * 72 + 32 + 8 * kq), kv[vt], 0, 0, 0); } }
            if (!PA) { const int tt = wave & 3;
#pragma unroll
                for (int vi = 0; vi < 4; ++vi) { const int vt = 4 * (wave >> 2) + vi; f32x4_t o = (f32x4_t){0.f, 0.f, 0.f, 0.f};
#pragma unroll
                    for (int kk = 0; kk < 2; ++kk) o = __builtin_amdgcn_mfma_f32_16x16x32_bf16(*(const bf16x8_t*)(Pm + (16 * tt + r16) * 72 + 32 * kk + 8 * kq), *(const bf16x8_t*)(iT + (16 * vt + r16) * 72 + 32 * kk + 8 * kq), o, 0, 0, 0);
#pragma unroll
                    for (int kk = 0; kk < 4; ++kk) o = __builtin_amdgcn_mfma_f32_16x16x32_bf16(*(const bf16x8_t*)(qin + (16 * tt + r16) * 136 + 32 * kk + 8 * kq), *(const bf16x8_t*)(SbT + (16 * vt + r16) * 136 + 32 * kk + 8 * kq), o, 0, 0, 0);
#pragma unroll
                    for (int e = 0; e < 4; ++e) kin[(16 * tt + 4 * kq + e) * 136 + 16 * vt + r16] = (bf16)f2bf(o[e]); } }
            { const int cc = 16 * wave + 4 * kq;
#pragma unroll
              for (int e = 0; e < 4; ++e) { const float ge = gtv[cc + e], ce = c2[cc + e];
#pragma unroll
                  for (int vt = 0; vt < 8; ++vt) S[vt][e] = ge * S[vt][e] + ce * kv[vt][e]; } }
            __syncthreads();
            if (!PA) { const size_t row = cbase + (dir ? 63 - jr : jr);
                *(u32x4_t*)(Op + row * 1024 + head * 128 + part * 16) = *(const u32x4_t*)(kin + jr * 136 + part * 16);
                *(u32x4_t*)(Op + row * 1024 + head * 128 + part * 16 + 8) = *(const u32x4_t*)(kin + jr * 136 + part * 16 + 8); }
        }
        if (PA) {
#pragma unroll
            for (int e = 0; e < 4; ++e) { const int kr = 16 * wave + 4 * kq + e;
#pragma unroll
                for (int vt = 0; vt < 8; ++vt) myPsi[kr * 128 + 16 * vt + r16] = S[vt][e]; }
            if (seg == 0) myG[c] = gprod;
        }
    }
}

__device__ __forceinline__ void hgrn_gate(const bf16* OFb, const bf16* OBb, bf16* G, const float* onorm, int tid) {
    const int lane = tid & 63, wave = tid >> 6; const int gw = blockIdx.x * 8 + wave, NGW = gridDim.x * 8;
    for (int r = gw; r < SLAB; r += NGW) {
        const size_t off = (size_t)r * 1024 + 16 * lane;
        float o[16], g[16]; float ss = 0.f;
#pragma unroll
        for (int h = 0; h < 2; ++h) { const u32x4_t a = *(const u32x4_t*)(OFb + off + 8 * h), b = *(const u32x4_t*)(OBb + off + 8 * h), gg = *(const u32x4_t*)(G + off + 8 * h);
            const unsigned aw[4] = {a.x, a.y, a.z, a.w}, bw[4] = {b.x, b.y, b.z, b.w}, gw4[4] = {gg.x, gg.y, gg.z, gg.w};
#pragma unroll
            for (int q = 0; q < 4; ++q) { o[8 * h + 2 * q] = __uint_as_float(aw[q] << 16) + __uint_as_float(bw[q] << 16); o[8 * h + 2 * q + 1] = __uint_as_float(aw[q] & 0xffff0000u) + __uint_as_float(bw[q] & 0xffff0000u);
                g[8 * h + 2 * q] = __uint_as_float(gw4[q] << 16); g[8 * h + 2 * q + 1] = __uint_as_float(gw4[q] & 0xffff0000u); } }
#pragma unroll
        for (int i = 0; i < 16; ++i) ss += o[i] * o[i];
        ss += __shfl_xor(ss, 1); ss += __shfl_xor(ss, 2); ss += __shfl_xor(ss, 4);
        const float rs = rsqrtf(ss * (1.0f / 128.0f) + NEPS);
        float res[16];
#pragma unroll
        for (int i = 0; i < 16; ++i) res[i] = o[i] * rs * onorm[16 * lane + i] * g[i];
#pragma unroll
        for (int h = 0; h < 2; ++h) { u32x4_t w; w.x = pk2(res[8 * h], res[8 * h + 1]); w.y = pk2(res[8 * h + 2], res[8 * h + 3]); w.z = pk2(res[8 * h + 4], res[8 * h + 5]); w.w = pk2(res[8 * h + 6], res[8 * h + 7]);
            *(u32x4_t*)(G + off + 8 * h) = w; }
    }
}

__device__ __forceinline__ void rwkv_mix(const bf16* HB, const float* ssq, const float* gain, const float* mu, bf16* P0, bf16* P1, int row0, int tid) {
    const int lane = tid & 63, wave = tid >> 6; const int gw = blockIdx.x * 8 + wave, NGW = gridDim.x * 8;
    for (int lr = gw; lr < SLAB; lr += NGW) {
        const int r = row0 + lr; const bool pad = row_is_pad(r);
        const float rs = rsqrtf(pg8::row_ssq16(ssq, r) * (1.0f / 1024.0f) + NEPS);
        const float rsm = (r > 0) ? rsqrtf(pg8::row_ssq16(ssq, r - 1) * (1.0f / 1024.0f) + NEPS) : 0.f;
        const float rsp = (r < TROWS - 1) ? rsqrtf(pg8::row_ssq16(ssq, r + 1) * (1.0f / 1024.0f) + NEPS) : 0.f;
#pragma unroll
        for (int h = 0; h < 2; ++h) { const int col = 16 * lane + 8 * h; const size_t off = (size_t)r * 1024 + col;
            u32x4_t a = *(const u32x4_t*)(HB + off), am = (u32x4_t){0u, 0u, 0u, 0u}, ap = (u32x4_t){0u, 0u, 0u, 0u};
            if (r > 0) am = *(const u32x4_t*)(HB + off - 1024);
            if (r < TROWS - 1) ap = *(const u32x4_t*)(HB + off + 1024);
            const unsigned aw[4] = {a.x, a.y, a.z, a.w}, mw[4] = {am.x, am.y, am.z, am.w}, pw[4] = {ap.x, ap.y, ap.z, ap.w};
            float xr[8], xk[8], xv[8], xx[8];
            const f32x4_t ga = *(const f32x4_t*)(gain + col), gb = *(const f32x4_t*)(gain + col + 4);
            const f32x4_t ra = *(const f32x4_t*)(mu + col), rb = *(const f32x4_t*)(mu + col + 4), ka = *(const f32x4_t*)(mu + 2048 + col), kb = *(const f32x4_t*)(mu + 2048 + col + 4), va = *(const f32x4_t*)(mu + 3072 + col), vb = *(const f32x4_t*)(mu + 3072 + col + 4);
            const float keep = pad ? 0.f : 1.f;
#pragma unroll
            for (int q = 0; q < 4; ++q) {
#pragma unroll
                for (int hh = 0; hh < 2; ++hh) { const int i8 = 2 * q + hh; const float g0 = (i8 < 4 ? ga[i8 & 3] : gb[i8 & 3]) * keep;
                    const float mr = i8 < 4 ? ra[i8 & 3] : rb[i8 & 3], mk = i8 < 4 ? ka[i8 & 3] : kb[i8 & 3], mv = i8 < 4 ? va[i8 & 3] : vb[i8 & 3];
                    const float x0 = (hh ? __uint_as_float(aw[q] & 0xffff0000u) : __uint_as_float(aw[q] << 16)) * rs * g0;
                    const float m0 = (hh ? __uint_as_float(mw[q] & 0xffff0000u) : __uint_as_float(mw[q] << 16)) * rsm * g0;
                    const float p0 = (hh ? __uint_as_float(pw[q] & 0xffff0000u) : __uint_as_float(pw[q] << 16)) * rsp * g0;
                    const float d0 = 0.5f * (m0 + p0) - x0;
                    xx[i8] = d0; xr[i8] = x0 + d0 * mr; xk[i8] = x0 + d0 * mk; xv[i8] = x0 + d0 * mv; } }
            u32x4_t w; w.x = pk2(xr[0], xr[1]); w.y = pk2(xr[2], xr[3]); w.z = pk2(xr[4], xr[5]); w.w = pk2(xr[6], xr[7]);
            *(u32x4_t*)(P0 + (size_t)lr * 2048 + col) = w;
            w.x = pk2(xx[0], xx[1]); w.y = pk2(xx[2], xx[3]); w.z = pk2(xx[4], xx[5]); w.w = pk2(xx[6], xx[7]);
            *(u32x4_t*)(P0 + (size_t)lr * 2048 + 1024 + col) = w;
            w.x = pk2(xk[0], xk[1]); w.y = pk2(xk[2], xk[3]); w.z = pk2(xk[4], xk[5]); w.w = pk2(xk[6], xk[7]);
            *(u32x4_t*)(P1 + (size_t)lr * 2048 + col) = w;
            w.x = pk2(xv[0], xv[1]); w.y = pk2(xv[2], xv[3]); w.z = pk2(xv[4], xv[5]); w.w = pk2(xv[6], xv[7]);
            *(u32x4_t*)(P1 + (size_t)lr * 2048 + 1024 + col) = w; }
    }
}

__device__ __forceinline__ void rwkv_scan_seq(unsigned char* lds, const bf16* Rb, const bf16* Kb, const bf16* Vb, const bf16* HWb, const bf16* HAb, bf16* OFb, bf16* OBb, float* beta,
                                              ArgP a, int slab, int tid) {
    float* w2s = (float*)lds; float* a2s = w2s + 4096; float* rS = a2s + 4096; float* kdS = rS + 4096; float* vS = kdS + 4096; float* wS = vS + 4096; float* kkS = wS + 4096; float* kkaS = kkS + 4096;
    const int nitems = (slab == 0 ? 2 : 1) * 32, nch = slab == 0 ? 129 : 257;
    const int j = tid >> 3, part = tid & 7, c8 = part * 8;
    for (int item = blockIdx.x; item < nitems; item += gridDim.x) {
        const int d = item & 1, head = (item >> 1) & 15, sq = item >> 5; const int seqbase = sq * 8256; const int hc8 = head * 64 + c8;
        bf16* Op = d ? OBb : OFb;
        const float* w0 = a->in[15] + d * 1024; const float* w2 = a->in[17] + (size_t)d * 64 * 1024; const float* a0 = a->in[18] + d * 1024; const float* a2 = a->in[20] + (size_t)d * 64 * 1024;
        const float* pkk = a->in[23]; const float* pka = a->in[24]; const float* prk = a->in[25];
        __syncthreads();
        for (int i = tid; i < 4096; i += 512) { const int l = i >> 6, cc = i & 63; w2s[i] = w2[(size_t)l * 1024 + head * 64 + cc]; a2s[i] = a2[(size_t)l * 1024 + head * 64 + cc]; }
        float s[8];
#pragma unroll
        for (int e = 0; e < 8; ++e) s[e] = 0.f;
        __syncthreads();
        for (int p = 0; p < nch; ++p) {
            const int cidx = d ? nch - 1 - p : p; const int cbase = seqbase + cidx * 64;
            const size_t row = cbase + (d ? 63 - j : j);
            asm volatile("" ::: "memory");
            float w0c[8], a0c[8];
#pragma unroll
            for (int e = 0; e < 8; ++e) { w0c[e] = w0[hc8 + e]; a0c[e] = a0[hc8 + e]; }
            const u32x4_t rw = *(const u32x4_t*)(Rb + row * 1024 + hc8), kw = *(const u32x4_t*)(Kb + row * 1024 + hc8), vw = *(const u32x4_t*)(Vb + row * 1024 + hc8);
            const unsigned rwa[4] = {rw.x, rw.y, rw.z, rw.w}, kwa[4] = {kw.x, kw.y, kw.z, kw.w}, vwa[4] = {vw.x, vw.y, vw.z, vw.w};
            float rv[8], kv[8], vv[8], z[8], aa[8];
#pragma unroll
            for (int q = 0; q < 4; ++q) { rv[2 * q] = __uint_as_float(rwa[q] << 16); rv[2 * q + 1] = __uint_as_float(rwa[q] & 0xffff0000u); kv[2 * q] = __uint_as_float(kwa[q] << 16); kv[2 * q + 1] = __uint_as_float(kwa[q] & 0xffff0000u);
                vv[2 * q] = __uint_as_float(vwa[q] << 16); vv[2 * q + 1] = __uint_as_float(vwa[q] & 0xffff0000u); }
#pragma unroll
            for (int e = 0; e < 8; ++e) { z[e] = w0c[e]; aa[e] = a0c[e]; }
#pragma unroll 1
            for (int l8 = 0; l8 < 8; ++l8) { const u32x4_t hw = *(const u32x4_t*)(HWb + row * 128 + d * 64 + 8 * l8), ha = *(const u32x4_t*)(HAb + row * 128 + d * 64 + 8 * l8);
                const unsigned hwa[4] = {hw.x, hw.y, hw.z, hw.w}, haa[4] = {ha.x, ha.y, ha.z, ha.w};
#pragma unroll
                for (int q = 0; q < 4; ++q) {
#pragma unroll
                    for (int hh = 0; hh < 2; ++hh) { const int l = 8 * l8 + 2 * q + hh; const float hwv = hh ? __uint_as_float(hwa[q] & 0xffff0000u) : __uint_as_float(hwa[q] << 16); const float hav = hh ? __uint_as_float(haa[q] & 0xffff0000u) : __uint_as_float(haa[q] << 16);
                        const f32x4_t wa = *(const f32x4_t*)(w2s + l * 64 + c8), wb = *(const f32x4_t*)(w2s + l * 64 + c8 + 4), xa = *(const f32x4_t*)(a2s + l * 64 + c8), xb = *(const f32x4_t*)(a2s + l * 64 + c8 + 4);
#pragma unroll
                        for (int e = 0; e < 4; ++e) { z[e] += hwv * wa[e]; z[4 + e] += hwv * wb[e]; aa[e] += hav * xa[e]; aa[4 + e] += hav * xb[e]; }
                        if (hh) asm volatile("" ::: "memory"); } } }
            asm volatile("" ::: "memory");
            float kkc[8], kac[8], rkc[8];
#pragma unroll
            for (int e = 0; e < 8; ++e) { kkc[e] = pkk[hc8 + e]; kac[e] = pka[hc8 + e]; rkc[e] = prk[hc8 + e]; }
            float kk[8], ss = 0.f, bsum = 0.f;
#pragma unroll
            for (int e = 0; e < 8; ++e) { kk[e] = kv[e] * kkc[e]; ss += kk[e] * kk[e]; }
            ss += __shfl_xor(ss, 1); ss += __shfl_xor(ss, 2); ss += __shfl_xor(ss, 4);
            const float inv = rsqrtf(fmaxf(ss, 1e-24f));
#pragma unroll
            for (int e = 0; e < 8; ++e) { const float av = sigmoidf_(aa[e]); const float wv = __expf(-0.6065306597f * sigmoidf_(z[e])); const float kd = kv[e] * (1.0f + (av - 1.0f) * kac[e]); const float kkn = kk[e] * inv;
                bsum += rv[e] * kd * rkc[e];
                rS[j * 64 + c8 + e] = rv[e]; kdS[j * 64 + c8 + e] = kd; vS[j * 64 + c8 + e] = vv[e]; wS[j * 64 + c8 + e] = wv; kkS[j * 64 + c8 + e] = kkn; kkaS[j * 64 + c8 + e] = kkn * av; }
            bsum += __shfl_xor(bsum, 1); bsum += __shfl_xor(bsum, 2); bsum += __shfl_xor(bsum, 4);
            if (part == 0) beta[((size_t)d * SLAB + row) * 16 + head] = bsum;
            __syncthreads();
#pragma unroll 1
            for (int st = 0; st < 64; ++st) {
                const f32x4_t k0 = *(const f32x4_t*)(kkS + st * 64 + c8), k1 = *(const f32x4_t*)(kkS + st * 64 + c8 + 4);
                const f32x4_t wv0 = *(const f32x4_t*)(wS + st * 64 + c8), wv1 = *(const f32x4_t*)(wS + st * 64 + c8 + 4);
                const f32x4_t ka0 = *(const f32x4_t*)(kkaS + st * 64 + c8), ka1 = *(const f32x4_t*)(kkaS + st * 64 + c8 + 4);
                const f32x4_t kd0 = *(const f32x4_t*)(kdS + st * 64 + c8), kd1 = *(const f32x4_t*)(kdS + st * 64 + c8 + 4);
                const f32x4_t r0 = *(const f32x4_t*)(rS + st * 64 + c8), r1 = *(const f32x4_t*)(rS + st * 64 + c8 + 4);
                const float vi = vS[st * 64 + j];
                float sa = 0.f;
#pragma unroll
                for (int e = 0; e < 4; ++e) sa += s[e] * k0[e] + s[4 + e] * k1[e];
                sa += __shfl_xor(sa, 1); sa += __shfl_xor(sa, 2); sa += __shfl_xor(sa, 4);
                float y = 0.f;
#pragma unroll
                for (int e = 0; e < 4; ++e) { s[e] = s[e] * wv0[e] - sa * ka0[e] + vi * kd0[e]; s[4 + e] = s[4 + e] * wv1[e] - sa * ka1[e] + vi * kd1[e]; y += s[e] * r0[e] + s[4 + e] * r1[e]; }
                y += __shfl_xor(y, 1); y += __shfl_xor(y, 2); y += __shfl_xor(y, 4);
                if (part == 0) { const size_t orow = cbase + (d ? 63 - st : st); Op[orow * 1024 + head * 64 + j] = (bf16)f2bf(y); }
            }
            __syncthreads();
        }
    }
}

__device__ __forceinline__ void mm2(f32x4_t (&acc)[2], const bf16* A, const bf16* Bt, int mt, int ntb, int r16, int kq) {
#pragma unroll
    for (int kk = 0; kk < 2; ++kk) { const bf16x8_t av = *(const bf16x8_t*)(A + (16 * mt + r16) * 72 + 32 * kk + 8 * kq);
#pragma unroll
        for (int i = 0; i < 2; ++i) { const bf16x8_t bv = *(const bf16x8_t*)(Bt + (16 * (ntb + i) + r16) * 72 + 32 * kk + 8 * kq); acc[i] = __builtin_amdgcn_mfma_f32_16x16x32_bf16(av, bv, acc[i], 0, 0, 0); } }
}
__device__ __forceinline__ void st_rm(bf16* dst, const f32x4_t (&acc)[2], int mt, int ntb, int r16, int kq) {
#pragma unroll
    for (int i = 0; i < 2; ++i) { const unsigned w0 = pk2(acc[i][0], acc[i][1]), w1 = pk2(acc[i][2], acc[i][3]); bf16* d = dst + (16 * mt + 4 * kq) * 72 + 16 * (ntb + i) + r16;
        d[0] = (bf16)(w0 & 0xffffu); d[72] = (bf16)(w0 >> 16); d[144] = (bf16)(w1 & 0xffffu); d[216] = (bf16)(w1 >> 16); }
}
__device__ __forceinline__ void st_tr(bf16* dst, const f32x4_t (&acc)[2], int mt, int ntb, int r16, int kq) {
#pragma unroll
    for (int i = 0; i < 2; ++i) { u32x2_t w; w.x = pk2(acc[i][0], acc[i][1]); w.y = pk2(acc[i][2], acc[i][3]); *(u32x2_t*)(dst + (16 * (ntb + i) + r16) * 72 + 16 * mt + 4 * kq) = w; }
}
template <bool PA>
__device__ __forceinline__ void rwkv_scan_chunk(unsigned char* lds, const bf16* Rb, const bf16* Kb, const bf16* Vb, const bf16* HWb, const bf16* HAb, bf16* OFb, bf16* OBb, float* beta, float* segm, bf16* tbuf,
                                                ArgP a, int slab, int tid) {
    bf16* M = (bf16*)lds;
#define MAT(i) (M + (i) * 4608)
    bf16* w2T = MAT(13); bf16* a2T = MAT(14); float* wc = (float*)MAT(15); float* cst = wc + 64;
    float* zbuf = (float*)MAT(0); float* abuf = zbuf + 4096;
    float* cumb = (float*)MAT(10); float* segtot = cumb + 4096;
    const int nch = slab == 0 ? 129 : 257, G = slab == 0 ? 4 : 8, nitems = 256, NCHA = nch;
    const int lane = tid & 63, wave = tid >> 6, r16 = lane & 15, kq = lane >> 4, mt = wave >> 1, ntb = 2 * (wave & 1);
    const int j = tid >> 3, part = tid & 7, c8 = part * 8;
    const int tunit = ((j >> 3) + 1) * (4 * (j >> 3) + (j & 7)) + part; const bool tlow = part <= (j >> 3);
    for (int item = blockIdx.x; item < nitems; item += gridDim.x) {
        const int g = item % G, strm = item / G; const int p0 = g == 0 ? 0 : 1 + 32 * g, p1 = 33 + 32 * g;
        const bool haveT = !PA;
        const int d = strm & 1, head = (strm >> 1) & 15, sq = strm >> 5; const int seqbase = sq * 8256; const int hc8 = head * 64 + c8;
        bf16* Op = d ? OBb : OFb;
        const float* w0 = a->in[15] + d * 1024; const float* w2 = a->in[17] + (size_t)d * 64 * 1024; const float* a0 = a->in[18] + d * 1024; const float* a2 = a->in[20] + (size_t)d * 64 * 1024;
        __syncthreads();
        if (tid < 320) { const int wch = tid >> 6, cc = tid & 63; const float* src = wch == 0 ? w0 : (wch == 1 ? a0 : (wch == 2 ? a->in[23] : (wch == 3 ? a->in[24] : a->in[25]))); cst[tid] = src[head * 64 + cc]; }
        for (int i = tid; i < 4096; i += 512) { const int l = i >> 6, cc = i & 63; w2T[cc * 72 + l] = (bf16)f2bf(w2[(size_t)l * 1024 + head * 64 + cc]); a2T[cc * 72 + l] = (bf16)f2bf(a2[(size_t)l * 1024 + head * 64 + cc]); }
        f32x4_t Sacc[2], S2acc[2]; Sacc[0] = (f32x4_t){0.f, 0.f, 0.f, 0.f}; Sacc[1] = Sacc[0];
#pragma unroll
        for (int i = 0; i < 2; ++i)
#pragma unroll
            for (int e = 0; e < 4; ++e) S2acc[i][e] = (16 * mt + 4 * kq + e == 16 * (ntb + i) + r16) ? 1.f : 0.f;
        __syncthreads();
        if (!PA) {
            for (int gg = 0; gg < g; ++gg) {
                const float* Psi = segm + (size_t)(strm * G + gg) * 8192; const float* Phi = Psi + 4096;
                { const f32x4_t q0 = *(const f32x4_t*)(Phi + j * 64 + c8), q1 = *(const f32x4_t*)(Phi + j * 64 + c8 + 4);
#pragma unroll
                  for (int e = 0; e < 4; ++e) { MAT(1)[(c8 + e) * 72 + j] = (bf16)f2bf(q0[e]); MAT(1)[(c8 + 4 + e) * 72 + j] = (bf16)f2bf(q1[e]); } }
                st_rm(MAT(0), Sacc, mt, ntb, r16, kq);
                __syncthreads();
#pragma unroll
                for (int i = 0; i < 2; ++i)
#pragma unroll
                    for (int e = 0; e < 4; ++e) Sacc[i][e] = Psi[(16 * mt + 4 * kq + e) * 64 + 16 * (ntb + i) + r16];
                mm2(Sacc, MAT(0), MAT(1), mt, ntb, r16, kq);
                __syncthreads();
            }
        }
        for (int p = p0; p < p1; ++p) {
            const int cidx = d ? nch - 1 - p : p; const int cbase = seqbase + cidx * 64;
            float rv[8], kk[8], av[8], kd[8], lw[8]; u32x4_t tld = (u32x4_t){0u, 0u, 0u, 0u}, vraw = (u32x4_t){0u, 0u, 0u, 0u};
            {
                const size_t row = cbase + (d ? 63 - j : j);
                asm volatile("" ::: "memory");
                if (haveT && tlow) tld = *(const u32x4_t*)(tbuf + ((size_t)strm * NCHA + p) * 2304 + tunit * 8);
                *(u32x4_t*)(MAT(4) + j * 72 + c8) = *(const u32x4_t*)(HWb + row * 128 + d * 64 + c8);
                *(u32x4_t*)(MAT(5) + j * 72 + c8) = *(const u32x4_t*)(HAb + row * 128 + d * 64 + c8);
                const u32x4_t rw = *(const u32x4_t*)(Rb + row * 1024 + hc8), kw = *(const u32x4_t*)(Kb + row * 1024 + hc8), vw = *(const u32x4_t*)(Vb + row * 1024 + hc8);
                __syncthreads();
                { f32x4_t za[2], xa[2]; za[0] = (f32x4_t){0.f, 0.f, 0.f, 0.f}; za[1] = za[0]; xa[0] = za[0]; xa[1] = za[0];
                  mm2(za, MAT(4), w2T, mt, ntb, r16, kq); mm2(xa, MAT(5), a2T, mt, ntb, r16, kq);
#pragma unroll
                  for (int i = 0; i < 2; ++i)
#pragma unroll
                      for (int e = 0; e < 4; ++e) { zbuf[(16 * mt + 4 * kq + e) * 64 + 16 * (ntb + i) + r16] = za[i][e]; abuf[(16 * mt + 4 * kq + e) * 64 + 16 * (ntb + i) + r16] = xa[i][e]; } }
                __syncthreads();
                const unsigned rwa[4] = {rw.x, rw.y, rw.z, rw.w}, kwa[4] = {kw.x, kw.y, kw.z, kw.w};
                float kv[8], z[8], aa[8];
#pragma unroll
                for (int q = 0; q < 4; ++q) { rv[2 * q] = __uint_as_float(rwa[q] << 16); rv[2 * q + 1] = __uint_as_float(rwa[q] & 0xffff0000u); kv[2 * q] = __uint_as_float(kwa[q] << 16); kv[2 * q + 1] = __uint_as_float(kwa[q] & 0xffff0000u);
                }
                vraw = vw;
                { const f32x4_t z0 = *(const f32x4_t*)(zbuf + j * 64 + c8), z1 = *(const f32x4_t*)(zbuf + j * 64 + c8 + 4), x0 = *(const f32x4_t*)(abuf + j * 64 + c8), x1 = *(const f32x4_t*)(abuf + j * 64 + c8 + 4);
#pragma unroll
                  for (int e = 0; e < 4; ++e) { z[e] = cst[c8 + e] + z0[e]; z[4 + e] = cst[c8 + 4 + e] + z1[e]; aa[e] = cst[64 + c8 + e] + x0[e]; aa[4 + e] = cst[64 + c8 + 4 + e] + x1[e]; } }
                asm volatile("" ::: "memory");
                float ss = 0.f, bsum = 0.f;
#pragma unroll
                for (int e = 0; e < 8; ++e) { kk[e] = kv[e] * cst[128 + c8 + e]; ss += kk[e] * kk[e]; }
                ss += __shfl_xor(ss, 1); ss += __shfl_xor(ss, 2); ss += __shfl_xor(ss, 4);
                const float inv = rsqrtf(fmaxf(ss, 1e-24f));
#pragma unroll
                for (int e = 0; e < 8; ++e) { av[e] = sigmoidf_(aa[e]); lw[e] = -0.6065306597f * sigmoidf_(z[e]); kd[e] = kv[e] * (1.0f + (av[e] - 1.0f) * cst[192 + c8 + e]); kk[e] *= inv; bsum += rv[e] * kd[e] * cst[256 + c8 + e]; }
                bsum += __shfl_xor(bsum, 1); bsum += __shfl_xor(bsum, 2); bsum += __shfl_xor(bsum, 4);
                if (!PA && part == 0) beta[((size_t)d * SLAB + row) * 16 + head] = bsum;
                *(f32x4_t*)(cumb + j * 64 + c8) = (f32x4_t){lw[0], lw[1], lw[2], lw[3]}; *(f32x4_t*)(cumb + j * 64 + c8 + 4) = (f32x4_t){lw[4], lw[5], lw[6], lw[7]};
            }
            __syncthreads();
            { const int c = tid & 63, sg = tid >> 6; float run = 0.f;
#pragma unroll
              for (int i = 0; i < 8; ++i) { run += cumb[(8 * sg + i) * 64 + c]; cumb[(8 * sg + i) * 64 + c] = run; }
              segtot[sg * 64 + c] = run; }
            __syncthreads();
            { const int c = tid & 63, sg = tid >> 6; float off = 0.f;
#pragma unroll
              for (int s = 0; s < 7; ++s) off += (s < sg) ? segtot[s * 64 + c] : 0.f;
#pragma unroll
              for (int i = 0; i < 8; ++i) cumb[(8 * sg + i) * 64 + c] += off; }
            __syncthreads();
            {
                const f32x4_t c0 = *(const f32x4_t*)(cumb + j * 64 + c8), c1 = *(const f32x4_t*)(cumb + j * 64 + c8 + 4);
                float ah[8], bh[8], kh[8], rh[8];
#pragma unroll
                for (int e = 0; e < 8; ++e) { const float cu = e < 4 ? c0[e & 3] : c1[e & 3]; const float Wt = __expf(cu), iW = __expf(-cu), Wm1 = __expf(cu - lw[e]);
                    ah[e] = kk[e] * Wm1; bh[e] = -(kk[e] * av[e]) * iW; kh[e] = kd[e] * iW; rh[e] = rv[e] * Wt;
                    if (j == 63) wc[c8 + e] = Wt; }
                u32x4_t w;
                w.x = pk2(ah[0], ah[1]); w.y = pk2(ah[2], ah[3]); w.z = pk2(ah[4], ah[5]); w.w = pk2(ah[6], ah[7]); *(u32x4_t*)(MAT(0) + j * 72 + c8) = w;
                u32x4_t wb, wk;
                wb.x = pk2(bh[0], bh[1]); wb.y = pk2(bh[2], bh[3]); wb.z = pk2(bh[4], bh[5]); wb.w = pk2(bh[6], bh[7]); *(u32x4_t*)(MAT(1) + j * 72 + c8) = wb;
                wk.x = pk2(kh[0], kh[1]); wk.y = pk2(kh[2], kh[3]); wk.z = pk2(kh[4], kh[5]); wk.w = pk2(kh[6], kh[7]); *(u32x4_t*)(MAT(2) + j * 72 + c8) = wk;
                w.x = pk2(rh[0], rh[1]); w.y = pk2(rh[2], rh[3]); w.z = pk2(rh[4], rh[5]); w.w = pk2(rh[6], rh[7]); *(u32x4_t*)(MAT(3) + j * 72 + c8) = w;
                { const unsigned wba[4] = {wb.x, wb.y, wb.z, wb.w}, wka[4] = {wk.x, wk.y, wk.z, wk.w}, wva[4] = {vraw.x, vraw.y, vraw.z, vraw.w};
#pragma unroll
                  for (int q = 0; q < 4; ++q) { bf16* d4 = MAT(4) + (c8 + 2 * q) * 72 + j; bf16* d5 = MAT(5) + (c8 + 2 * q) * 72 + j; bf16* d6 = MAT(6) + (c8 + 2 * q) * 72 + j;
                      d4[0] = (bf16)(wba[q] & 0xffffu); d4[72] = (bf16)(wba[q] >> 16); d5[0] = (bf16)(wka[q] & 0xffffu); d5[72] = (bf16)(wka[q] >> 16); d6[0] = (bf16)(wva[q] & 0xffffu); d6[72] = (bf16)(wva[q] >> 16); } }
                if (haveT) *(u32x4_t*)(MAT(9) + j * 72 + c8) = tld;
                st_rm(MAT(7), Sacc, mt, ntb, r16, kq);
                if (PA) st_rm(MAT(12), S2acc, mt, ntb, r16, kq);
            }
            __syncthreads();
            f32x4_t Pacc[2], Tacc[2], Xacc[2], Yacc[2], tmp[2];
            const f32x4_t z4 = (f32x4_t){0.f, 0.f, 0.f, 0.f};
            Tacc[0] = z4; Tacc[1] = z4;
            if (!haveT) {
            Pacc[0] = z4; Pacc[1] = z4; mm2(Pacc, MAT(0), MAT(1), mt, ntb, r16, kq);
#pragma unroll
            for (int i = 0; i < 2; ++i)
#pragma unroll
                for (int e = 0; e < 4; ++e) { const int t = 16 * mt + 4 * kq + e, s = 16 * (ntb + i) + r16; Pacc[i][e] = (s < t) ? Pacc[i][e] : 0.f; Tacc[i][e] = Pacc[i][e] + ((s == t) ? 1.f : 0.f); }
            st_rm(MAT(8), Pacc, mt, ntb, r16, kq); st_tr(MAT(9), Pacc, mt, ntb, r16, kq);
            }
            tmp[0] = z4; tmp[1] = z4; mm2(tmp, MAT(0), MAT(2), mt, ntb, r16, kq);
#pragma unroll
            for (int i = 0; i < 2; ++i)
#pragma unroll
                for (int e = 0; e < 4; ++e) { const int t = 16 * mt + 4 * kq + e, s = 16 * (ntb + i) + r16; tmp[i][e] = (s < t) ? tmp[i][e] : 0.f; }
            st_rm(MAT(10), tmp, mt, ntb, r16, kq);
            f32x4_t X2acc[2]; X2acc[0] = z4; X2acc[1] = z4;
            if (PA) mm2(X2acc, MAT(0), MAT(12), mt, ntb, r16, kq);
            if (!PA) {
            tmp[0] = z4; tmp[1] = z4; mm2(tmp, MAT(3), MAT(1), mt, ntb, r16, kq);
#pragma unroll
            for (int i = 0; i < 2; ++i)
#pragma unroll
                for (int e = 0; e < 4; ++e) { const int t = 16 * mt + 4 * kq + e, s = 16 * (ntb + i) + r16; tmp[i][e] = (s <= t) ? tmp[i][e] : 0.f; }
            st_rm(MAT(11), tmp, mt, ntb, r16, kq);
            tmp[0] = z4; tmp[1] = z4; mm2(tmp, MAT(3), MAT(2), mt, ntb, r16, kq);
#pragma unroll
            for (int i = 0; i < 2; ++i)
#pragma unroll
                for (int e = 0; e < 4; ++e) { const int t = 16 * mt + 4 * kq + e, s = 16 * (ntb + i) + r16; tmp[i][e] = (s <= t) ? tmp[i][e] : 0.f; }
            st_rm(MAT(12), tmp, mt, ntb, r16, kq);
            }
            Xacc[0] = z4; Xacc[1] = z4; mm2(Xacc, MAT(0), MAT(7), mt, ntb, r16, kq);
            Yacc[0] = z4; Yacc[1] = z4; if (!PA) mm2(Yacc, MAT(3), MAT(7), mt, ntb, r16, kq);
            __syncthreads();
            if (!haveT) {
            tmp[0] = z4; tmp[1] = z4; mm2(tmp, MAT(8), MAT(9), mt, ntb, r16, kq);
            st_rm(MAT(0), tmp, mt, ntb, r16, kq); st_tr(MAT(1), tmp, mt, ntb, r16, kq); st_rm(MAT(2), Tacc, mt, ntb, r16, kq);
            __syncthreads();
#pragma unroll
            for (int i = 1; i <= 5; ++i) {
                bf16* Pc = (i & 1) ? MAT(0) : MAT(8); bf16* PcT = (i & 1) ? MAT(1) : MAT(9); bf16* Pn = (i & 1) ? MAT(8) : MAT(0); bf16* PnT = (i & 1) ? MAT(9) : MAT(1);
                bf16* Tc = (i & 1) ? MAT(2) : MAT(3); bf16* Tn = (i & 1) ? MAT(3) : MAT(2);
                mm2(Tacc, Tc, PcT, mt, ntb, r16, kq);
                if (i < 5) { tmp[0] = z4; tmp[1] = z4; mm2(tmp, Pc, PcT, mt, ntb, r16, kq); st_rm(Pn, tmp, mt, ntb, r16, kq); st_tr(PnT, tmp, mt, ntb, r16, kq); }
                st_rm(Tn, Tacc, mt, ntb, r16, kq);
                __syncthreads();
            }
            }
            if (PA && tlow) *(u32x4_t*)(tbuf + ((size_t)strm * NCHA + p) * 2304 + tunit * 8) = *(const u32x4_t*)(MAT(3) + j * 72 + c8);
            const bf16* Tm = haveT ? MAT(9) : MAT(3);
            mm2(Xacc, MAT(10), MAT(6), mt, ntb, r16, kq);
            st_tr(MAT(7), Xacc, mt, ntb, r16, kq);
            if (PA) st_tr(MAT(11), X2acc, mt, ntb, r16, kq);
            __syncthreads();
            tmp[0] = z4; tmp[1] = z4; mm2(tmp, Tm, MAT(7), mt, ntb, r16, kq);
            st_tr(MAT(8), tmp, mt, ntb, r16, kq);
            if (PA) { tmp[0] = z4; tmp[1] = z4; mm2(tmp, MAT(3), MAT(11), mt, ntb, r16, kq); st_tr(MAT(12), tmp, mt, ntb, r16, kq); }
            __syncthreads();
            if (!PA) { mm2(Yacc, MAT(11), MAT(8), mt, ntb, r16, kq); mm2(Yacc, MAT(12), MAT(6), mt, ntb, r16, kq);
            st_rm(MAT(7), Yacc, mt, ntb, r16, kq); }
            if (PA) mm2(S2acc, MAT(12), MAT(4), mt, ntb, r16, kq);
            mm2(Sacc, MAT(8), MAT(4), mt, ntb, r16, kq); mm2(Sacc, MAT(6), MAT(5), mt, ntb, r16, kq);
#pragma unroll
            for (int i = 0; i < 2; ++i) { const float wk = wc[16 * (ntb + i) + r16];
#pragma unroll
                for (int e = 0; e < 4; ++e) { Sacc[i][e] *= wk; S2acc[i][e] *= wk; } }
            __syncthreads();
            if (!PA) { const size_t orow = cbase + (d ? 63 - j : j); *(u32x4_t*)(Op + orow * 1024 + hc8) = *(const u32x4_t*)(MAT(7) + j * 72 + c8); }
        }
        if (PA) { float* Psi = segm + (size_t)item * 8192; float* Phi = Psi + 4096;
#pragma unroll
            for (int i = 0; i < 2; ++i)
#pragma unroll
                for (int e = 0; e < 4; ++e) { Psi[(16 * mt + 4 * kq + e) * 64 + 16 * (ntb + i) + r16] = Sacc[i][e]; Phi[(16 * mt + 4 * kq + e) * 64 + 16 * (ntb + i) + r16] = S2acc[i][e]; } }
    }
#undef MAT
}

__device__ __forceinline__ void rwkv_gn(bf16* OFb, const bf16* OBb, const bf16* Vb, const float* beta, const float* gnw, const float* gnb, int tid) {
    const int lane = tid & 63, wave = tid >> 6; const int gw = blockIdx.x * 8 + wave, NGW = gridDim.x * 8;
    for (int r = gw; r < SLAB; r += NGW) {
        const size_t off = (size_t)r * 1024 + 16 * lane; const int head = lane >> 2;
        float y[16], v[16]; float sm = 0.f;
#pragma unroll
        for (int h = 0; h < 2; ++h) { const u32x4_t a = *(const u32x4_t*)(OFb + off + 8 * h), b = *(const u32x4_t*)(OBb + off + 8 * h), vv = *(const u32x4_t*)(Vb + off + 8 * h);
            const unsigned aw[4] = {a.x, a.y, a.z, a.w}, bw[4] = {b.x, b.y, b.z, b.w}, vw[4] = {vv.x, vv.y, vv.z, vv.w};
#pragma unroll
            for (int q = 0; q < 4; ++q) { y[8 * h + 2 * q] = __uint_as_float(aw[q] << 16) + __uint_as_float(bw[q] << 16); y[8 * h + 2 * q + 1] = __uint_as_float(aw[q] & 0xffff0000u) + __uint_as_float(bw[q] & 0xffff0000u);
                v[8 * h + 2 * q] = __uint_as_float(vw[q] << 16); v[8 * h + 2 * q + 1] = __uint_as_float(vw[q] & 0xffff0000u); } }
#pragma unroll
        for (int i = 0; i < 16; ++i) sm += y[i];
        sm += __shfl_xor(sm, 1); sm += __shfl_xor(sm, 2);
        const float mean = sm * (1.0f / 64.0f); float sv = 0.f;
#pragma unroll
        for (int i = 0; i < 16; ++i) { const float dd = y[i] - mean; sv += dd * dd; }
        sv += __shfl_xor(sv, 1); sv += __shfl_xor(sv, 2);
        const float rs = rsqrtf(sv * (1.0f / 64.0f) + 64e-5f);
        const float bt = beta[(size_t)r * 16 + head] + beta[((size_t)SLAB + r) * 16 + head];
        float res[16];
#pragma unroll
        for (int i = 0; i < 16; ++i) res[i] = (y[i] - mean) * rs * gnw[16 * lane + i] + gnb[16 * lane + i] + bt * v[i];
#pragma unroll
        for (int h = 0; h < 2; ++h) { u32x4_t w; w.x = pk2(res[8 * h], res[8 * h + 1]); w.y = pk2(res[8 * h + 2], res[8 * h + 3]); w.z = pk2(res[8 * h + 4], res[8 * h + 5]); w.w = pk2(res[8 * h + 6], res[8 * h + 7]);
            *(u32x4_t*)(OFb + off + 8 * h) = w; }
    }
}

__device__ __forceinline__ void final_norm(const bf16* HBN, const float* ssq, const float* gain, float* out, int tid) {
    const int lane = tid & 63, wave = tid >> 6; const int gw = blockIdx.x * 8 + wave, NGW = gridDim.x * 8;
    for (int g = gw; g < 32768; g += NGW) {
        const int row = (g < 16384) ? 16640 + 64 + g : (g < 24576 ? 64 + (g - 16384) : 8256 + 64 + (g - 24576));
        const float rs = rsqrtf(pg8::row_ssq16(ssq, row) * (1.0f / 1024.0f) + NEPS);
#pragma unroll
        for (int jx = 0; jx < 4; ++jx) { const int col = 4 * lane + 256 * jx; const u32x2_t w = *(const u32x2_t*)(HBN + (size_t)row * 1024 + col); const f32x4_t gg = *(const f32x4_t*)(gain + col);
            f32x4_t o; o[0] = __uint_as_float(w.x << 16) * rs * gg[0]; o[1] = __uint_as_float(w.x & 0xffff0000u) * rs * gg[1]; o[2] = __uint_as_float(w.y << 16) * rs * gg[2]; o[3] = __uint_as_float(w.y & 0xffff0000u) * rs * gg[3];
            __builtin_nontemporal_store(o, (f32x4_t*)(out + (size_t)g * 1024 + col)); }
    }
}

#ifndef PHM
#define PHM 4095
#endif
__global__ void __launch_bounds__(512, 2) fwd_mega(Args a_) {
    ArgP ap0 = (ArgP)__builtin_amdgcn_kernarg_segment_ptr();
    extern __shared__ __attribute__((aligned(16))) unsigned char lds[];
    cg::grid_group grid = cg::this_grid();
    PG8_LAS float* edge = (PG8_LAS float*)((PG8_LAS unsigned char*)lds + RING_BYTES);
    volatile LAS unsigned* bst = (volatile LAS unsigned*)((LAS unsigned char*)lds + LDS_BYTES - 16);
    const int wave_s = __builtin_amdgcn_readfirstlane(threadIdx.x >> 6);
    if (threadIdx.x < 4) bst[threadIdx.x] = 0u;
    __syncthreads();
    XcdBarrier xbar = xcd_barrier_post((unsigned*)(ap0->ws + WS_BAR), bst);
    grid.sync();
#pragma unroll 1
    for (int phc = 0; phc < 30; ++phc) {
        int ph = phc; asm volatile("" : "+s"(ph));
        int kind = 15, slab = 0;
        if (ph == 0) kind = 0;
        else if (ph <= 10) { const int q = (ph - 1) % 5; slab = (ph - 1) / 5; kind = q == 0 ? 1 : (q == 1 ? 14 : (q == 2 ? 2 : (q == 3 ? 3 : 4))); }
        else if (ph == 11) kind = 5; else if (ph == 12) kind = 6;
        else if (ph <= 26) { kind = 7 + (ph - 13) % 7; slab = (ph - 13) / 7; }
        else if (ph == 27) { kind = 5; slab = 1; } else if (ph == 28) { kind = 6; slab = 1; }
        ArgP ap = LAUNDER_ARGS(ap0);
        unsigned char* dob = (unsigned char*)ap->out; unsigned char* ws = ap->ws;
        bf16* HB = (bf16*)(dob + DO_HB); float* ssq = (float*)(ws + WS_SSQ); bf16* BIG = (bf16*)(ws + WS_BIG);
        unsigned zl = 0u; asm volatile("" : "+v"(zl));
        const int tid = wave_s * 64 + (int)__builtin_amdgcn_mbcnt_hi(~0u, __builtin_amdgcn_mbcnt_lo(~0u, zl));
        const int row0 = slab * SLAB;
        switch (kind) {
        case 0: if (PHM & 1) p0_prologue(ap, lds, tid); break;
        case 1: { pg8::EpiHgIn E{BIG, ssq + row0};
                  if (PHM & 2) run_gemm<pg8::EpiHgIn, true>(lds, HB + (size_t)row0 * 1024, (const bf16*)(dob + DO_WHG), 65, 20, 1024, 256, E, tid); } break;
        case 2: if (PHM & 4) hgrn_scan<false>(lds, BIG, BIG + SLABE, BIG + 2 * SLABE, BIG + 3 * SLABE, BIG + 5 * SLABE, BIG + 6 * SLABE, ap->in[8], (float*)(ws + WS_HW), slab, tid); break;
        case 14: if (PHM & 4) hgrn_scan<true>(lds, BIG, BIG + SLABE, BIG + 2 * SLABE, BIG + 3 * SLABE, BIG + 5 * SLABE, BIG + 6 * SLABE, ap->in[8], (float*)(ws + WS_HW), slab, tid); break;
        case 3: if (PHM & 8) hgrn_gate(BIG + 5 * SLABE, BIG + 6 * SLABE, BIG + 4 * SLABE, ap->in[9], tid); break;
        case 4: case 6: case 13: {
                  const bf16* A; const bf16* Bt; int nM, K, r0; float* sq; bf16* hout = HB;
                  if (kind == 4) { A = BIG + 4 * SLABE; Bt = (const bf16*)(dob + DO_WHGO); nM = 65; K = 1024; r0 = row0; sq = (float*)(ws + WS_PA); }
                  else if (kind == 13) { A = BIG; Bt = (const bf16*)(dob + DO_WRWO); nM = 65; K = 1024; r0 = row0; sq = (float*)(ws + WS_PA); }
                  else { A = (const bf16*)(ws + WS_ACT); Bt = (const bf16*)(dob + (slab ? DO_WF1O : DO_WF0O)); nM = 130; K = 2816; r0 = 0; sq = (float*)(ws + WS_PB); if (slab) hout = (bf16*)(ws + WS_HBNEW); }
                  pg8::EpiRes E{HB, hout, sq, r0};
                  if (PHM & 16) run_gemm<pg8::EpiRes, true>(lds, A, Bt, nM, 4, K, 256, E, tid); } break;
        case 5: { pg8::EpiFfnIn E{(bf16*)(ws + WS_ACT), (const float*)(ws + WS_PA), ap->in[29] + slab * 3 * FFN, ap->in[30] + slab * FFN, edge};
                  if (PHM & 32) run_gemm<pg8::EpiFfnIn, true>(lds, HB, (const bf16*)(dob + (slab ? DO_WF1I : DO_WF0I)), 131, 22, 1024, 254, E, tid); } break;
        case 7: if (PHM & 64) rwkv_mix(HB, (const float*)(ws + WS_PB), ap->in[3] + 1024, ap->in[10], BIG, BIG + 2 * SLABE, row0, tid); break;
        case 8: {
                  int c = (int)blockIdx.x, gd = (int)gridDim.x; asm volatile("" : "+s"(c), "+s"(gd));
                  { pg8::BalOrder S{65, 2, 130, gd, c, 0};
                    pg8::EpiLora E{(bf16*)(ws + WS_HW), (bf16*)(ws + WS_HA), (bf16*)(ws + WS_HG)};
                    if (PHM & 128) run_gemm_list<pg8::EpiLora>(lds, BIG, (const bf16*)(dob + DO_WLORA), 2048, 2048, 0u, 0u, S, E, tid); }
                  { pg8::BalOrder S{65, 12, 780, gd, c, 1};
                    pg8::EpiRkv E{BIG + 4 * SLABE};
                    if (PHM & 128) run_gemm_list<pg8::EpiRkv>(lds, BIG, (const bf16*)(dob + DO_WRW1), 1024, 2048, (unsigned)(2 * SLABE * 2), (unsigned)(2 * SLABE * 2 + 2048), S, E, tid); } } break;
        case 9: if (PHM & 256) rwkv_scan_chunk<true>(lds, BIG + 4 * SLABE, BIG + 5 * SLABE, BIG + 6 * SLABE, (const bf16*)(ws + WS_HW), (const bf16*)(ws + WS_HA), BIG + 2 * SLABE, BIG + 3 * SLABE, (float*)(ws + WS_BETA), (float*)BIG, (bf16*)((unsigned char*)BIG + 8388608), ap, slab, tid); break;
        case 10: if (PHM & 256) rwkv_scan_chunk<false>(lds, BIG + 4 * SLABE, BIG + 5 * SLABE, BIG + 6 * SLABE, (const bf16*)(ws + WS_HW), (const bf16*)(ws + WS_HA), BIG + 2 * SLABE, BIG + 3 * SLABE, (float*)(ws + WS_BETA), (float*)BIG, (bf16*)((unsigned char*)BIG + 8388608), ap, slab, tid); break;
        case 11: if (PHM & 512) rwkv_gn(BIG + 2 * SLABE, BIG + 3 * SLABE, BIG + 6 * SLABE, (const float*)(ws + WS_BETA), ap->in[26], ap->in[27], tid); break;
        case 12: { pg8::EpiGate E{BIG + 2 * SLABE, BIG};
                  if (PHM & 1024) run_gemm<pg8::EpiGate, true>(lds, (const bf16*)(ws + WS_HG), (const bf16*)(dob + DO_WG2), 65, 4, 256, 256, E, tid); } break;
        default: if (PHM & 2048) final_norm((const bf16*)(ws + WS_HBNEW), (const float*)(ws + WS_PB), ap->in[5], ap->out, tid); break;
        }
        if (phc < 29) { unsigned z2 = 0u; asm volatile("" : "+v"(z2)); const int t2 = wave_s * 64 + (int)__builtin_amdgcn_mbcnt_hi(~0u, __builtin_amdgcn_mbcnt_lo(~0u, z2)); xcd_barrier(xbar, t2); }
    }
}

extern "C" void kernel_launch(void* const* d_in, const int* in_sizes, int n_in, void* d_out, int out_size, void* d_ws, size_t ws_size, hipStream_t stream) {
    static int grid = 0;
    if (grid == 0) {
        if (n_in != 32 || ws_size < WS_NEED || out_size != 32768 * 1024) { fprintf(stderr, "kernel_launch: unexpected shapes (n_in %d, ws %zu, out %d)\n", n_in, ws_size, out_size); grid = -1; return; }
        int dev = 0, cus = 0, per_cu = 0;
        hipGetDevice(&dev); hipDeviceGetAttribute(&cus, hipDeviceAttributeMultiprocessorCount, dev);
        if (hipFuncSetAttribute((const void*)fwd_mega, hipFuncAttributeMaxDynamicSharedMemorySize, LDS_BYTES) != hipSuccess) { fprintf(stderr, "kernel_launch: hipFuncSetAttribute failed\n"); grid = -1; return; }
        if (hipOccupancyMaxActiveBlocksPerMultiprocessor(&per_cu, (const void*)fwd_mega, 512, LDS_BYTES) != hipSuccess || per_cu < 1) { fprintf(stderr, "kernel_launch: occupancy query says %d\n", per_cu); per_cu = 1; }
        (void)hipGetLastError();
        grid = cus;
    }
    if (grid < 0) return;
    if (hipMemsetAsync((char*)d_ws + WS_BAR, 0, 16384, stream) != hipSuccess) { fprintf(stderr, "kernel_launch: memset failed\n"); return; }
    Args a{};
    for (int i = 0; i < 32; ++i) a.in[i] = (const float*)d_in[i];
    a.out = (float*)d_out; a.ws = (unsigned char*)d_ws;
    void* args[] = {&a};
    hipError_t e = hipLaunchCooperativeKernel((const void*)fwd_mega, dim3(grid), dim3(512), args, LDS_BYTES, stream);
    if (e != hipSuccess) fprintf(stderr, "kernel_launch: cooperative launch failed: %s (grid %d)\n", hipGetErrorString(e), grid);
}
```
